# Optimizing an MI355X kernel written in HIP

```python
import jax, jax.numpy as jnp
from jax import lax
import numpy as np

D_MODEL = 1024
BATCH = 4
SEQ = 4096
DEPTH = 1

GRID_W = 64
CTX_LEN = 256
MLA_HEADS = 8
MLA_NOPE = 64
MLA_ROPE = 32
MLA_V = 64
Q_LORA = 256
KV_LORA = 128
MLA_WIDTH = MLA_HEADS * MLA_V
NA_HEADS = 8
NA_DIM = 64
NA_KR = 8
NA_KC = 16
NA_WIDTH = NA_HEADS * NA_DIM

ROPE_THETA = 10000.0
Q_BLOCK = 128
EPS = 1e-6

KV_SPLITS = (KV_LORA, MLA_ROPE, NA_WIDTH, NA_WIDTH)
Q_SPLITS = (Q_LORA, MLA_WIDTH, NA_WIDTH, NA_WIDTH, D_MODEL, D_MODEL)
KV_COLS = KV_LORA + MLA_ROPE + 2 * NA_WIDTH
IN_WIDTH = KV_COLS + Q_LORA + MLA_WIDTH + 2 * NA_WIDTH + 2 * D_MODEL

kernel_name = "hybrid_mla_natten_gated_dit_layer"


def rmsnorm(x, g):
    xf = x.astype(jnp.float32)
    y = xf * lax.rsqrt(jnp.mean(xf * xf, axis=-1, keepdims=True) + EPS)
    return (y * g.astype(jnp.float32)).astype(x.dtype)


def split_cols(p, sizes):
    idx = np.cumsum(np.array(sizes))[:-1].tolist()
    return jnp.split(p, idx, axis=-1)


def heads(t, n):
    b, s, _ = t.shape
    return t.reshape(b, s, n, -1)


def rope_1d(x, pos):
    half = x.shape[-1] // 2
    freqs = ROPE_THETA ** (-jnp.arange(half, dtype=jnp.float32) / half)
    ang = pos.astype(jnp.float32)[:, None] * freqs[None, :]
    cos = jnp.cos(ang)[None, :, None, :]
    sin = jnp.sin(ang)[None, :, None, :]
    x1 = x[..., :half].astype(jnp.float32)
    x2 = x[..., half:].astype(jnp.float32)
    out = jnp.concatenate([x1 * cos - x2 * sin, x2 * cos + x1 * sin], axis=-1)
    return out.astype(x.dtype)


def rope_2d(x, rows, cols):
    d = x.shape[-1] // 2
    return jnp.concatenate([rope_1d(x[..., :d], rows), rope_1d(x[..., d:], cols)], axis=-1)


def mla_q(cq, g_cq, w_uq):
    b, s, _ = cq.shape
    q = (rmsnorm(cq, g_cq) @ w_uq).reshape(b, s, MLA_HEADS, MLA_NOPE + MLA_ROPE)
    return q[..., :MLA_NOPE], q[..., MLA_NOPE:]


def mla_kv(ckv, g_ckv, w_ukv):
    b, s, _ = ckv.shape
    kv = (rmsnorm(ckv, g_ckv) @ w_ukv).reshape(b, s, MLA_HEADS, MLA_NOPE + MLA_V)
    return kv[..., :MLA_NOPE], kv[..., MLA_NOPE:]


def block_attention(q, k, v, scale):
    b, s, h, dk = q.shape
    dv = v.shape[-1]
    nb = s // Q_BLOCK
    qb = q.reshape(b, nb, Q_BLOCK, h, dk).transpose(1, 0, 2, 3, 4)

    def one(qblk):
        sc = jnp.einsum('bqhd,bkhd->bhqk', qblk, k, preferred_element_type=jnp.float32) * scale
        p = jax.nn.softmax(sc, axis=-1).astype(v.dtype)
        return jnp.einsum('bhqk,bkhd->bqhd', p, v)

    o = lax.map(one, qb)
    return o.transpose(1, 0, 2, 3, 4).reshape(b, s, h * dv)


def neighborhood_attention(q, k, v, kc, vc, rpb):
    b, s, h, d = q.shape
    rows = s // GRID_W
    kr = min(NA_KR, rows)
    qg = q.reshape(b, rows, GRID_W, h, d)
    kg = k.reshape(b, rows, GRID_W, h, d)
    vg = v.reshape(b, rows, GRID_W, h, d)
    col = jnp.arange(GRID_W)
    c_start = jnp.clip(col - NA_KC // 2, 0, GRID_W - NA_KC)
    c_idx = c_start[:, None] + jnp.arange(NA_KC)[None, :]
    c_off = c_idx - col[:, None] + (NA_KC - 1)
    scale = d ** -0.5

    def one_row(r):
        r_start = jnp.clip(r - kr // 2, 0, rows - kr)
        k_slab = lax.dynamic_slice_in_dim(kg, r_start, kr, axis=1)
        v_slab = lax.dynamic_slice_in_dim(vg, r_start, kr, axis=1)
        k_win = k_slab[:, :, c_idx]
        v_win = v_slab[:, :, c_idx]
        qr = lax.dynamic_index_in_dim(qg, r, axis=1, keepdims=False)
        r_off = r_start + jnp.arange(kr) - r + (NA_KR - 1)
        bias = rpb[:, r_off[:, None, None], c_off[None, :, :]]
        bias = bias.transpose(0, 2, 1, 3).reshape(h, GRID_W, kr * NA_KC).astype(jnp.float32)
        s_win = jnp.einsum('bwhd,brwchd->bhwrc', qr, k_win, preferred_element_type=jnp.float32)
        s_win = s_win.reshape(b, h, GRID_W, kr * NA_KC) * scale + bias[None]
        s_ctx = jnp.einsum('bwhd,blhd->bhwl', qr, kc, preferred_element_type=jnp.float32) * scale
        p = jax.nn.softmax(jnp.concatenate([s_win, s_ctx], axis=-1), axis=-1).astype(v.dtype)
        p_win = p[..., :kr * NA_KC].reshape(b, h, GRID_W, kr, NA_KC)
        p_ctx = p[..., kr * NA_KC:]
        return (jnp.einsum('bhwrc,brwchd->bwhd', p_win, v_win)
                + jnp.einsum('bhwl,blhd->bwhd', p_ctx, vc))

    o = lax.map(one_row, jnp.arange(rows))
    return o.transpose(1, 0, 2, 3, 4).reshape(b, s, h * d)


def setup_inputs(seed: int = 0) -> dict:
    key = jax.random.key(seed)
    ks = jax.random.split(key, 20)
    n = jax.random.normal
    D = D_MODEL
    return {
        "x": n(ks[0], (BATCH, SEQ, D), jnp.float32),
        "c": n(ks[1], (BATCH, D), jnp.float32),
        "ctx": n(ks[2], (BATCH, CTX_LEN, D), jnp.float32),
        "c_ctx": n(ks[3], (D,), jnp.float32),
        "w_mod": n(ks[4], (DEPTH, D, 3 * D), jnp.float32) * (0.5 * D ** -0.5),
        "b_mod": n(ks[5], (DEPTH, 3 * D), jnp.float32) * 0.01,
        "norm_g": 1.0 + 0.05 * n(ks[6], (DEPTH, D), jnp.float32),
        "w_in": n(ks[7], (DEPTH, D, IN_WIDTH), jnp.float32) * D ** -0.5,
        "g_cq": 1.0 + 0.05 * n(ks[8], (DEPTH, Q_LORA), jnp.float32),
        "w_uq": n(ks[9], (DEPTH, Q_LORA, MLA_HEADS * (MLA_NOPE + MLA_ROPE)), jnp.float32) * Q_LORA ** -0.5,
        "g_ckv": 1.0 + 0.05 * n(ks[10], (DEPTH, KV_LORA), jnp.float32),
        "w_ukv": n(ks[11], (DEPTH, KV_LORA, MLA_HEADS * (MLA_NOPE + MLA_V)), jnp.float32) * KV_LORA ** -0.5,
        "rpb": 0.02 * n(ks[12], (DEPTH, NA_HEADS, 2 * NA_KR - 1, 2 * NA_KC - 1), jnp.float32),
        "w_oa": n(ks[13], (DEPTH, MLA_WIDTH, D), jnp.float32) * MLA_WIDTH ** -0.5,
        "w_ob": n(ks[14], (DEPTH, NA_WIDTH, D), jnp.float32) * NA_WIDTH ** -0.5,
        "w_out": n(ks[15], (DEPTH, D, D), jnp.float32) * D ** -0.5,
        "final_g": 1.0 + 0.05 * n(ks[16], (D,), jnp.float32),
    }


def reference(x, c, ctx, c_ctx, w_mod, b_mod, norm_g, w_in, g_cq, w_uq, g_ckv, w_ukv,
              rpb, w_oa, w_ob, w_out, final_g):
    b, s, _ = x.shape
    t = jnp.arange(s)
    row_pos = t // GRID_W
    col_pos = t % GRID_W
    mla_scale = (MLA_NOPE + MLA_ROPE) ** -0.5
    na_scale = NA_DIM ** -0.5
    sc = jax.nn.silu(c)
    scc = jax.nn.silu(c_ctx)
    for i in range(DEPTH):
        last = i == DEPTH - 1
        shift, scale, gate = jnp.split((sc @ w_mod[i] + b_mod[i])[:, None, :], 3, axis=-1)
        shift_c, scale_c, gate_c = jnp.split(scc @ w_mod[i] + b_mod[i], 3, axis=-1)
        h = rmsnorm(x, norm_g[i]) * (1 + scale) + shift
        hc = rmsnorm(ctx, norm_g[i]) * (1 + scale_c) + shift_c

        ckv, kr, kb, vb, cq, za, qb, zb, ga, gb = split_cols(h @ w_in[i], KV_SPLITS + Q_SPLITS)
        if last:
            c_ckv, c_kr, c_kb, c_vb = split_cols(hc @ w_in[i][:, :KV_COLS], KV_SPLITS)
        else:
            (c_ckv, c_kr, c_kb, c_vb, c_cq, c_za, c_qb, c_zb, c_ga, c_gb) = split_cols(
                hc @ w_in[i], KV_SPLITS + Q_SPLITS)

        qa_n, qa_r = mla_q(cq, g_cq[i], w_uq[i])
        qa = jnp.concatenate([qa_n, rope_2d(qa_r, row_pos, col_pos)], axis=-1)
        ka_n, va = mla_kv(ckv, g_ckv[i], w_ukv[i])
        ka_r = rope_2d(kr[:, :, None, :], row_pos, col_pos)
        ka = jnp.concatenate([ka_n, jnp.broadcast_to(ka_r, ka_n.shape[:-1] + (MLA_ROPE,))], axis=-1)
        kca_n, vca = mla_kv(c_ckv, g_ckv[i], w_ukv[i])
        kca = jnp.concatenate(
            [kca_n, jnp.broadcast_to(c_kr[:, :, None, :], kca_n.shape[:-1] + (MLA_ROPE,))], axis=-1)
        oa = block_attention(qa, jnp.concatenate([ka, kca], axis=1),
                             jnp.concatenate([va, vca], axis=1), mla_scale)

        ob = neighborhood_attention(heads(qb, NA_HEADS), heads(kb, NA_HEADS), heads(vb, NA_HEADS),
                                    heads(c_kb, NA_HEADS), heads(c_vb, NA_HEADS), rpb[i])

        ya = (oa * jax.nn.silu(za)) @ w_oa[i]
        yb = (ob * jax.nn.silu(zb)) @ w_ob[i]
        y = (jax.nn.sigmoid(ga) * ya + jax.nn.sigmoid(gb) * yb) @ w_out[i]

        if not last:
            qca_n, qca_r = mla_q(c_cq, g_cq[i], w_uq[i])
            oca = block_attention(jnp.concatenate([qca_n, qca_r], axis=-1), kca, vca, mla_scale)
            ocb = block_attention(heads(c_qb, NA_HEADS), heads(c_kb, NA_HEADS),
                                  heads(c_vb, NA_HEADS), na_scale)
            yca = (oca * jax.nn.silu(c_za)) @ w_oa[i]
            ycb = (ocb * jax.nn.silu(c_zb)) @ w_ob[i]
            yc = (jax.nn.sigmoid(c_ga) * yca + jax.nn.sigmoid(c_gb) * ycb) @ w_out[i]
            ctx = ctx + gate_c * yc

        x = x + gate * y
    return rmsnorm(x, final_g)
```

```cpp
#include <hip/hip_runtime.h>
#include <hip/hip_bf16.h>
#include <cstdio>
#include <cstdint>
#include <cmath>

#ifndef MK_N_LAUNCHES
#define MK_N_LAUNCHES 1
#endif

namespace pg8 {
#define PG8_LAS __attribute__((address_space(3)))
typedef unsigned short bf16_t;
typedef short bf16x8 __attribute__((ext_vector_type(8)));
typedef float f32x4 __attribute__((ext_vector_type(4)));
typedef unsigned u32x4 __attribute__((ext_vector_type(4)));
typedef unsigned u32x2 __attribute__((ext_vector_type(2)));
constexpr int BM = 256, BK = 64, HALF = 128, HTB = HALF * BK * 2  , STAGE_BYTES = 8 * HTB, NXCD = 8, WGM = 8;

__host__ __device__ __forceinline__ int lds_byte(int r, int c) { const int st = (r >> 4) * 2 + (c >> 5), rr = r & 15, cc = c & 31, ob = rr * 64 + cc * 2; return st * 1024 + (ob ^ (((ob >> 9) & 1) << 5)); }
__host__ __device__ __forceinline__ void stage_rc(int b, int& R, int& C) { const int st = b / 1024, sb = b % 1024, swz = sb ^ (((sb >> 9) & 1) << 5); R = (st >> 1) * 16 + swz / 64; C = (st & 1) * 32 + (swz % 64) / 2; }
__host__ __device__ __forceinline__ int perm32(int rho) { const int n = rho >> 4, i = rho & 15; return 8 * (i >> 2) + 4 * n + (i & 3); }

struct Unit { int ta, tb, kind; };
typedef float f32x2_cv __attribute__((ext_vector_type(2))); typedef __bf16 bf16x2_cv __attribute__((ext_vector_type(2)));
__device__ __forceinline__ unsigned cvt_pk_bf16(float lo, float hi) { const f32x2_cv v = {lo, hi}; const bf16x2_cv b = __builtin_convertvector(v, bf16x2_cv); return __builtin_bit_cast(unsigned, b); }

template <class Epi, class Sched, bool ALIGN_EPI = false, bool SP2 = false>
__device__ __forceinline__ void gemm_phase(PG8_LAS unsigned char* lds, const int K, const Sched& S, const Epi& E) {
    const int tid = threadIdx.x, wid = __builtin_amdgcn_readfirstlane(tid >> 6), lane = tid & 63, wr = wid >> 2, wc = wid & 3, fr = lane & 15, fq = lane >> 4;
    const int nt = K / BK;
    unsigned voffA[2], voffB[2];
#pragma unroll
    for (int i = 0; i < 2; ++i) { int R, C; stage_rc(tid * 16 + i * 8192, R, C); const int Rb = Epi::PERM ? ((R & ~31) + perm32(R & 31)) : R;
        voffA[i] = (unsigned)(R * K + C) * 2u; voffB[i] = (unsigned)(Rb * K + C) * 2u; }
    const size_t kstep = (size_t)(BK * 2);
    const size_t hstep = (size_t)HALF * K * 2;
    const unsigned ldsw = (unsigned)wid * 1024u;
    const int aoff = lds_byte(wr * 64 + fr, fq * 8), boff = lds_byte(wc * 32 + fr, fq * 8);
#define PG8_SA(b, h) (((b) * 2 + (h)) * HTB)
#define PG8_SB(b, h) ((4 + (b) * 2 + (h)) * HTB)
#define PG8_STAGE(bufoff, gbase, voff) do { _Pragma("unroll") for (int _i = 0; _i < 2; ++_i) \
        __builtin_amdgcn_global_load_lds((const unsigned*)((const char*)(gbase) + (voff)[_i]), (PG8_LAS unsigned*)(lds + (bufoff) + ldsw + _i * 8192), 16, 0, 0); } while (0)
#define PG8_LDA(dst, b, h) do { _Pragma("unroll") for (int m = 0; m < 4; ++m) _Pragma("unroll") for (int k = 0; k < 2; ++k) dst[m][k] = *(const PG8_LAS bf16x8*)(lds + PG8_SA(b, h) + aoff + m * 2048 + k * 1024); } while (0)
#define PG8_LDB(dst, b, h) do { _Pragma("unroll") for (int n = 0; n < 2; ++n) _Pragma("unroll") for (int k = 0; k < 2; ++k) dst[n][k] = *(const PG8_LAS bf16x8*)(lds + PG8_SB(b, h) + boff + n * 2048 + k * 1024); } while (0)
#define PG8_MMA(ai, bj, At, Bt) do { __builtin_amdgcn_s_setprio(1); _Pragma("unroll") for (int m = 0; m < 4; ++m) _Pragma("unroll") for (int n = 0; n < 2; ++n) _Pragma("unroll") for (int k = 0; k < 2; ++k) \
        acc[ai][bj][m][n] = __builtin_amdgcn_mfma_f32_16x16x32_bf16(Bt[n][k], At[m][k], acc[ai][bj][m][n], 0, 0, 0); __builtin_amdgcn_s_setprio(0); } while (0)
#define PG8_WAIT_V(n) asm volatile("s_waitcnt vmcnt(" #n ")" ::: "memory")
#define PG8_WAIT_L(n) asm volatile("s_waitcnt lgkmcnt(" #n ")" ::: "memory")
#define PG8_BAR __builtin_amdgcn_s_barrier()
#define PG8_SCHED __builtin_amdgcn_sched_barrier(0)
    Unit cur, nxt; int ui = 0;
    if (!S.next(0, cur)) return;
    f32x4 acc[2][2][4][2];
#pragma unroll
    for (int a = 0; a < 2; ++a)
#pragma unroll
        for (int b = 0; b < 2; ++b)
#pragma unroll
            for (int m = 0; m < 4; ++m)
#pragma unroll
                for (int n = 0; n < 2; ++n) acc[a][b][m][n] = (f32x4){0.f, 0.f, 0.f, 0.f};
    bf16x8 At[4][2], B0[2][2], B1[2][2];
    const char* cA = S.aptr(cur); const char* cB = S.bptr(cur);
    if constexpr (SP2) {
        PG8_STAGE(PG8_SB(0, 0), cB, voffB); PG8_STAGE(PG8_SB(0, 1), cB + hstep, voffB); PG8_STAGE(PG8_SA(0, 0), cA, voffA); PG8_STAGE(PG8_SA(0, 1), cA + hstep, voffA);
        if (wr == 1) PG8_BAR;
        PG8_WAIT_V(2); PG8_BAR;
        PG8_STAGE(PG8_SB(1, 0), cB + kstep, voffB); PG8_STAGE(PG8_SA(1, 0), cA + kstep, voffA); PG8_STAGE(PG8_SB(1, 1), cB + hstep + kstep, voffB);
        PG8_WAIT_V(6); PG8_BAR;
    } else {
        PG8_STAGE(PG8_SB(0, 0), cB, voffB); PG8_STAGE(PG8_SA(0, 0), cA, voffA); PG8_STAGE(PG8_SB(0, 1), cB + hstep, voffB); PG8_STAGE(PG8_SA(0, 1), cA + hstep, voffA);
        if (wr == 1) PG8_BAR;
        PG8_WAIT_V(4); PG8_BAR;
        PG8_STAGE(PG8_SB(1, 0), cB + kstep, voffB); PG8_STAGE(PG8_SA(1, 0), cA + kstep, voffA); PG8_STAGE(PG8_SB(1, 1), cB + hstep + kstep, voffB);
        PG8_WAIT_V(6); PG8_BAR;
    }
    for (;;) {
        const bool has_next = S.next(ui + 1, nxt);
        const char* nA = has_next ? S.aptr(nxt) : cA; const char* nB = has_next ? S.bptr(nxt) : cB;
        for (int t = 0; t < nt; t += 2) {
            const bool last = (t == nt - 2);
            const char* a1 = cA + (size_t)(t + 1) * kstep;
            const char* a2 = last ? nA : cA + (size_t)(t + 2) * kstep; const char* b2 = last ? nB : cB + (size_t)(t + 2) * kstep;
            const char* a3 = a2 + kstep; const char* b3 = b2 + kstep;
            if constexpr (SP2) {
            PG8_LDB(B0, 0, 0); PG8_LDB(B1, 0, 1); PG8_SCHED; PG8_LDA(At, 0, 0); PG8_STAGE(PG8_SA(1, 1), a1 + hstep, voffA);
            PG8_WAIT_V(8); PG8_WAIT_L(0); PG8_BAR; PG8_MMA(0, 0, At, B0); PG8_MMA(0, 1, At, B1); PG8_BAR; PG8_SCHED;
            PG8_LDA(At, 0, 1); PG8_STAGE(PG8_SB(0, 0), b2, voffB); PG8_STAGE(PG8_SB(0, 1), b2 + hstep, voffB); PG8_STAGE(PG8_SA(0, 0), a2, voffA);
            PG8_WAIT_V(8); PG8_WAIT_L(0); PG8_BAR; PG8_MMA(1, 0, At, B0); PG8_MMA(1, 1, At, B1); PG8_BAR; PG8_SCHED;
            PG8_LDB(B0, 1, 0); PG8_LDB(B1, 1, 1); PG8_SCHED; PG8_LDA(At, 1, 0); PG8_STAGE(PG8_SA(0, 1), a2 + hstep, voffA);
            PG8_WAIT_V(8); PG8_WAIT_L(0); PG8_BAR; PG8_MMA(0, 0, At, B0); PG8_MMA(0, 1, At, B1); PG8_BAR; PG8_SCHED;
            PG8_LDA(At, 1, 1); PG8_STAGE(PG8_SB(1, 0), b3, voffB); PG8_STAGE(PG8_SB(1, 1), b3 + hstep, voffB); PG8_STAGE(PG8_SA(1, 0), a3, voffA);
            PG8_WAIT_V(8); PG8_WAIT_L(0); PG8_BAR; PG8_MMA(1, 0, At, B0); PG8_MMA(1, 1, At, B1); PG8_BAR; PG8_SCHED;
            } else {
            PG8_LDB(B0, 0, 0); PG8_SCHED; PG8_LDA(At, 0, 0); PG8_STAGE(PG8_SA(1, 1), a1 + hstep, voffA);
            PG8_WAIT_L(8); PG8_BAR; PG8_WAIT_L(0); PG8_MMA(0, 0, At, B0); PG8_BAR; PG8_SCHED;
            PG8_LDB(B1, 0, 1); PG8_STAGE(PG8_SB(0, 0), b2, voffB);
            PG8_BAR; PG8_WAIT_L(0); PG8_MMA(0, 1, At, B1); PG8_BAR;
            PG8_LDA(At, 0, 1); PG8_STAGE(PG8_SA(0, 0), a2, voffA);
            PG8_BAR; PG8_WAIT_L(0); PG8_MMA(1, 0, At, B0); PG8_BAR; PG8_SCHED;
            PG8_STAGE(PG8_SB(0, 1), b2 + hstep, voffB);
            PG8_WAIT_V(6); PG8_BAR; PG8_MMA(1, 1, At, B1); PG8_BAR;
            PG8_LDB(B0, 1, 0); PG8_SCHED; PG8_LDA(At, 1, 0); PG8_STAGE(PG8_SA(0, 1), a2 + hstep, voffA);
            PG8_WAIT_L(8); PG8_BAR; PG8_WAIT_L(0); PG8_MMA(0, 0, At, B0); PG8_BAR; PG8_SCHED;
            PG8_LDB(B1, 1, 1); PG8_STAGE(PG8_SB(1, 0), b3, voffB);
            PG8_BAR; PG8_WAIT_L(0); PG8_MMA(0, 1, At, B1); PG8_BAR;
            PG8_LDA(At, 1, 1); PG8_STAGE(PG8_SA(1, 0), a3, voffA);
            PG8_BAR; PG8_WAIT_L(0); PG8_MMA(1, 0, At, B0); PG8_BAR; PG8_SCHED;
            PG8_STAGE(PG8_SB(1, 1), b3 + hstep, voffB);
            PG8_WAIT_V(6); PG8_BAR; PG8_MMA(1, 1, At, B1); PG8_BAR;
            }
        }
        if constexpr (ALIGN_EPI) { if (wr == 0) PG8_BAR; }
        if constexpr (!Epi::AFTER_DRAIN) { E(acc, cur, wr, wc, fr, fq); }
        if (!has_next) break;
#pragma unroll
        for (int a = 0; a < 2; ++a)
#pragma unroll
            for (int b = 0; b < 2; ++b)
#pragma unroll
                for (int m = 0; m < 4; ++m)
#pragma unroll
                    for (int n = 0; n < 2; ++n) acc[a][b][m][n] = (f32x4){0.f, 0.f, 0.f, 0.f};
        cur = nxt; cA = nA; cB = nB; ++ui;
        if constexpr (ALIGN_EPI) { if (wr == 1) PG8_BAR; }
    }
    PG8_WAIT_V(0);
    if constexpr (!ALIGN_EPI) { if (wr == 0) PG8_BAR; }
    PG8_BAR;
    if constexpr (Epi::AFTER_DRAIN) { E.fused(acc, cur, wr, wc, fr, fq, lds, wid, lane); }
#undef PG8_SA
#undef PG8_SB
#undef PG8_STAGE
#undef PG8_LDA
#undef PG8_LDB
#undef PG8_MMA
#undef PG8_WAIT_V
#undef PG8_WAIT_L
#undef PG8_BAR
#undef PG8_SCHED
}
}


constexpr int NWAVES = 8;
constexpr int DM = 1024, NB = 4, SEQ = 4096, CTXL = 256, TK = SEQ + CTXL;
constexpr int MLAT = NB * SEQ, MCTX = NB * CTXL, MALL = MLAT + MCTX;
constexpr int INW = 5024, NIN = 5120;
constexpr int NH = 8;
constexpr float EPS = 1e-6f;
constexpr float LOG2E = 1.4426950408889634f;
constexpr float MLA_C2 = 0.10206207261596577f * LOG2E;
constexpr float NA_C2 = 0.125f * LOG2E;

constexpr size_t MiB = 1u << 20;
constexpr size_t WS_CTL = 0, CTL_ZERO_BYTES = 64 * 1024;
constexpr size_t WS_WIN = 2 * MiB;
constexpr size_t WS_WUQ = 12 * MiB;
constexpr size_t WS_WUKV = 12 * MiB + 512 * 1024;
constexpr size_t WS_WOA = 13 * MiB, WS_WOB = 14 * MiB, WS_WOUT = 15 * MiB;
constexpr size_t WS_MOD = 17 * MiB;
constexpr size_t WS_ROPE = 17 * MiB + 256 * 1024;
constexpr size_t WS_SSQQ = 17 * MiB + 512 * 1024;
constexpr size_t WS_SSQKV = 18 * MiB;
constexpr size_t WS_SSQO = 18 * MiB + 512 * 1024;
constexpr size_t WS_H = 20 * MiB;
constexpr size_t WS_QA = 20 * MiB;
constexpr size_t WS_T0 = 54 * MiB;
constexpr size_t WS_CQ = 63 * MiB;
constexpr size_t WS_KB = 71 * MiB;
constexpr size_t WS_VBT = 88 * MiB;
constexpr size_t WS_M = 71 * MiB;
constexpr size_t WS_QB = 105 * MiB;
constexpr size_t WS_SZA = 121 * MiB;
constexpr size_t WS_SZB = 137 * MiB;
constexpr size_t WS_SGA = 153 * MiB;
constexpr size_t WS_SGB = 185 * MiB;
constexpr size_t WS_END = 217 * MiB;
constexpr size_t DO_KA = 0, DO_VAT = 26 * MiB;
constexpr int CW_BAR = 1024;

constexpr int RING_BYTES = 131072, MISC_OFF = RING_BYTES + 320, LDS_BYTES = 147456;

#define GAS __attribute__((address_space(1)))
#define LAS __attribute__((address_space(3)))
typedef unsigned short bf16;
typedef unsigned v4u __attribute__((ext_vector_type(4)));
typedef unsigned v2u __attribute__((ext_vector_type(2)));
typedef float f32x4 __attribute__((ext_vector_type(4)));
typedef float f32x16 __attribute__((ext_vector_type(16)));
typedef short bf16x8 __attribute__((ext_vector_type(8)));
typedef short s16x4 __attribute__((ext_vector_type(4)));
__device__ __forceinline__ unsigned f2bf(float f) { unsigned u = __builtin_bit_cast(unsigned, f); return (u + 0x7fffu + ((u >> 16) & 1u)) >> 16; }
__device__ __forceinline__ unsigned pk2(float lo, float hi) { return f2bf(lo) | (f2bf(hi) << 16); }
__device__ __forceinline__ float bf_lo(unsigned w) { return __builtin_bit_cast(float, w << 16); }
__device__ __forceinline__ float bf_hi(unsigned w) { return __builtin_bit_cast(float, w & 0xffff0000u); }
__device__ __forceinline__ float fast_rcp(float x) { return __builtin_amdgcn_rcpf(x); }
__device__ __forceinline__ float sigmoidf_(float x) { return fast_rcp(1.f + __builtin_amdgcn_exp2f(-x * LOG2E)); }
__device__ __forceinline__ float siluf_(float x) { return x * sigmoidf_(x); }
#define XB_TMO      128
#define XB_XCNT(j)  (256  + 64 * (j))
#define XB_XSUB(j)  (1280 + 64 * (j))
#define XB_XGEN(j)  (2304 + 64 * (j))
#define XB_TOP      3328
#define XB_TOPGEN   3392
#define XCD_BAR_WORDS 3456
#define XB_SPIN_CAP (1u << 18)

__device__ __forceinline__ unsigned xb_ld(unsigned* p)              { return __hip_atomic_load(p, __ATOMIC_RELAXED, __HIP_MEMORY_SCOPE_AGENT); }
__device__ __forceinline__ unsigned xb_add(unsigned* p, unsigned v) { return __hip_atomic_fetch_add(p, v, __ATOMIC_RELAXED, __HIP_MEMORY_SCOPE_AGENT); }
__device__ __forceinline__ unsigned xb_xcc_id() { return (unsigned)__builtin_amdgcn_s_getreg((3 << 11) | 20) & 0xFu; }
#define XB_SPIN(cond, bar) do { unsigned _sp = 0; while (cond) { __builtin_amdgcn_s_sleep(1); \
    if ((++_sp & 255u) == 0u) { if (xb_ld(&(bar)[XB_TMO])) break; if (_sp > XB_SPIN_CAP) { atomicAdd(&(bar)[XB_TMO], 1u); break; } } } } while (0)

struct XcdBarrier {
    unsigned* bar; unsigned x;
    volatile LAS unsigned* st;
};

__device__ __forceinline__ XcdBarrier xcd_barrier_post(unsigned* bar, volatile LAS unsigned* st) {
    XcdBarrier b; b.bar = bar; b.x = xb_xcc_id(); b.st = st;
    if (threadIdx.x == 0) (void)xb_add(&bar[XB_XCNT(b.x)], 1u);
    return b;
}
__device__ __forceinline__ void xcd_barrier_complete(unsigned* bar, unsigned x, unsigned& nloc, unsigned& nx) {
    const unsigned G = gridDim.x * gridDim.y * gridDim.z;
    unsigned sum, cnt, mine, sp = 0u;
    for (;;) {
        sum = 0u; cnt = 0u; mine = 0u;
#pragma unroll
        for (unsigned j = 0; j < 16; ++j) { const unsigned c = xb_ld(&bar[XB_XCNT(j)]); sum += c; cnt += (c > 0u) ? 1u : 0u; mine = (j == x) ? c : mine; }
        if (sum == G) break;
        __builtin_amdgcn_s_sleep(1);
        if ((++sp & 255u) == 0u) { if (xb_ld(&bar[XB_TMO])) break; if (sp > XB_SPIN_CAP) { atomicAdd(&bar[XB_TMO], 1u); break; } }
    }
    nloc = mine > 0u ? mine : 1u; nx = cnt > 0u ? cnt : 1u;
}

__device__ __forceinline__ void xcd_barrier(const XcdBarrier& b) {
    asm volatile("s_waitcnt vmcnt(0)" ::: "memory");
    __syncthreads();
    if (threadIdx.x == 0) {
        unsigned* bar = b.bar;
        __builtin_amdgcn_s_waitcnt(0);
        unsigned nloc = b.st[0], nx = b.st[1];
        if (nloc == 0u) { xcd_barrier_complete(bar, b.x, nloc, nx); b.st[0] = nloc; b.st[1] = nx; }
        const unsigned old = xb_add(&bar[XB_XSUB(b.x)], 1u);
        const unsigned gen = old / nloc;
        if (old + 1u == (gen + 1u) * nloc) {
            __builtin_amdgcn_fence(__ATOMIC_RELEASE, "agent");
            asm volatile("s_waitcnt vmcnt(0)" ::: "memory");
            const unsigned og = xb_add(&bar[XB_TOP], 1u);
            const unsigned tg = og / nx;
            if (og + 1u == (tg + 1u) * nx) xb_add(&bar[XB_TOPGEN], 1u);
            else XB_SPIN(xb_ld(&bar[XB_TOPGEN]) == tg, bar);
            __builtin_amdgcn_fence(__ATOMIC_ACQUIRE, "agent");
            xb_add(&bar[XB_XGEN(b.x)], 1u);
            asm volatile("s_waitcnt vmcnt(0)" ::: "memory");
        } else {
            XB_SPIN(xb_ld(&bar[XB_XGEN(b.x)]) == gen, bar);
            __builtin_amdgcn_fence(__ATOMIC_ACQUIRE, "agent");
            asm volatile("s_waitcnt vmcnt(0)" ::: "memory");
        }
    }
    __syncthreads();
}

#define LDS_WAIT() asm volatile("s_waitcnt lgkmcnt(0)" ::: "memory")
#define VM_WAIT() asm volatile("s_waitcnt vmcnt(0)" ::: "memory")
__device__ __forceinline__ float wave_sum(float v) {
#pragma unroll
    for (int o = 1; o < 64; o <<= 1) v += __shfl_xor(v, o);
    return v;
}
__device__ __forceinline__ void tile_remap(int L, int nM, int nN, int& pm, int& pn) {
    const int nwg = nM * nN; int wgid = L;
    { const int q = nwg / 8, r = nwg % 8, xcd = wgid % 8, off = wgid / 8; wgid = (xcd < r ? xcd * (q + 1) : r * (q + 1) + (xcd - r) * q) + off; }
    const int nig = 8 * nN, gid = wgid / nig, fm = gid * 8, gsz = (nM - fm) < 8 ? (nM - fm) : 8;
    pm = fm + ((wgid % nig) % gsz); pn = (wgid % nig) / gsz;
}
__device__ __forceinline__ void row_bt(int row, int& b, int& t) {
    if (row < MLAT) { b = row >> 12; t = row & 4095; } else { const int r = row - MLAT; b = r >> 8; t = SEQ + (r & 255); }
}

__device__ __forceinline__ void transpose_item(const float* W, int ldw, int k0, int n0, bf16* WT, int KD, int drow0, const float* g, LAS float* scr, int lane) {
#pragma unroll 8
    for (int i = 0; i < 32; ++i) { const int kk = 2 * i + (lane >> 5); float v = W[(size_t)(k0 + kk) * ldw + n0 + (lane & 31)]; if (g) v *= g[k0 + kk]; scr[kk * 33 + (lane & 31)] = v; }
    LDS_WAIT(); asm volatile("" ::: "memory");
    const int c = lane & 7;
#pragma unroll
    for (int j = 0; j < 4; ++j) { const int n = (lane >> 3) + 8 * j; const LAS float* s = scr + (8 * c) * 33 + n;
        v4u o; o.x = pk2(s[0 * 33], s[1 * 33]); o.y = pk2(s[2 * 33], s[3 * 33]); o.z = pk2(s[4 * 33], s[5 * 33]); o.w = pk2(s[6 * 33], s[7 * 33]);
        *(v4u*)(WT + (size_t)(drow0 + n) * KD + k0 + 8 * c) = o; }
    LDS_WAIT(); asm volatile("" ::: "memory");
}

struct Ptrs {
    const float *x, *c, *ctx, *c_ctx, *w_mod, *b_mod, *norm_g, *w_in, *g_cq, *w_uq, *g_ckv, *w_ukv, *rpb, *w_oa, *w_ob, *w_out, *final_g;
    float* out; unsigned char* ws;
};

__device__ __forceinline__ void p0_weights(const Ptrs& P, LAS unsigned char* lds, int tid, int lane, int wave, int G) {
    LAS float* scr = (LAS float*)(lds + wave * 16384);
    const int gw = blockIdx.x * NWAVES + wave, NGW = G * NWAVES;
    unsigned char* ws = P.ws;
    constexpr int I_IN = 16 * 157, I_UQ = 4 * 24, I_UKV = 2 * 32, I_OA = 8 * 32, I_OUT = 16 * 32;
    constexpr int NITEMS = I_IN + I_UQ + I_UKV + 2 * I_OA + I_OUT;
    for (int it = gw; it < NITEMS; it += NGW) {
        int r = it;
        if (r < I_IN) { const int kb = r / 157, nb = r % 157, n0 = 32 * nb; transpose_item(P.w_in, INW, 64 * kb, n0, (bf16*)(ws + WS_WIN), 1024, n0 + (n0 >= 160 ? 96 : 0), nullptr, scr, lane); continue; } r -= I_IN;
        if (r < I_UQ) { const int kb = r / 24, nb = r % 24, h = nb / 3, j = nb % 3; transpose_item(P.w_uq, 768, 64 * kb, 32 * nb, (bf16*)(ws + WS_WUQ), 256, j < 2 ? h * 64 + 32 * j : 512 + 32 * h, P.g_cq, scr, lane); continue; } r -= I_UQ;
        if (r < I_UKV) { const int kb = r / 32, nb = r % 32, h = nb / 4, j = nb % 4; transpose_item(P.w_ukv, 1024, 64 * kb, 32 * nb, (bf16*)(ws + WS_WUKV), 256, j < 2 ? h * 64 + 32 * j : 512 + h * 64 + 32 * (j - 2), P.g_ckv, scr, lane); continue; } r -= I_UKV;
        if (r < I_OA) { const int kb = r / 32, nb = r % 32; transpose_item(P.w_oa, 1024, 64 * kb, 32 * nb, (bf16*)(ws + WS_WOA), 512, 32 * nb, nullptr, scr, lane); continue; } r -= I_OA;
        if (r < I_OA) { const int kb = r / 32, nb = r % 32; transpose_item(P.w_ob, 1024, 64 * kb, 32 * nb, (bf16*)(ws + WS_WOB), 512, 32 * nb, nullptr, scr, lane); continue; } r -= I_OA;
        { const int kb = r / 32, nb = r % 32; transpose_item(P.w_out, 1024, 64 * kb, 32 * nb, (bf16*)(ws + WS_WOUT), 1024, 32 * nb, nullptr, scr, lane); }
    }
    { const int gt = blockIdx.x * (NWAVES * 64) + tid, NT = G * NWAVES * 64; const v4u z = {0u, 0u, 0u, 0u};
      for (int ch = gt; ch < 12288; ch += NT) *(v4u*)(ws + WS_WIN + (size_t)160 * 2048 + (size_t)ch * 16) = z;
      for (int ch = gt; ch < 16384; ch += NT) *(v4u*)(ws + WS_WUKV + (size_t)(ch >> 4) * 512 + 256 + (ch & 15) * 16) = z; }
    if (blockIdx.x == 0) {
        const int p = tid >> 3, i = tid & 7;
        const float fr = (i == 0) ? 1.0f : (i == 1) ? 0.31622776601683794f : (i == 2) ? 0.1f : (i == 3) ? 0.031622776601683794f : (i == 4) ? 0.01f : (i == 5) ? 0.0031622776601683794f : (i == 6) ? 0.001f : 0.00031622776601683794f;
        const float ang = (float)p * fr;
        float2 cs; cs.x = cosf(ang); cs.y = sinf(ang);
        ((float2*)(ws + WS_ROPE))[tid] = cs;
    }
}
__device__ __forceinline__ void p0_gemv(const Ptrs& P, LAS unsigned char* lds, int tid, int lane, int wave, int G) {
    unsigned char* ws = P.ws;
    __syncthreads();
    LAS float* red = (LAS float*)(lds + 7 * 16384 + 12288);
    for (int cgp = blockIdx.x; cgp < 256; cgp += G) {
        const int c0 = 12 * cgp;
        float acc[5][12];
#pragma unroll
        for (int b = 0; b < 5; ++b)
#pragma unroll
            for (int j = 0; j < 12; ++j) acc[b][j] = 0.f;
#pragma unroll
        for (int h = 0; h < 2; ++h) {
            const int kk = tid + 512 * h;
            float s[5];
#pragma unroll
            for (int b = 0; b < 4; ++b) s[b] = siluf_(P.c[b * 1024 + kk]);
            s[4] = siluf_(P.c_ctx[kk]);
            const f32x4* wp = (const f32x4*)(P.w_mod + (size_t)kk * 3072 + c0);
            const f32x4 w0 = wp[0], w1 = wp[1], w2 = wp[2];
            const float w[12] = {w0[0], w0[1], w0[2], w0[3], w1[0], w1[1], w1[2], w1[3], w2[0], w2[1], w2[2], w2[3]};
#pragma unroll
            for (int b = 0; b < 5; ++b)
#pragma unroll
                for (int j = 0; j < 12; ++j) acc[b][j] += s[b] * w[j];
        }
#pragma unroll
        for (int b = 0; b < 5; ++b)
#pragma unroll
            for (int j = 0; j < 12; ++j) { const float v = wave_sum(acc[b][j]); if (lane == 0) red[wave * 60 + b * 12 + j] = v; }
        __syncthreads();
        if (tid < 60) { float v = 0.f;
#pragma unroll
            for (int w8 = 0; w8 < 8; ++w8) v += red[w8 * 60 + tid];
            const int b = tid / 12, j = tid % 12;
            ((float*)(ws + WS_MOD))[b * 3072 + c0 + j] = v + P.b_mod[c0 + j]; }
        __syncthreads();
    }
}

__device__ __forceinline__ void p1_hconv(const Ptrs& P, int lane, int wave, int G) {
    const int gw = blockIdx.x * NWAVES + wave, NGW = G * NWAVES;
    const float* MOD = (const float*)(P.ws + WS_MOD);
    bf16* H = (bf16*)(P.ws + WS_H);
    for (int row = gw; row < MALL; row += NGW) {
        const float* xr = row < MLAT ? P.x + (size_t)row * DM : P.ctx + (size_t)(row - MLAT) * DM;
        const int mb = row < MLAT ? (row >> 12) : 4;
        const f32x4* x4 = (const f32x4*)xr + lane;
        f32x4 v[4]; float s = 0.f;
#pragma unroll
        for (int j = 0; j < 4; ++j) { v[j] = x4[64 * j]; s += (v[j][0] * v[j][0] + v[j][1] * v[j][1]) + (v[j][2] * v[j][2] + v[j][3] * v[j][3]); }
        const float rstd = 1.0f / sqrtf(wave_sum(s) * (1.f / DM) + EPS);
        const f32x4* g4 = (const f32x4*)P.norm_g + lane;
        const f32x4* sh4 = (const f32x4*)(MOD + mb * 3072) + lane;
        const f32x4* sc4 = (const f32x4*)(MOD + mb * 3072 + 1024) + lane;
        unsigned long long* o8 = (unsigned long long*)(H + (size_t)row * DM) + lane;
#pragma unroll
        for (int j = 0; j < 4; ++j) {
            const f32x4 g = g4[64 * j], sh = sh4[64 * j], sc = sc4[64 * j];
            f32x4 h;
#pragma unroll
            for (int e = 0; e < 4; ++e) h[e] = (v[j][e] * rstd * g[e]) * (1.f + sc[e]) + sh[e];
            o8[64 * j] = (unsigned long long)pk2(h[0], h[1]) | ((unsigned long long)pk2(h[2], h[3]) << 32);
        }
    }
}

using pg8::Unit;
using pg8::cvt_pk_bf16;
__device__ __forceinline__ v4u pack8(const f32x4& a, const f32x4& b) { v4u w; w.x = cvt_pk_bf16(a[0], a[1]); w.y = cvt_pk_bf16(a[2], a[3]); w.z = cvt_pk_bf16(b[0], b[1]); w.w = cvt_pk_bf16(b[2], b[3]); return w; }

__device__ __forceinline__ void rope8(float (&v)[8], int fq, int t, const float2* tab) {
    const int pos = (fq < 2) ? (t >> 6) : (t & 63);
    const float sgn = (fq & 1) ? 1.f : -1.f;
#pragma unroll
    for (int i = 0; i < 8; ++i) { const float pv = __shfl_xor(v[i], 16); const float2 cs = tab[pos * 8 + i]; v[i] = v[i] * cs.x + sgn * pv * cs.y; }
}

struct SchedG1 {
    int G, c; const char* H; const char* W;
    static constexpr size_t TS = (size_t)256 * 1024 * 2;
    __device__ __forceinline__ bool next(int i, Unit& u) const {
        const int L = i * G + c; if (L >= 1300) return false;
        int pm, pn;
        if (L < 1280) tile_remap(L, 64, 20, pm, pn); else { const int k = L - 1280; pm = 64 + k / 5; pn = k % 5; }
        if (pn == 3 || pn == 4) { u.kind = 1; u.ta = pn; u.tb = pm; } else { u.kind = 0; u.ta = pm; u.tb = pn; }
        return true;
    }
    __device__ __forceinline__ const char* aptr(const Unit& u) const { return (u.kind == 1 ? W : H) + (size_t)u.ta * TS; }
    __device__ __forceinline__ const char* bptr(const Unit& u) const { return (u.kind == 1 ? H : W) + (size_t)u.tb * TS; }
};
struct EpiG1 {
    static constexpr bool PERM = true, AFTER_DRAIN = false;
    unsigned char* ws; unsigned char* dout;
    __device__ __forceinline__ void operator()(const f32x4 (&acc)[2][2][4][2], const Unit& u, int wr, int wc, int fr, int fq) const {
        using pg8::HALF;
        if (u.kind == 1) {
            bf16* VBT = (bf16*)(ws + WS_VBT);
#pragma unroll
            for (int bj = 0; bj < 2; ++bj) {
                int b, t; row_bt(256 * u.tb + HALF * bj + 32 * wc + 8 * fq, b, t);
#pragma unroll
                for (int ai = 0; ai < 2; ++ai)
#pragma unroll
                    for (int m = 0; m < 4; ++m) { const int vc = 256 * (u.ta - 3) + HALF * ai + 64 * wr + 16 * m + fr, h = vc >> 6, dv = vc & 63;
                        *(v4u*)(VBT + ((size_t)((b * NH + h) * 64 + dv)) * TK + t) = pack8(acc[ai][bj][m][0], acc[ai][bj][m][1]); }
            }
            return;
        }
        const int pn = u.tb;
        const float2* tab = (const float2*)(ws + WS_ROPE);
#pragma unroll
        for (int ai = 0; ai < 2; ++ai)
#pragma unroll
            for (int m = 0; m < 4; ++m) {
                const int row = 256 * u.ta + HALF * ai + 64 * wr + 16 * m + fr; int b, t; row_bt(row, b, t);
                float qq = 0.f;
#pragma unroll
                for (int bj = 0; bj < 2; ++bj) {
                    const int col = HALF * bj + 32 * wc + 8 * fq;
                    const f32x4 v0 = acc[ai][bj][m][0], v1 = acc[ai][bj][m][1];
                    if (pn == 0) {
                        *(v4u*)((bf16*)(ws + WS_T0) + (size_t)row * 256 + col) = pack8(v0, v1);
                        if (bj == 0) { float q = (v0[0] * v0[0] + v0[1] * v0[1]) + (v0[2] * v0[2] + v0[3] * v0[3]) + (v1[0] * v1[0] + v1[1] * v1[1]) + (v1[2] * v1[2] + v1[3] * v1[3]);
                            q += __shfl_xor(q, 16); q += __shfl_xor(q, 32); if (fq == 0) ((float*)(ws + WS_SSQKV))[row * 4 + wc] = q; }
                        else if (wc == 0) {
                            float v[8] = {v0[0], v0[1], v0[2], v0[3], v1[0], v1[1], v1[2], v1[3]};
                            if (u.ta < 64) rope8(v, fq, t, tab);
                            v4u w; w.x = cvt_pk_bf16(v[0], v[1]); w.y = cvt_pk_bf16(v[2], v[3]); w.z = cvt_pk_bf16(v[4], v[5]); w.w = cvt_pk_bf16(v[6], v[7]);
                            bf16* KA = (bf16*)(dout + DO_KA);
#pragma unroll
                            for (int h = 0; h < NH; ++h) *(v4u*)(KA + ((size_t)(b * NH + h) * TK + t) * 96 + 64 + 8 * fq) = w;
                        }
                    } else if (pn <= 2) {
                        const int kc = 256 * (pn - 1) + col, h = kc >> 6, d = kc & 63;
                        *(v4u*)((bf16*)(ws + WS_KB) + ((size_t)(b * NH + h) * TK + t) * 64 + d) = pack8(v0, v1);
                    } else if (pn == 5) {
                        *(v4u*)((bf16*)(ws + WS_CQ) + (size_t)row * 256 + col) = pack8(v0, v1);
                        qq += (v0[0] * v0[0] + v0[1] * v0[1]) + (v0[2] * v0[2] + v0[3] * v0[3]) + (v1[0] * v1[0] + v1[1] * v1[1]) + (v1[2] * v1[2] + v1[3] * v1[3]);
                    } else if (pn <= 7 || (pn >= 10 && pn <= 11)) {
                        bf16* dst = (bf16*)(ws + (pn <= 7 ? WS_SZA : WS_SZB)) + (size_t)row * 512 + 256 * (pn <= 7 ? pn - 6 : pn - 10) + col;
                        f32x4 a, c2;
#pragma unroll
                        for (int e = 0; e < 4; ++e) { a[e] = siluf_(v0[e]); c2[e] = siluf_(v1[e]); }
                        *(v4u*)dst = pack8(a, c2);
                    } else if (pn <= 9) {
                        const int qc = 256 * (pn - 8) + col, h = qc >> 6, d = qc & 63;
                        *(v4u*)((bf16*)(ws + WS_QB) + ((size_t)(b * NH + h) * SEQ + t) * 64 + d) = pack8(v0 * NA_C2, v1 * NA_C2);
                    } else {
                        bf16* dst = (bf16*)(ws + (pn <= 15 ? WS_SGA : WS_SGB)) + (size_t)row * 1024 + 256 * (pn <= 15 ? pn - 12 : pn - 16) + col;
                        f32x4 a, c2;
#pragma unroll
                        for (int e = 0; e < 4; ++e) { a[e] = sigmoidf_(v0[e]); c2[e] = sigmoidf_(v1[e]); }
                        *(v4u*)dst = pack8(a, c2);
                    }
                }
                if (pn == 5) { qq += __shfl_xor(qq, 16); qq += __shfl_xor(qq, 32); if (fq == 0) ((float*)(ws + WS_SSQQ))[row * 4 + wc] = qq; }
            }
    }
};

struct SchedG23 {
    int G, c; const char* wsb;
    static constexpr size_t TS = (size_t)256 * 256 * 2;
    __device__ __forceinline__ bool next(int i, Unit& u) const {
        const int L = i * G + c; if (L >= 464) return false;
        if (L < 192) { u.kind = 0; u.ta = L % 64; u.tb = L / 64; return true; }
        const int k = L - 192, pm = k % 68, pn = k / 68;
        if (pn < 2) { u.kind = 1; u.ta = pm; u.tb = pn; } else { u.kind = 2; u.ta = pn; u.tb = pm; }
        return true;
    }
    __device__ __forceinline__ const char* aptr(const Unit& u) const { const size_t o = (u.kind == 0) ? WS_CQ : (u.kind == 1) ? WS_T0 : WS_WUKV; return wsb + o + (size_t)u.ta * TS; }
    __device__ __forceinline__ const char* bptr(const Unit& u) const { const size_t o = (u.kind == 0) ? WS_WUQ : (u.kind == 1) ? WS_WUKV : WS_T0; return wsb + o + (size_t)u.tb * TS; }
};
struct EpiG23 {
    static constexpr bool PERM = true, AFTER_DRAIN = false;
    unsigned char* ws; unsigned char* dout;
    __device__ __forceinline__ void operator()(const f32x4 (&acc)[2][2][4][2], const Unit& u, int wr, int wc, int fr, int fq) const {
        using pg8::HALF;
        const float* SSQKV = (const float*)(ws + WS_SSQKV);
        if (u.kind == 2) {
            bf16* VAT = (bf16*)(dout + DO_VAT);
#pragma unroll
            for (int bj = 0; bj < 2; ++bj) {
                const int tok0 = 256 * u.tb + HALF * bj + 32 * wc + 8 * fq; int b, t; row_bt(tok0, b, t);
                float rs[8];
                { const f32x4 ss = *(const f32x4*)(SSQKV + (size_t)(tok0 + (fr & 7)) * 4); const float mine = 1.0f / sqrtf(((ss[0] + ss[1]) + (ss[2] + ss[3])) * (1.f / 128.f) + EPS);
#pragma unroll
                  for (int i = 0; i < 8; ++i) rs[i] = __shfl(mine, (fq << 4) + i); }
#pragma unroll
                for (int ai = 0; ai < 2; ++ai)
#pragma unroll
                    for (int m = 0; m < 4; ++m) { const int vc = 256 * (u.ta - 2) + HALF * ai + 64 * wr + 16 * m + fr, h = vc >> 6, dv = vc & 63;
                        f32x4 a = acc[ai][bj][m][0], c2 = acc[ai][bj][m][1];
#pragma unroll
                        for (int e = 0; e < 4; ++e) { a[e] *= rs[e]; c2[e] *= rs[4 + e]; }
                        *(v4u*)(VAT + ((size_t)((b * NH + h) * 64 + dv)) * TK + t) = pack8(a, c2); }
            }
            return;
        }
        const float2* tab = (const float2*)(ws + WS_ROPE);
#pragma unroll
        for (int ai = 0; ai < 2; ++ai)
#pragma unroll
            for (int m = 0; m < 4; ++m) {
                const int row = 256 * u.ta + HALF * ai + 64 * wr + 16 * m + fr; int b, t; row_bt(row, b, t);
                if (u.kind == 0) {
                    const f32x4 ss = *(const f32x4*)((const float*)(ws + WS_SSQQ) + (size_t)row * 4);
                    const float f = MLA_C2 / sqrtf(((ss[0] + ss[1]) + (ss[2] + ss[3])) * (1.f / 256.f) + EPS);
                    bf16* QA = (bf16*)(ws + WS_QA);
#pragma unroll
                    for (int bj = 0; bj < 2; ++bj) {
                        const f32x4 v0 = acc[ai][bj][m][0] * f, v1 = acc[ai][bj][m][1] * f;
                        if (u.tb < 2) { const int qc = 256 * u.tb + HALF * bj + 32 * wc + 8 * fq, h = qc >> 6, d = qc & 63;
                            *(v4u*)(QA + ((size_t)(b * NH + h) * SEQ + t) * 96 + d) = pack8(v0, v1);
                        } else { const int h = 4 * bj + wc;
                            float v[8] = {v0[0], v0[1], v0[2], v0[3], v1[0], v1[1], v1[2], v1[3]};
                            rope8(v, fq, t, tab);
                            v4u w; w.x = cvt_pk_bf16(v[0], v[1]); w.y = cvt_pk_bf16(v[2], v[3]); w.z = cvt_pk_bf16(v[4], v[5]); w.w = cvt_pk_bf16(v[6], v[7]);
                            *(v4u*)(QA + ((size_t)(b * NH + h) * SEQ + t) * 96 + 64 + 8 * fq) = w; }
                    }
                } else {
                    const f32x4 ss = *(const f32x4*)(SSQKV + (size_t)row * 4);
                    const float f = 1.0f / sqrtf(((ss[0] + ss[1]) + (ss[2] + ss[3])) * (1.f / 128.f) + EPS);
                    bf16* KA = (bf16*)(dout + DO_KA);
#pragma unroll
                    for (int bj = 0; bj < 2; ++bj) { const int kc = 256 * u.tb + HALF * bj + 32 * wc + 8 * fq, h = kc >> 6, d = kc & 63;
                        *(v4u*)(KA + ((size_t)(b * NH + h) * TK + t) * 96 + d) = pack8(acc[ai][bj][m][0] * f, acc[ai][bj][m][1] * f); }
                }
            }
    }
};

struct SchedG4 {
    int G, c; const char* OA; const char* OB; const char* WOA; const char* WOB;
    static constexpr size_t TS = (size_t)256 * 512 * 2;
    __device__ __forceinline__ bool next(int j, Unit& u) const {
        const int tile = c + (j >> 1) * G; if (tile >= 256) return false;
        tile_remap(tile, 64, 4, u.ta, u.tb); u.kind = j & 1; return true;
    }
    __device__ __forceinline__ const char* aptr(const Unit& u) const { return (u.kind ? OB : OA) + (size_t)u.ta * TS; }
    __device__ __forceinline__ const char* bptr(const Unit& u) const { return (u.kind ? WOB : WOA) + (size_t)u.tb * TS; }
};
struct EpiG4 {
    static constexpr bool PERM = true, AFTER_DRAIN = false;
    unsigned char* ws; float* scratch;
    __device__ __forceinline__ void operator()(const f32x4 (&acc)[2][2][4][2], const Unit& u, int wr, int wc, int fr, int fq) const {
        using pg8::HALF;
        const bf16* SG = (const bf16*)(ws + (u.kind ? WS_SGB : WS_SGA));
        bf16* Mb = (bf16*)(ws + WS_M);
#pragma unroll
        for (int ai = 0; ai < 2; ++ai) {
            v4u g[4][2], t1[4][2];
#pragma unroll
            for (int m = 0; m < 4; ++m)
#pragma unroll
                for (int bj = 0; bj < 2; ++bj) {
                    const size_t off = (size_t)(256 * u.ta + HALF * ai + 64 * wr + 16 * m + fr) * 1024 + 256 * u.tb + HALF * bj + 32 * wc + 8 * fq;
                    g[m][bj] = *(const v4u*)(SG + off);
                    if (u.kind) t1[m][bj] = *(const v4u*)(Mb + off); else t1[m][bj] = (v4u){0u, 0u, 0u, 0u};
                }
#pragma unroll
            for (int m = 0; m < 4; ++m)
#pragma unroll
                for (int bj = 0; bj < 2; ++bj) {
                    const size_t off = (size_t)(256 * u.ta + HALF * ai + 64 * wr + 16 * m + fr) * 1024 + 256 * u.tb + HALF * bj + 32 * wc + 8 * fq;
                    const v4u gg = g[m][bj], tt = t1[m][bj];
                    f32x4 v0 = acc[ai][bj][m][0], v1 = acc[ai][bj][m][1];
                    v0[0] = v0[0] * bf_lo(gg.x) + bf_lo(tt.x); v0[1] = v0[1] * bf_hi(gg.x) + bf_hi(tt.x); v0[2] = v0[2] * bf_lo(gg.y) + bf_lo(tt.y); v0[3] = v0[3] * bf_hi(gg.y) + bf_hi(tt.y);
                    v1[0] = v1[0] * bf_lo(gg.z) + bf_lo(tt.z); v1[1] = v1[1] * bf_hi(gg.z) + bf_hi(tt.z); v1[2] = v1[2] * bf_lo(gg.w) + bf_lo(tt.w); v1[3] = v1[3] * bf_hi(gg.w) + bf_hi(tt.w);
                    *(v4u*)(Mb + off) = pack8(v0, v1);
                }
        }
    }
};

struct SchedG5 {
    int G, c; const char* M; const char* W;
    static constexpr size_t TS = (size_t)256 * 1024 * 2;
    __device__ __forceinline__ bool next(int i, Unit& u) const { const int L = i * G + c; if (L >= 256) return false; tile_remap(L, 64, 4, u.ta, u.tb); u.kind = 0; return true; }
    __device__ __forceinline__ const char* aptr(const Unit& u) const { return M + (size_t)u.ta * TS; }
    __device__ __forceinline__ const char* bptr(const Unit& u) const { return W + (size_t)u.tb * TS; }
};
struct EpiG5 {
    static constexpr bool PERM = true, AFTER_DRAIN = false;
    unsigned char* ws; const float* x; float* out;
    __device__ __forceinline__ void operator()(const f32x4 (&acc)[2][2][4][2], const Unit& u, int wr, int wc, int fr, int fq) const {
        using pg8::HALF;
        const float* MOD = (const float*)(ws + WS_MOD) + ((256 * u.ta) >> 12) * 3072 + 2048;
        f32x4 gt[2][2];
#pragma unroll
        for (int bj = 0; bj < 2; ++bj) { const int col = 256 * u.tb + HALF * bj + 32 * wc + 8 * fq; gt[bj][0] = *(const f32x4*)(MOD + col); gt[bj][1] = *(const f32x4*)(MOD + col + 4); }
#pragma unroll
        for (int ai = 0; ai < 2; ++ai) {
            f32x4 xa[4][2][2];
#pragma unroll
            for (int m = 0; m < 4; ++m)
#pragma unroll
                for (int bj = 0; bj < 2; ++bj) {
                    const size_t off = (size_t)(256 * u.ta + HALF * ai + 64 * wr + 16 * m + fr) * 1024 + 256 * u.tb + HALF * bj + 32 * wc + 8 * fq;
                    xa[m][bj][0] = *(const f32x4*)(x + off); xa[m][bj][1] = *(const f32x4*)(x + off + 4);
                }
#pragma unroll
            for (int m = 0; m < 4; ++m) {
                const int row = 256 * u.ta + HALF * ai + 64 * wr + 16 * m + fr;
                float q = 0.f;
#pragma unroll
                for (int bj = 0; bj < 2; ++bj) {
                    const size_t off = (size_t)row * 1024 + 256 * u.tb + HALF * bj + 32 * wc + 8 * fq;
                    const f32x4 o0 = xa[m][bj][0] + gt[bj][0] * acc[ai][bj][m][0], o1 = xa[m][bj][1] + gt[bj][1] * acc[ai][bj][m][1];
                    *(f32x4*)(out + off) = o0; *(f32x4*)(out + off + 4) = o1;
                    q += (o0[0] * o0[0] + o0[1] * o0[1]) + (o0[2] * o0[2] + o0[3] * o0[3]) + (o1[0] * o1[0] + o1[1] * o1[1]) + (o1[2] * o1[2] + o1[3] * o1[3]);
                }
                q += __shfl_xor(q, 16); q += __shfl_xor(q, 32);
                if (fq == 0) ((float*)(ws + WS_SSQO))[(size_t)row * 16 + u.tb * 4 + wc] = q;
            }
        }
    }
};

constexpr int CW_PANEL = 8192;
struct EpiG5F {
    static constexpr bool PERM = true, AFTER_DRAIN = true;
    unsigned char* ws; const float* x; float* out; const float* final_g;
    __device__ __forceinline__ void operator()(const f32x4 (&)[2][2][4][2], const Unit&, int, int, int, int) const {}
    __device__ __forceinline__ void fused(f32x4 (&acc)[2][2][4][2], const Unit& u, int wr, int wc, int fr, int fq, LAS unsigned char* lds, int wid, int lane) const {
        using pg8::HALF;
        const float* MOD = (const float*)(ws + WS_MOD) + ((256 * u.ta) >> 12) * 3072 + 2048;
        LAS float* Pq = (LAS float*)lds;
        LAS float* Sr = (LAS float*)(lds + 4096);
        float* slots = (float*)(ws + WS_SSQO);
        unsigned* cnt = (unsigned*)(ws + WS_CTL) + CW_PANEL + 64 * u.ta;
        f32x4 gt[2][2];
#pragma unroll
        for (int bj = 0; bj < 2; ++bj) { const int col = 256 * u.tb + HALF * bj + 32 * wc + 8 * fq; gt[bj][0] = *(const f32x4*)(MOD + col); gt[bj][1] = *(const f32x4*)(MOD + col + 4); }
#pragma unroll
        for (int ai = 0; ai < 2; ++ai) {
            f32x4 xa[4][2][2];
#pragma unroll
            for (int m = 0; m < 4; ++m)
#pragma unroll
                for (int bj = 0; bj < 2; ++bj) {
                    const size_t off = (size_t)(256 * u.ta + HALF * ai + 64 * wr + 16 * m + fr) * 1024 + 256 * u.tb + HALF * bj + 32 * wc + 8 * fq;
                    xa[m][bj][0] = *(const f32x4*)(x + off); xa[m][bj][1] = *(const f32x4*)(x + off + 4);
                }
#pragma unroll
            for (int m = 0; m < 4; ++m) {
                float q = 0.f;
#pragma unroll
                for (int bj = 0; bj < 2; ++bj) {
                    const f32x4 o0 = xa[m][bj][0] + gt[bj][0] * acc[ai][bj][m][0], o1 = xa[m][bj][1] + gt[bj][1] * acc[ai][bj][m][1];
                    acc[ai][bj][m][0] = o0; acc[ai][bj][m][1] = o1;
                    q += (o0[0] * o0[0] + o0[1] * o0[1]) + (o0[2] * o0[2] + o0[3] * o0[3]) + (o1[0] * o1[0] + o1[1] * o1[1]) + (o1[2] * o1[2] + o1[3] * o1[3]);
                }
                q += __shfl_xor(q, 16); q += __shfl_xor(q, 32);
                if (fq == 0) Pq[(HALF * ai + 64 * wr + 16 * m + fr) * 4 + wc] = q;
            }
        }
        asm volatile("s_waitcnt lgkmcnt(0)" ::: "memory"); __builtin_amdgcn_s_barrier(); asm volatile("" ::: "memory");
        const int row = wid * 32 + (lane & 31);
        if (lane < 32) { const float t = (Pq[row * 4 + 0] + Pq[row * 4 + 1]) + (Pq[row * 4 + 2] + Pq[row * 4 + 3]);
            __hip_atomic_store(slots + (size_t)(256 * u.ta + row) * 16 + 4 * u.tb, t, __ATOMIC_RELAXED, __HIP_MEMORY_SCOPE_AGENT); }
        asm volatile("s_waitcnt vmcnt(0)" ::: "memory");
        if (lane == 0) __hip_atomic_fetch_add(cnt, 1u, __ATOMIC_RELAXED, __HIP_MEMORY_SCOPE_AGENT);
        if (wid == 0) {
            unsigned spins = 0;
            while ((unsigned)__builtin_amdgcn_readfirstlane(__hip_atomic_load(cnt, __ATOMIC_RELAXED, __HIP_MEMORY_SCOPE_AGENT)) < 32u) { __builtin_amdgcn_s_sleep(2); if (++spins > (1u << 22)) break; }
            __builtin_amdgcn_fence(__ATOMIC_ACQUIRE, "agent");
        }
        asm volatile("s_waitcnt vmcnt(0) lgkmcnt(0)" ::: "memory"); __builtin_amdgcn_s_barrier(); asm volatile("" ::: "memory");
        if (lane < 32) { const float* sl = slots + (size_t)(256 * u.ta + row) * 16; float t = 0.f;
#pragma unroll
            for (int k = 0; k < 4; ++k) t += __hip_atomic_load(sl + 4 * k, __ATOMIC_RELAXED, __HIP_MEMORY_SCOPE_AGENT);
            Sr[row] = 1.0f / sqrtf(t * (1.f / DM) + EPS); }
        asm volatile("s_waitcnt vmcnt(0) lgkmcnt(0)" ::: "memory"); __builtin_amdgcn_s_barrier(); asm volatile("" ::: "memory");
        f32x4 fg[2][2];
#pragma unroll
        for (int bj = 0; bj < 2; ++bj) { const int col = 256 * u.tb + HALF * bj + 32 * wc + 8 * fq; fg[bj][0] = *(const f32x4*)(final_g + col); fg[bj][1] = *(const f32x4*)(final_g + col + 4); }
#pragma unroll
        for (int ai = 0; ai < 2; ++ai)
#pragma unroll
            for (int m = 0; m < 4; ++m) { const int r = HALF * ai + 64 * wr + 16 * m + fr; const float rs = Sr[r];
#pragma unroll
                for (int bj = 0; bj < 2; ++bj) { const size_t off = (size_t)(256 * u.ta + r) * 1024 + 256 * u.tb + HALF * bj + 32 * wc + 8 * fq;
                    *(f32x4*)(out + off) = acc[ai][bj][m][0] * rs * fg[bj][0]; *(f32x4*)(out + off + 4) = acc[ai][bj][m][1] * rs * fg[bj][1]; } }
    }
};

__device__ __forceinline__ void p7_final(const Ptrs& P, int lane, int wave, int G) {
    const int gw = blockIdx.x * NWAVES + wave, NGW = G * NWAVES;
    const float* SSQO = (const float*)(P.ws + WS_SSQO);
    for (int row = gw; row < MLAT; row += NGW) {
        float s = 0.f;
        { const f32x4* p = (const f32x4*)(SSQO + (size_t)row * 16); const f32x4 a = p[0], b = p[1], c = p[2], d = p[3];
          s = ((a[0] + a[1]) + (a[2] + a[3])) + ((b[0] + b[1]) + (b[2] + b[3])) + ((c[0] + c[1]) + (c[2] + c[3])) + ((d[0] + d[1]) + (d[2] + d[3])); }
        const float rstd = 1.0f / sqrtf(s * (1.f / DM) + EPS);
        f32x4* o4 = (f32x4*)(P.out + (size_t)row * DM) + lane;
        const f32x4* g4 = (const f32x4*)P.final_g + lane;
#pragma unroll
        for (int j = 0; j < 4; ++j) { f32x4 v = o4[64 * j]; const f32x4 g = g4[64 * j]; v = v * rstd * g; o4[64 * j] = v; }
    }
}

__device__ __forceinline__ int crow(int r, int hi) { return (r & 3) + 8 * (r >> 2) + 4 * hi; }
constexpr int VROW = 136;
constexpr int ATT_RPB_OFF = 96 * 1024;

template <int DK, bool NA>
__device__ __forceinline__ void attn_unit(LAS unsigned char* lds, const bf16* Qg, const bf16* Kg, const bf16* Vtg, bf16* SZ, const float* rpb, int b, int h, int qblk, int tid, int lane, int wave) {
    constexpr int KROW = DK * 2 + 16, KCH = DK / 8  , NKC = 64 * KCH, KT_BYTES = 64 * KROW, VT_BYTES = 64 * VROW, BUF = KT_BYTES + VT_BYTES;
    const int r32 = lane & 31, hi = lane >> 5;
    const int q0 = qblk * 256;
    const bf16* Kh = Kg + (size_t)(b * NH + h) * TK * DK;
    const bf16* Vh = Vtg + (size_t)(b * NH + h) * 64 * TK;
    int ntiles, kr_lo = 0, nwin = 0, rq = 0, cq = 0, rs = 0, cs = 0;
    if (NA) { const int r0 = qblk * 4; auto rst = [](int r) { int s = r - 4; s = s < 0 ? 0 : s; return s > 56 ? 56 : s; };
        kr_lo = rst(r0); nwin = rst(r0 + 3) + 8 - kr_lo; ntiles = nwin + 4;
        rq = r0 + (wave >> 1); cq = 32 * (wave & 1) + r32; rs = rst(rq); cs = cq - 8; cs = cs < 0 ? 0 : cs; cs = cs > 48 ? 48 : cs;
        LAS float* bt = (LAS float*)(lds + ATT_RPB_OFF);
        for (int i = tid; i < 15 * 31; i += 512) bt[i] = rpb[h * 465 + i] * LOG2E;
    } else ntiles = TK / 64;
    bf16x8 qf[DK / 16];
    { const bf16* qp = Qg + ((size_t)(b * NH + h) * SEQ + q0 + 32 * wave + r32) * DK + 8 * hi;
#pragma unroll
      for (int s = 0; s < DK / 16; ++s) qf[s] = *(const bf16x8*)(qp + 16 * s); }
    auto tile_tok = [&](int j) -> int { if (NA) return j < nwin ? (kr_lo + j) * 64 : SEQ + (j - nwin) * 64; return j * 64; };
    v4u kreg0, kreg1, vreg;
    const int kc0 = tid, kc1 = tid + 512;
    auto gload = [&](int j) { const int tok = tile_tok(j);
        const unsigned char* kb = (const unsigned char*)(Kh + (size_t)tok * DK);
        kreg0 = *(const v4u*)(kb + (size_t)kc0 * 16);
        if (kc1 < NKC) kreg1 = *(const v4u*)(kb + (size_t)kc1 * 16);
        vreg = *(const v4u*)((const unsigned char*)(Vh + (size_t)(tid >> 3) * TK + tok) + (tid & 7) * 16); };
    auto lstore = [&](int buf) { LAS unsigned char* base = lds + buf * BUF;
        *(LAS v4u*)(base + (kc0 / KCH) * KROW + (kc0 % KCH) * 16) = kreg0;
        if (kc1 < NKC) *(LAS v4u*)(base + (kc1 / KCH) * KROW + (kc1 % KCH) * 16) = kreg1;
        LAS unsigned char* vp = base + KT_BYTES + (tid >> 3) * VROW + (tid & 7) * 16;
        *(LAS v2u*)vp = (v2u){vreg.x, vreg.y}; *(LAS v2u*)(vp + 8) = (v2u){vreg.z, vreg.w}; };
    float m_run = -1e30f, l_run = 0.f;
    f32x16 o0 = {}, o1 = {};
    gload(0); lstore(0); __syncthreads();
    for (int j = 0; j < ntiles; ++j) {
        const bool more = (j + 1 < ntiles);
        if (more) gload(j + 1);
        bool active = true; int krow = 0;
        if (NA && j < nwin) { krow = kr_lo + j; active = (krow >= rs && krow < rs + 8); }
        if (active) {
            const LAS unsigned char* kb = lds + (j & 1) * BUF;
            const LAS unsigned char* vb = kb + KT_BYTES;
            f32x16 s0 = {}, s1 = {};
#pragma unroll
            for (int s = 0; s < DK / 16; ++s) {
                const bf16x8 k0 = *(const LAS bf16x8*)(kb + r32 * KROW + (16 * s + 8 * hi) * 2);
                const bf16x8 k1 = *(const LAS bf16x8*)(kb + (32 + r32) * KROW + (16 * s + 8 * hi) * 2);
                s0 = __builtin_amdgcn_mfma_f32_32x32x16_bf16(k0, qf[s], s0, 0, 0, 0);
                s1 = __builtin_amdgcn_mfma_f32_32x32x16_bf16(k1, qf[s], s1, 0, 0, 0);
            }
            if (NA && j < nwin) {
                const LAS float* bt = (const LAS float*)(lds + ATT_RPB_OFF) + (krow - rq + 7) * 31 + (15 - cq);
#pragma unroll
                for (int i = 0; i < 16; ++i) {
                    const int kc = crow(i, hi);
                    { const bool ok = (unsigned)(kc - cs) < 16u; const float bv = bt[ok ? kc : cq]; s0[i] = ok ? s0[i] + bv : -1e30f; }
                    { const int kc2 = kc + 32; const bool ok = (unsigned)(kc2 - cs) < 16u; const float bv = bt[ok ? kc2 : cq]; s1[i] = ok ? s1[i] + bv : -1e30f; }
                }
            }
            float mx = fmaxf(s0[0], s1[0]);
#pragma unroll
            for (int i = 1; i < 16; ++i) mx = fmaxf(mx, fmaxf(s0[i], s1[i]));
            mx = fmaxf(mx, __shfl_xor(mx, 32));
            if (__any(mx > m_run + 4.0f)) {
                const float mnew = fmaxf(m_run, mx);
                const float alpha = __builtin_amdgcn_exp2f(m_run - mnew);
                m_run = mnew; l_run *= alpha;
#pragma unroll
                for (int i = 0; i < 16; ++i) { o0[i] *= alpha; o1[i] *= alpha; }
            }
            float ls = 0.f;
#pragma unroll
            for (int i = 0; i < 16; ++i) { s0[i] = __builtin_amdgcn_exp2f(s0[i] - m_run); s1[i] = __builtin_amdgcn_exp2f(s1[i] - m_run); ls += s0[i] + s1[i]; }
            l_run += ls;
            bf16x8 pb[2][2];
#pragma unroll
            for (int kk = 0; kk < 2; ++kk) {
                v4u w0, w1;
                w0.x = cvt_pk_bf16(s0[8 * kk + 0], s0[8 * kk + 1]); w0.y = cvt_pk_bf16(s0[8 * kk + 2], s0[8 * kk + 3]); w0.z = cvt_pk_bf16(s0[8 * kk + 4], s0[8 * kk + 5]); w0.w = cvt_pk_bf16(s0[8 * kk + 6], s0[8 * kk + 7]);
                w1.x = cvt_pk_bf16(s1[8 * kk + 0], s1[8 * kk + 1]); w1.y = cvt_pk_bf16(s1[8 * kk + 2], s1[8 * kk + 3]); w1.z = cvt_pk_bf16(s1[8 * kk + 4], s1[8 * kk + 5]); w1.w = cvt_pk_bf16(s1[8 * kk + 6], s1[8 * kk + 7]);
                pb[0][kk] = __builtin_bit_cast(bf16x8, w0); pb[1][kk] = __builtin_bit_cast(bf16x8, w1);
            }
#pragma unroll
            for (int u = 0; u < 2; ++u)
#pragma unroll
                for (int kk = 0; kk < 2; ++kk) {
                    const int koff = (32 * u + 16 * kk + 4 * hi) * 2;
                    const LAS unsigned char* v0p = vb + r32 * VROW + koff;
                    const LAS unsigned char* v1p = vb + (32 + r32) * VROW + koff;
                    const s16x4 a0 = *(const LAS s16x4*)v0p, a1 = *(const LAS s16x4*)(v0p + 16);
                    const s16x4 c0 = *(const LAS s16x4*)v1p, c1 = *(const LAS s16x4*)(v1p + 16);
                    const bf16x8 vf0 = {a0[0], a0[1], a0[2], a0[3], a1[0], a1[1], a1[2], a1[3]};
                    const bf16x8 vf1 = {c0[0], c0[1], c0[2], c0[3], c1[0], c1[1], c1[2], c1[3]};
                    o0 = __builtin_amdgcn_mfma_f32_32x32x16_bf16(vf0, pb[u][kk], o0, 0, 0, 0);
                    o1 = __builtin_amdgcn_mfma_f32_32x32x16_bf16(vf1, pb[u][kk], o1, 0, 0, 0);
                }
        }
        if (more) lstore((j + 1) & 1);
        __syncthreads();
    }
    const float lt = l_run + __shfl_xor(l_run, 32);
    const float inv = 1.0f / lt;
    bf16* zp = SZ + ((size_t)(b * SEQ + q0 + 32 * wave + r32)) * 512 + h * 64;
#pragma unroll
    for (int dt = 0; dt < 2; ++dt)
#pragma unroll
        for (int g = 0; g < 4; ++g) {
            bf16* p = zp + 32 * dt + 8 * g + 4 * hi;
            const v2u z = *(const v2u*)p;
            const f32x16& o = dt ? o1 : o0;
            v2u w; w.x = cvt_pk_bf16(o[4 * g + 0] * inv * bf_lo(z.x), o[4 * g + 1] * inv * bf_hi(z.x)); w.y = cvt_pk_bf16(o[4 * g + 2] * inv * bf_lo(z.y), o[4 * g + 3] * inv * bf_hi(z.y));
            *(v2u*)p = w;
        }
}


__device__ __forceinline__ void attn_unit_na2(LAS unsigned char* lds, const bf16* Qg, const bf16* Kg, const bf16* Vtg, bf16* SZ, const float* rpb, int b, int h, int qblk, int tid, int lane, int wave) {
    constexpr int DK = 64; constexpr bool NA = true;
    constexpr int KROW = DK * 2 + 16, KCH = DK / 8  , NKC = 64 * KCH, KT_BYTES = 64 * KROW, VT_BYTES = 64 * VROW, SUB = KT_BYTES + VT_BYTES, BUF = 2 * SUB;
    const int r32 = lane & 31, hi = lane >> 5;
    const int q0 = qblk * 256;
    const bf16* Kh = Kg + (size_t)(b * NH + h) * TK * DK;
    const bf16* Vh = Vtg + (size_t)(b * NH + h) * 64 * TK;
    int ntiles, kr_lo = 0, nwin = 0, rq = 0, cq = 0, rs = 0, cs = 0;
    unsigned vmask0 = 0u, vmask1 = 0u;
    if (NA) { const int r0 = qblk * 4; auto rst = [](int r) { int s = r - 4; s = s < 0 ? 0 : s; return s > 56 ? 56 : s; };
        kr_lo = rst(r0); nwin = rst(r0 + 3) + 8 - kr_lo; ntiles = nwin + 4;
        rq = r0 + (wave >> 1); cq = 32 * (wave & 1) + r32; rs = rst(rq); cs = cq - 8; cs = cs < 0 ? 0 : cs; cs = cs > 48 ? 48 : cs;
        for (int i = 0; i < 16; ++i) { const int kc = crow(i, hi); vmask0 |= ((unsigned)(kc - cs) < 16u ? 1u : 0u) << i; vmask1 |= ((unsigned)(kc + 32 - cs) < 16u ? 1u : 0u) << i; }
        LAS float* bt = (LAS float*)(lds + ATT_RPB_OFF);
        for (int i = tid; i < 15 * 31; i += 512) bt[i] = rpb[h * 465 + i] * LOG2E;
    } else ntiles = TK / 64;
    bf16x8 qf[DK / 16];
    { const bf16* qp = Qg + ((size_t)(b * NH + h) * SEQ + q0 + 32 * wave + r32) * DK + 8 * hi;
#pragma unroll
      for (int s = 0; s < DK / 16; ++s) qf[s] = *(const bf16x8*)(qp + 16 * s); }
    auto tile_tok = [&](int j) -> int { if (NA) return j < nwin ? (kr_lo + j) * 64 : SEQ + (j - nwin) * 64; return j * 64; };
    v4u kreg[2], vreg[2];
    const int kc0 = tid;
    auto gload = [&](int jp) {
#pragma unroll
        for (int sub = 0; sub < 2; ++sub) { const int j = 2 * jp + sub; if (j < ntiles) { const int tok = tile_tok(j);
            kreg[sub] = *(const v4u*)((const unsigned char*)(Kh + (size_t)tok * DK) + (size_t)kc0 * 16);
            vreg[sub] = *(const v4u*)((const unsigned char*)(Vh + (size_t)(tid >> 3) * TK + tok) + (tid & 7) * 16); } } };
    auto lstore = [&](int buf, int jp) {
#pragma unroll
        for (int sub = 0; sub < 2; ++sub) { if (2 * jp + sub < ntiles) { LAS unsigned char* base = lds + buf * BUF + sub * SUB;
            *(LAS v4u*)(base + (kc0 / KCH) * KROW + (kc0 % KCH) * 16) = kreg[sub];
            LAS unsigned char* vp = base + KT_BYTES + (tid >> 3) * VROW + (tid & 7) * 16;
            *(LAS v2u*)vp = (v2u){vreg[sub].x, vreg[sub].y}; *(LAS v2u*)(vp + 8) = (v2u){vreg[sub].z, vreg[sub].w}; } } };
    float m_run = 0.f, l_run = 0.f; bool started = false;
    f32x16 o0 = {}, o1 = {};
    const int npairs = (ntiles + 1) >> 1;
    gload(0); lstore(0, 0); __syncthreads();
    for (int jp = 0; jp < npairs; ++jp) {
        const bool more = (jp + 1 < npairs);
        if (more) gload(jp + 1);
#pragma unroll
        for (int sub = 0; sub < 2; ++sub) {
        const int j = 2 * jp + sub;
        bool active = (j < ntiles); int krow = 0;
        if (NA && j < nwin) { krow = kr_lo + j; active = (krow >= rs && krow < rs + 8); }
        if (active) {
            const LAS unsigned char* kb = lds + (jp & 1) * BUF + sub * SUB;
            const LAS unsigned char* vb = kb + KT_BYTES;
            f32x16 s0, s1, negm;
#pragma unroll
            for (int i = 0; i < 16; ++i) negm[i] = -m_run;
#pragma unroll
            for (int s = 0; s < DK / 16; ++s) {
                const bf16x8 k0 = *(const LAS bf16x8*)(kb + r32 * KROW + (16 * s + 8 * hi) * 2);
                const bf16x8 k1 = *(const LAS bf16x8*)(kb + (32 + r32) * KROW + (16 * s + 8 * hi) * 2);
                s0 = __builtin_amdgcn_mfma_f32_32x32x16_bf16(k0, qf[s], s == 0 ? negm : s0, 0, 0, 0);
                s1 = __builtin_amdgcn_mfma_f32_32x32x16_bf16(k1, qf[s], s == 0 ? negm : s1, 0, 0, 0);
            }
            if (NA && j < nwin) {
                const LAS float* bt = (const LAS float*)(lds + ATT_RPB_OFF) + (krow - rq + 7) * 31 + (15 - cq);
#pragma unroll
                for (int i = 0; i < 16; ++i) {
                    const LAS float* bp = bt + 4 * hi;
                    const int kci = (i & 3) + 8 * (i >> 2);
                    { const float bv = bp[kci]; s0[i] = ((vmask0 >> i) & 1u) ? s0[i] + bv : -1e30f; }
                    { const float bv = bp[kci + 32]; s1[i] = ((vmask1 >> i) & 1u) ? s1[i] + bv : -1e30f; }
                }
            }
            float mx = fmaxf(s0[0], s1[0]);
#pragma unroll
            for (int i = 1; i < 16; ++i) mx = fmaxf(mx, fmaxf(s0[i], s1[i]));
            mx = fmaxf(mx, __shfl_xor(mx, 32));
            if (!started || __any(mx > 4.0f)) {
                const float d = started ? fmaxf(mx, 0.f) : mx;
                const float alpha = started ? __builtin_amdgcn_exp2f(-d) : 0.f;
                m_run += d; l_run *= alpha; started = true;
#pragma unroll
                for (int i = 0; i < 16; ++i) { o0[i] *= alpha; o1[i] *= alpha; s0[i] -= d; s1[i] -= d; }
            }
            float ls = 0.f;
#pragma unroll
            for (int i = 0; i < 16; ++i) { s0[i] = __builtin_amdgcn_exp2f(s0[i]); s1[i] = __builtin_amdgcn_exp2f(s1[i]); ls += s0[i] + s1[i]; }
            l_run += ls;
            bf16x8 pb[2][2];
#pragma unroll
            for (int kk = 0; kk < 2; ++kk) {
                v4u w0, w1;
                w0.x = cvt_pk_bf16(s0[8 * kk + 0], s0[8 * kk + 1]); w0.y = cvt_pk_bf16(s0[8 * kk + 2], s0[8 * kk + 3]); w0.z = cvt_pk_bf16(s0[8 * kk + 4], s0[8 * kk + 5]); w0.w = cvt_pk_bf16(s0[8 * kk + 6], s0[8 * kk + 7]);
                w1.x = cvt_pk_bf16(s1[8 * kk + 0], s1[8 * kk + 1]); w1.y = cvt_pk_bf16(s1[8 * kk + 2], s1[8 * kk + 3]); w1.z = cvt_pk_bf16(s1[8 * kk + 4], s1[8 * kk + 5]); w1.w = cvt_pk_bf16(s1[8 * kk + 6], s1[8 * kk + 7]);
                pb[0][kk] = __builtin_bit_cast(bf16x8, w0); pb[1][kk] = __builtin_bit_cast(bf16x8, w1);
            }
#pragma unroll
            for (int u = 0; u < 2; ++u)
#pragma unroll
                for (int kk = 0; kk < 2; ++kk) {
                    const int koff = (32 * u + 16 * kk + 4 * hi) * 2;
                    const LAS unsigned char* v0p = vb + r32 * VROW + koff;
                    const LAS unsigned char* v1p = vb + (32 + r32) * VROW + koff;
                    const s16x4 a0 = *(const LAS s16x4*)v0p, a1 = *(const LAS s16x4*)(v0p + 16);
                    const s16x4 c0 = *(const LAS s16x4*)v1p, c1 = *(const LAS s16x4*)(v1p + 16);
                    const bf16x8 vf0 = {a0[0], a0[1], a0[2], a0[3], a1[0], a1[1], a1[2], a1[3]};
                    const bf16x8 vf1 = {c0[0], c0[1], c0[2], c0[3], c1[0], c1[1], c1[2], c1[3]};
                    o0 = __builtin_amdgcn_mfma_f32_32x32x16_bf16(vf0, pb[u][kk], o0, 0, 0, 0);
                    o1 = __builtin_amdgcn_mfma_f32_32x32x16_bf16(vf1, pb[u][kk], o1, 0, 0, 0);
                }
        }
        }
        if (more) lstore((jp + 1) & 1, jp + 1);
        __syncthreads();
    }
    const float lt = l_run + __shfl_xor(l_run, 32);
    const float inv = 1.0f / lt;
    bf16* zp = SZ + ((size_t)(b * SEQ + q0 + 32 * wave + r32)) * 512 + h * 64;
#pragma unroll
    for (int dt = 0; dt < 2; ++dt)
#pragma unroll
        for (int g = 0; g < 4; ++g) {
            bf16* p = zp + 32 * dt + 8 * g + 4 * hi;
            const v2u z = *(const v2u*)p;
            const f32x16& o = dt ? o1 : o0;
            v2u w; w.x = cvt_pk_bf16(o[4 * g + 0] * inv * bf_lo(z.x), o[4 * g + 1] * inv * bf_hi(z.x)); w.y = cvt_pk_bf16(o[4 * g + 2] * inv * bf_lo(z.y), o[4 * g + 3] * inv * bf_hi(z.y));
            *(v2u*)p = w;
        }
}


__device__ __forceinline__ void attn_unit_mla2(LAS unsigned char* lds, const bf16* Qg, const bf16* Kg, const bf16* Vtg, bf16* SZ, int b, int h, int qblk, int tid, int lane, int wave) {
    constexpr int DK = 96, KROW = DK * 2 + 16, KCH = DK / 8, NKC = 64 * KCH, KT_BYTES = 64 * KROW, VT_BYTES = 64 * VROW, SUB = KT_BYTES + VT_BYTES, BUF = 2 * SUB;
    const int r32 = lane & 31, hi = lane >> 5;
    const int q0 = qblk * 256;
    const bf16* Kh = Kg + (size_t)(b * NH + h) * TK * DK;
    const bf16* Vh = Vtg + (size_t)(b * NH + h) * 64 * TK;
    constexpr int ntiles = TK / 128;
    bf16x8 qf[DK / 16];
    { const bf16* qp = Qg + ((size_t)(b * NH + h) * SEQ + q0 + 32 * wave + r32) * DK + 8 * hi;
#pragma unroll
      for (int s = 0; s < DK / 16; ++s) qf[s] = *(const bf16x8*)(qp + 16 * s); }
    v4u kreg[2][2], vreg[2];
    const int kc0 = tid, kc1 = tid + 512;
    auto gload = [&](int j) {
#pragma unroll
        for (int sub = 0; sub < 2; ++sub) { const int tok = j * 128 + 64 * sub;
            const unsigned char* kb = (const unsigned char*)(Kh + (size_t)tok * DK);
            kreg[sub][0] = *(const v4u*)(kb + (size_t)kc0 * 16);
            if (kc1 < NKC) kreg[sub][1] = *(const v4u*)(kb + (size_t)kc1 * 16);
            vreg[sub] = *(const v4u*)((const unsigned char*)(Vh + (size_t)(tid >> 3) * TK + tok) + (tid & 7) * 16); } };
    auto lstore = [&](int buf) {
#pragma unroll
        for (int sub = 0; sub < 2; ++sub) { LAS unsigned char* base = lds + buf * BUF + sub * SUB;
            *(LAS v4u*)(base + (kc0 / KCH) * KROW + (kc0 % KCH) * 16) = kreg[sub][0];
            if (kc1 < NKC) *(LAS v4u*)(base + (kc1 / KCH) * KROW + (kc1 % KCH) * 16) = kreg[sub][1];
            LAS unsigned char* vp = base + KT_BYTES + (tid >> 3) * VROW + (tid & 7) * 16;
            *(LAS v2u*)vp = (v2u){vreg[sub].x, vreg[sub].y}; *(LAS v2u*)(vp + 8) = (v2u){vreg[sub].z, vreg[sub].w}; } };
    float m_run = 0.f, l_run = 0.f;
    f32x16 o0 = {}, o1 = {};
    gload(0); lstore(0); __syncthreads();
    for (int j = 0; j < ntiles; ++j) {
        const bool more = (j + 1 < ntiles);
        if (more) gload(j + 1);
        const LAS unsigned char* tb = lds + (j & 1) * BUF;
        f32x16 s[2][2];
        f32x16 negm;
#pragma unroll
        for (int i = 0; i < 16; ++i) negm[i] = -m_run;
        const LAS unsigned char* kp0 = tb + r32 * KROW + 16 * hi;
        const LAS unsigned char* vp0 = tb + KT_BYTES + r32 * VROW + 8 * hi;
#define KFRAG(sub, u, st) (*(const LAS bf16x8*)(kp0 + (sub) * SUB + (u) * 32 * KROW + (st) * 32))
        bf16x8 ka[DK / 16][2], kb2[DK / 16][2];
#pragma unroll
        for (int st = 0; st < DK / 16; ++st) { ka[st][0] = KFRAG(0, 0, st); ka[st][1] = KFRAG(0, 1, st); }
        __builtin_amdgcn_sched_barrier(0);
#pragma unroll
        for (int st = 0; st < DK / 16; ++st) {
            kb2[st][0] = KFRAG(1, 0, st); kb2[st][1] = KFRAG(1, 1, st);
            s[0][0] = __builtin_amdgcn_mfma_f32_32x32x16_bf16(ka[st][0], qf[st], st == 0 ? negm : s[0][0], 0, 0, 0);
            s[0][1] = __builtin_amdgcn_mfma_f32_32x32x16_bf16(ka[st][1], qf[st], st == 0 ? negm : s[0][1], 0, 0, 0);
        }
        __builtin_amdgcn_sched_barrier(0);
        s16x4 va[2][2][2][2];
#define VFRAG(sub, u, kk, dt, half) (*(const LAS s16x4*)(vp0 + (sub) * SUB + (dt) * 32 * VROW + (32 * (u) + 16 * (kk)) * 2 + (half) * 16))
#pragma unroll
        for (int u = 0; u < 2; ++u)
#pragma unroll
            for (int kk = 0; kk < 2; ++kk)
#pragma unroll
                for (int dt = 0; dt < 2; ++dt) { va[u][kk][dt][0] = VFRAG(0, u, kk, dt, 0); va[u][kk][dt][1] = VFRAG(0, u, kk, dt, 1); }
#pragma unroll
        for (int st = 0; st < DK / 16; ++st) {
            s[1][0] = __builtin_amdgcn_mfma_f32_32x32x16_bf16(kb2[st][0], qf[st], st == 0 ? negm : s[1][0], 0, 0, 0);
            s[1][1] = __builtin_amdgcn_mfma_f32_32x32x16_bf16(kb2[st][1], qf[st], st == 0 ? negm : s[1][1], 0, 0, 0);
        }
        __builtin_amdgcn_sched_barrier(0);
        float mx = fmaxf(fmaxf(s[0][0][0], s[0][1][0]), fmaxf(s[1][0][0], s[1][1][0]));
#pragma unroll
        for (int i = 1; i < 16; ++i) mx = fmaxf(mx, fmaxf(fmaxf(s[0][0][i], s[0][1][i]), fmaxf(s[1][0][i], s[1][1][i])));
        mx = fmaxf(mx, __shfl_xor(mx, 32));
        if (j == 0 || __any(mx > 4.0f)) {
            const float d = (j == 0) ? mx : fmaxf(mx, 0.f);
            const float alpha = (j == 0) ? 0.f : __builtin_amdgcn_exp2f(-d);
            m_run += d; l_run *= alpha;
#pragma unroll
            for (int i = 0; i < 16; ++i) { o0[i] *= alpha; o1[i] *= alpha; }
#pragma unroll
            for (int sub = 0; sub < 2; ++sub)
#pragma unroll
                for (int u = 0; u < 2; ++u)
#pragma unroll
                    for (int i = 0; i < 16; ++i) s[sub][u][i] -= d;
        }
        float ls = 0.f;
#pragma unroll
        for (int sub = 0; sub < 2; ++sub)
#pragma unroll
            for (int u = 0; u < 2; ++u)
#pragma unroll
                for (int i = 0; i < 16; ++i) { s[sub][u][i] = __builtin_amdgcn_exp2f(s[sub][u][i]); ls += s[sub][u][i]; }
        l_run += ls;
        __builtin_amdgcn_sched_barrier(0);
        s16x4 vb2[2][2][2][2];
#define PFRAG(sub, u, kk) ({ v4u w_; const f32x16& sv_ = s[sub][u]; w_.x = cvt_pk_bf16(sv_[8 * (kk) + 0], sv_[8 * (kk) + 1]); w_.y = cvt_pk_bf16(sv_[8 * (kk) + 2], sv_[8 * (kk) + 3]); \
            w_.z = cvt_pk_bf16(sv_[8 * (kk) + 4], sv_[8 * (kk) + 5]); w_.w = cvt_pk_bf16(sv_[8 * (kk) + 6], sv_[8 * (kk) + 7]); __builtin_bit_cast(bf16x8, w_); })
#define V8(a_) ((bf16x8){(a_)[0][0], (a_)[0][1], (a_)[0][2], (a_)[0][3], (a_)[1][0], (a_)[1][1], (a_)[1][2], (a_)[1][3]})
#pragma unroll
        for (int u = 0; u < 2; ++u)
#pragma unroll
            for (int kk = 0; kk < 2; ++kk) {
#pragma unroll
                for (int dt = 0; dt < 2; ++dt) { vb2[u][kk][dt][0] = VFRAG(1, u, kk, dt, 0); vb2[u][kk][dt][1] = VFRAG(1, u, kk, dt, 1); }
                const bf16x8 pb = PFRAG(0, u, kk);
                o0 = __builtin_amdgcn_mfma_f32_32x32x16_bf16(V8(va[u][kk][0]), pb, o0, 0, 0, 0);
                o1 = __builtin_amdgcn_mfma_f32_32x32x16_bf16(V8(va[u][kk][1]), pb, o1, 0, 0, 0);
            }
        __builtin_amdgcn_sched_barrier(0);
#pragma unroll
        for (int u = 0; u < 2; ++u)
#pragma unroll
            for (int kk = 0; kk < 2; ++kk) {
                const bf16x8 pb = PFRAG(1, u, kk);
                o0 = __builtin_amdgcn_mfma_f32_32x32x16_bf16(V8(vb2[u][kk][0]), pb, o0, 0, 0, 0);
                o1 = __builtin_amdgcn_mfma_f32_32x32x16_bf16(V8(vb2[u][kk][1]), pb, o1, 0, 0, 0);
            }
#undef KFRAG
#undef VFRAG
#undef PFRAG
#undef V8
        if (more) lstore((j + 1) & 1);
        __syncthreads();
    }
    const float lt = l_run + __shfl_xor(l_run, 32);
    const float inv = 1.0f / lt;
    bf16* zp = SZ + ((size_t)(b * SEQ + q0 + 32 * wave + r32)) * 512 + h * 64;
#pragma unroll
    for (int dt = 0; dt < 2; ++dt)
#pragma unroll
        for (int g = 0; g < 4; ++g) {
            bf16* p = zp + 32 * dt + 8 * g + 4 * hi;
            const v2u z = *(const v2u*)p;
            const f32x16& o = dt ? o1 : o0;
            v2u w; w.x = cvt_pk_bf16(o[4 * g + 0] * inv * bf_lo(z.x), o[4 * g + 1] * inv * bf_hi(z.x)); w.y = cvt_pk_bf16(o[4 * g + 2] * inv * bf_lo(z.y), o[4 * g + 3] * inv * bf_hi(z.y));
            *(v2u*)p = w;
        }
}

__device__ __forceinline__ void p4_attention(const Ptrs& P, LAS unsigned char* lds, int tid, int lane, int wave, int G) {
    const int bx = blockIdx.x; const int vcu = (G % 8 == 0) ? (bx % 8) * (G / 8) + bx / 8 : bx;
    for (int u = vcu; u < 1024; u += G) {
        if (u < 512) { const int bh = u >> 4, qb = u & 15;
            attn_unit_mla2(lds, (const bf16*)(P.ws + WS_QA), (const bf16*)((unsigned char*)P.out + DO_KA), (const bf16*)((unsigned char*)P.out + DO_VAT), (bf16*)(P.ws + WS_SZA), bh >> 3, bh & 7, qb, tid, lane, wave);
        } else { const int v = u - 512, bh = v >> 4, qb = v & 15;
            attn_unit_na2(lds, (const bf16*)(P.ws + WS_QB), (const bf16*)(P.ws + WS_KB), (const bf16*)(P.ws + WS_VBT), (bf16*)(P.ws + WS_SZB), P.rpb, bh >> 3, bh & 7, qb, tid, lane, wave);
        }
    }
}

struct Args { Ptrs p; int ph_lo, ph_hi; };
constexpr int N_PHASES = 8;
__global__ void __launch_bounds__(NWAVES * 64, 2) mk_fwd(Args args) {
    extern __shared__ __attribute__((aligned(16))) unsigned char lds_raw[];
    LAS unsigned char* lds = (LAS unsigned char*)lds_raw;
    const Ptrs& P = args.p;
    const int tid = threadIdx.x, lane = tid & 63, wave = __builtin_amdgcn_readfirstlane(tid >> 6);
    const int G = gridDim.x;
    volatile LAS unsigned* MISC = (volatile LAS unsigned*)(lds + MISC_OFF);
    for (int u = tid; u < 32; u += NWAVES * 64) MISC[u] = 0u;
    __syncthreads();
    XcdBarrier bar; bar.bar = (unsigned*)(P.ws + WS_CTL) + CW_BAR; bar.x = 0; bar.st = nullptr;
    if (MK_N_LAUNCHES == 1) bar = xcd_barrier_post((unsigned*)(P.ws + WS_CTL) + CW_BAR, MISC + 8);
    const int lo = args.ph_lo, hi = args.ph_hi;
    int K1024 = 1024, K512 = 512, K256 = 256; asm volatile("" : "+s"(K1024), "+s"(K512), "+s"(K256));
#ifndef PH_MASK
#define PH_MASK 0xff
#endif
#define IN(k) (((PH_MASK >> (k)) & 1) && lo <= (k) && (k) < hi)
#define SEAM(k) do { if (IN(k) && IN((k) + 1)) xcd_barrier(bar); } while (0)
    unsigned char* ws = P.ws; unsigned char* dout = (unsigned char*)P.out;

    if (IN(0)) { p0_gemv(P, lds, tid, lane, wave, G); }
    SEAM(0);
    if (IN(1)) { p0_weights(P, lds, tid, lane, wave, G); p1_hconv(P, lane, wave, G); }
    SEAM(1);
    if (IN(2)) { SchedG1 S{G, (int)blockIdx.x, (const char*)(ws + WS_H), (const char*)(ws + WS_WIN)}; EpiG1 E{ws, dout};
        pg8::gemm_phase<EpiG1, SchedG1, true, true>(lds, K1024, S, E); }
    SEAM(2);
    if (IN(3)) { SchedG23 S{G, (int)blockIdx.x, (const char*)ws}; EpiG23 E{ws, dout};
        pg8::gemm_phase<EpiG23, SchedG23, true, true>(lds, K256, S, E); }
    SEAM(3);
    if (IN(4)) { p4_attention(P, lds, tid, lane, wave, G); }
    SEAM(4);
    if (IN(5)) { SchedG4 S{G, (int)blockIdx.x, (const char*)(ws + WS_SZA), (const char*)(ws + WS_SZB), (const char*)(ws + WS_WOA), (const char*)(ws + WS_WOB)}; EpiG4 E{ws, P.out};
        pg8::gemm_phase<EpiG4, SchedG4, true, true>(lds, K512, S, E); }
    SEAM(5);
    const bool fuse_final = (G == 256) && IN(6) && IN(7);
    if (IN(6)) { SchedG5 S{G, (int)blockIdx.x, (const char*)(ws + WS_M), (const char*)(ws + WS_WOUT)};
        if (fuse_final) { EpiG5F E{ws, P.x, P.out, P.final_g}; pg8::gemm_phase<EpiG5F, SchedG5, false, true>(lds, K1024, S, E); }
        else { EpiG5 E{ws, P.x, P.out}; pg8::gemm_phase<EpiG5, SchedG5, true, true>(lds, K1024, S, E); } }
    if (!fuse_final) {
    SEAM(6);
    if (IN(7)) { p7_final(P, lane, wave, G); }
    }
#undef IN
#undef SEAM
}

extern "C" void kernel_launch(void* const* d_in, const int* in_sizes, int n_in, void* d_out, int out_size, void* d_ws, size_t ws_size, hipStream_t stream) {
    static int grid = 0;
    if (grid == 0) {
        if (n_in != 17 || in_sizes[0] != MLAT * DM || out_size != MLAT * DM || ws_size < WS_END) { fprintf(stderr, "kernel_launch: unexpected shapes (n_in %d, ws %zu); nothing launched\n", n_in, ws_size); grid = -1; return; }
        int dev = 0, cus = 0, per_cu = 0;
        if (hipGetDevice(&dev) != hipSuccess || hipDeviceGetAttribute(&cus, hipDeviceAttributeMultiprocessorCount, dev) != hipSuccess) { grid = -1; return; }
        if (hipFuncSetAttribute((const void*)mk_fwd, hipFuncAttributeMaxDynamicSharedMemorySize, LDS_BYTES) != hipSuccess) { fprintf(stderr, "kernel_launch: hipFuncSetAttribute failed\n"); grid = -1; return; }
        if (hipOccupancyMaxActiveBlocksPerMultiprocessor(&per_cu, (const void*)mk_fwd, NWAVES * 64, LDS_BYTES) != hipSuccess || per_cu < 1) fprintf(stderr, "kernel_launch: occupancy query says %d\n", per_cu);
        (void)hipGetLastError();
        grid = cus;
    }
    if (grid < 0) return;
    if (hipMemsetAsync((char*)d_ws + WS_CTL, 0, CTL_ZERO_BYTES, stream) != hipSuccess) { fprintf(stderr, "kernel_launch: memset failed\n"); return; }
    Args a{};
    const float** pp = (const float**)&a.p;
    for (int i = 0; i < 17; ++i) pp[i] = (const float*)d_in[i];
    a.p.out = (float*)d_out; a.p.ws = (unsigned char*)d_ws;
    if (MK_N_LAUNCHES == 1) {
        a.ph_lo = 0; a.ph_hi = N_PHASES;
        void* kargs[] = {&a};
        hipError_t e = hipLaunchCooperativeKernel((const void*)mk_fwd, dim3(grid), dim3(NWAVES * 64), kargs, LDS_BYTES, stream);
        if (e != hipSuccess) fprintf(stderr, "kernel_launch: cooperative launch failed: %s (grid %d)\n", hipGetErrorString(e), grid);
    } else {
        for (int k = 0; k < N_PHASES; ++k) { a.ph_lo = k; a.ph_hi = k + 1; hipLaunchKernelGGL(mk_fwd, dim3(grid), dim3(NWAVES * 64), LDS_BYTES, stream, a); }
    }
}
```

```cpp
#include <hip/hip_runtime.h>
#include <hip/hip_bf16.h>
#include <cstdio>
#include <cstdint>
#include <cmath>

#ifndef MK_N_LAUNCHES
#define MK_N_LAUNCHES 1
#endif

namespace pg8 {
#define PG8_LAS __attribute__((address_space(3)))
typedef unsigned short bf16_t;
typedef short bf16x8 __attribute__((ext_vector_type(8)));
typedef float f32x4 __attribute__((ext_vector_type(4)));
typedef unsigned u32x4 __attribute__((ext_vector_type(4)));
typedef unsigned u32x2 __attribute__((ext_vector_type(2)));
constexpr int BM = 256, BK = 64, HALF = 128, HTB = HALF * BK * 2  , STAGE_BYTES = 8 * HTB, NXCD = 8, WGM = 8;

__host__ __device__ __forceinline__ int lds_byte(int r, int c) { const int st = (r >> 4) * 2 + (c >> 5), rr = r & 15, cc = c & 31, ob = rr * 64 + cc * 2; return st * 1024 + (ob ^ (((ob >> 9) & 1) << 5)); }
__host__ __device__ __forceinline__ void stage_rc(int b, int& R, int& C) { const int st = b / 1024, sb = b % 1024, swz = sb ^ (((sb >> 9) & 1) << 5); R = (st >> 1) * 16 + swz / 64; C = (st & 1) * 32 + (swz % 64) / 2; }
__host__ __device__ __forceinline__ int perm32(int rho) { const int n = rho >> 4, i = rho & 15; return 8 * (i >> 2) + 4 * n + (i & 3); }

struct Unit { int ta, tb, kind; };
typedef float f32x2_cv __attribute__((ext_vector_type(2))); typedef __bf16 bf16x2_cv __attribute__((ext_vector_type(2)));
__device__ __forceinline__ unsigned cvt_pk_bf16(float lo, float hi) { const f32x2_cv v = {lo, hi}; const bf16x2_cv b = __builtin_convertvector(v, bf16x2_cv); return __builtin_bit_cast(unsigned, b); }

template <class Epi, class Sched, bool ALIGN_EPI = false, bool SP2 = false>
__device__ __forceinline__ void gemm_phase(PG8_LAS unsigned char* lds, const int K, const Sched& S, const Epi& E) {
    int tid = threadIdx.x; asm volatile("" : "+v"(tid));
    const int wid = __builtin_amdgcn_readfirstlane(tid >> 6), lane = tid & 63, wr = wid >> 2, wc = wid & 3, fr = lane & 15, fq = lane >> 4;
    const int nt = K / BK;
    unsigned voffA[2], voffB[2];
#pragma unroll
    for (int i = 0; i < 2; ++i) { int R, C; stage_rc(tid * 16 + i * 8192, R, C); const int Rb = Epi::PERM ? ((R & ~31) + perm32(R & 31)) : R;
        voffA[i] = (unsigned)(R * K + C) * 2u; voffB[i] = (unsigned)(Rb * K + C) * 2u; }
    const size_t kstep = (size_t)(BK * 2);
    const size_t hstep = (size_t)HALF * K * 2;
    const unsigned ldsw = (unsigned)wid * 1024u;
    const int aoff = lds_byte(wr * 64 + fr, fq * 8), boff = lds_byte(wc * 32 + fr, fq * 8);
#define PG8_SA(b, h) (((b) * 2 + (h)) * HTB)
#define PG8_SB(b, h) ((4 + (b) * 2 + (h)) * HTB)
#define PG8_STAGE(bufoff, gbase, voff) do { _Pragma("unroll") for (int _i = 0; _i < 2; ++_i) \
        __builtin_amdgcn_global_load_lds((const unsigned*)((const char*)(gbase) + (voff)[_i]), (PG8_LAS unsigned*)(lds + (bufoff) + ldsw + _i * 8192), 16, 0, 0); } while (0)
#define PG8_LDA(dst, b, h) do { _Pragma("unroll") for (int m = 0; m < 4; ++m) _Pragma("unroll") for (int k = 0; k < 2; ++k) dst[m][k] = *(const PG8_LAS bf16x8*)(lds + PG8_SA(b, h) + aoff + m * 2048 + k * 1024); } while (0)
#define PG8_LDB(dst, b, h) do { _Pragma("unroll") for (int n = 0; n < 2; ++n) _Pragma("unroll") for (int k = 0; k < 2; ++k) dst[n][k] = *(const PG8_LAS bf16x8*)(lds + PG8_SB(b, h) + boff + n * 2048 + k * 1024); } while (0)
#define PG8_MMA(ai, bj, At, Bt) do { __builtin_amdgcn_s_setprio(1); _Pragma("unroll") for (int m = 0; m < 4; ++m) _Pragma("unroll") for (int n = 0; n < 2; ++n) _Pragma("unroll") for (int k = 0; k < 2; ++k) \
        acc[ai][bj][m][n] = __builtin_amdgcn_mfma_f32_16x16x32_bf16(Bt[n][k], At[m][k], acc[ai][bj][m][n], 0, 0, 0); __builtin_amdgcn_s_setprio(0); } while (0)
#define PG8_WAIT_V(n) asm volatile("s_waitcnt vmcnt(" #n ")" ::: "memory")
#define PG8_WAIT_L(n) asm volatile("s_waitcnt lgkmcnt(" #n ")" ::: "memory")
#define PG8_BAR __builtin_amdgcn_s_barrier()
#define PG8_SCHED __builtin_amdgcn_sched_barrier(0)
    Unit cur, nxt; int ui = 0;
    if (!S.next(0, cur)) return;
    f32x4 acc[2][2][4][2];
#pragma unroll
    for (int a = 0; a < 2; ++a)
#pragma unroll
        for (int b = 0; b < 2; ++b)
#pragma unroll
            for (int m = 0; m < 4; ++m)
#pragma unroll
                for (int n = 0; n < 2; ++n) acc[a][b][m][n] = (f32x4){0.f, 0.f, 0.f, 0.f};
    bf16x8 At[4][2], B0[2][2], B1[2][2];
    const char* cA = S.aptr(cur); const char* cB = S.bptr(cur);
    if constexpr (SP2) {
        PG8_STAGE(PG8_SB(0, 0), cB, voffB); PG8_STAGE(PG8_SB(0, 1), cB + hstep, voffB); PG8_STAGE(PG8_SA(0, 0), cA, voffA); PG8_STAGE(PG8_SA(0, 1), cA + hstep, voffA);
        if (wr == 1) PG8_BAR;
        PG8_WAIT_V(2); PG8_BAR;
        PG8_STAGE(PG8_SB(1, 0), cB + kstep, voffB); PG8_STAGE(PG8_SA(1, 0), cA + kstep, voffA); PG8_STAGE(PG8_SB(1, 1), cB + hstep + kstep, voffB);
        PG8_WAIT_V(6); PG8_BAR;
    } else {
        PG8_STAGE(PG8_SB(0, 0), cB, voffB); PG8_STAGE(PG8_SA(0, 0), cA, voffA); PG8_STAGE(PG8_SB(0, 1), cB + hstep, voffB); PG8_STAGE(PG8_SA(0, 1), cA + hstep, voffA);
        if (wr == 1) PG8_BAR;
        PG8_WAIT_V(4); PG8_BAR;
        PG8_STAGE(PG8_SB(1, 0), cB + kstep, voffB); PG8_STAGE(PG8_SA(1, 0), cA + kstep, voffA); PG8_STAGE(PG8_SB(1, 1), cB + hstep + kstep, voffB);
        PG8_WAIT_V(6); PG8_BAR;
    }
    for (;;) {
        const bool has_next = S.next(ui + 1, nxt);
        const char* nA = has_next ? S.aptr(nxt) : cA; const char* nB = has_next ? S.bptr(nxt) : cB;
        for (int t = 0; t < nt; t += 2) {
            const bool last = (t == nt - 2);
            const char* a1 = cA + (size_t)(t + 1) * kstep;
            const char* a2 = last ? nA : cA + (size_t)(t + 2) * kstep; const char* b2 = last ? nB : cB + (size_t)(t + 2) * kstep;
            const char* a3 = a2 + kstep; const char* b3 = b2 + kstep;
            if constexpr (SP2) {
            PG8_LDB(B0, 0, 0); PG8_LDB(B1, 0, 1); PG8_SCHED; PG8_LDA(At, 0, 0); PG8_STAGE(PG8_SA(1, 1), a1 + hstep, voffA);
            PG8_WAIT_V(8); PG8_WAIT_L(0); PG8_BAR; PG8_MMA(0, 0, At, B0); PG8_MMA(0, 1, At, B1); PG8_BAR; PG8_SCHED;
            PG8_LDA(At, 0, 1); PG8_STAGE(PG8_SB(0, 0), b2, voffB); PG8_STAGE(PG8_SB(0, 1), b2 + hstep, voffB); PG8_STAGE(PG8_SA(0, 0), a2, voffA);
            PG8_WAIT_V(8); PG8_WAIT_L(0); PG8_BAR; PG8_MMA(1, 0, At, B0); PG8_MMA(1, 1, At, B1); PG8_BAR; PG8_SCHED;
            PG8_LDB(B0, 1, 0); PG8_LDB(B1, 1, 1); PG8_SCHED; PG8_LDA(At, 1, 0); PG8_STAGE(PG8_SA(0, 1), a2 + hstep, voffA);
            PG8_WAIT_V(8); PG8_WAIT_L(0); PG8_BAR; PG8_MMA(0, 0, At, B0); PG8_MMA(0, 1, At, B1); PG8_BAR; PG8_SCHED;
            PG8_LDA(At, 1, 1); PG8_STAGE(PG8_SB(1, 0), b3, voffB); PG8_STAGE(PG8_SB(1, 1), b3 + hstep, voffB); PG8_STAGE(PG8_SA(1, 0), a3, voffA);
            PG8_WAIT_V(8); PG8_WAIT_L(0); PG8_BAR; PG8_MMA(1, 0, At, B0); PG8_MMA(1, 1, At, B1); PG8_BAR; PG8_SCHED;
            } else {
            PG8_LDB(B0, 0, 0); PG8_SCHED; PG8_LDA(At, 0, 0); PG8_STAGE(PG8_SA(1, 1), a1 + hstep, voffA);
            PG8_WAIT_L(8); PG8_BAR; PG8_WAIT_L(0); PG8_MMA(0, 0, At, B0); PG8_BAR; PG8_SCHED;
            PG8_LDB(B1, 0, 1); PG8_STAGE(PG8_SB(0, 0), b2, voffB);
            PG8_BAR; PG8_WAIT_L(0); PG8_MMA(0, 1, At, B1); PG8_BAR;
            PG8_LDA(At, 0, 1); PG8_STAGE(PG8_SA(0, 0), a2, voffA);
            PG8_BAR; PG8_WAIT_L(0); PG8_MMA(1, 0, At, B0); PG8_BAR; PG8_SCHED;
            PG8_STAGE(PG8_SB(0, 1), b2 + hstep, voffB);
            PG8_WAIT_V(6); PG8_BAR; PG8_MMA(1, 1, At, B1); PG8_BAR;
            PG8_LDB(B0, 1, 0); PG8_SCHED; PG8_LDA(At, 1, 0); PG8_STAGE(PG8_SA(0, 1), a2 + hstep, voffA);
            PG8_WAIT_L(8); PG8_BAR; PG8_WAIT_L(0); PG8_MMA(0, 0, At, B0); PG8_BAR; PG8_SCHED;
            PG8_LDB(B1, 1, 1); PG8_STAGE(PG8_SB(1, 0), b3, voffB);
            PG8_BAR; PG8_WAIT_L(0); PG8_MMA(0, 1, At, B1); PG8_BAR;
            PG8_LDA(At, 1, 1); PG8_STAGE(PG8_SA(1, 0), a3, voffA);
            PG8_BAR; PG8_WAIT_L(0); PG8_MMA(1, 0, At, B0); PG8_BAR; PG8_SCHED;
            PG8_STAGE(PG8_SB(1, 1), b3 + hstep, voffB);
            PG8_WAIT_V(6); PG8_BAR; PG8_MMA(1, 1, At, B1); PG8_BAR;
            }
        }
        if constexpr (ALIGN_EPI) { if (wr == 0) PG8_BAR; }
        if constexpr (!Epi::AFTER_DRAIN) { E(acc, cur, wr, wc, fr, fq); }
        if (!has_next) break;
#pragma unroll
        for (int a = 0; a < 2; ++a)
#pragma unroll
            for (int b = 0; b < 2; ++b)
#pragma unroll
                for (int m = 0; m < 4; ++m)
#pragma unroll
                    for (int n = 0; n < 2; ++n) acc[a][b][m][n] = (f32x4){0.f, 0.f, 0.f, 0.f};
        cur = nxt; cA = nA; cB = nB; ++ui;
        if constexpr (ALIGN_EPI) { if (wr == 1) PG8_BAR; }
    }
    PG8_WAIT_V(0);
    if constexpr (!ALIGN_EPI) { if (wr == 0) PG8_BAR; }
    PG8_BAR;
    if constexpr (Epi::AFTER_DRAIN) { E.fused(acc, cur, wr, wc, fr, fq, lds, wid, lane); }
#undef PG8_SA
#undef PG8_SB
#undef PG8_STAGE
#undef PG8_LDA
#undef PG8_LDB
#undef PG8_MMA
#undef PG8_WAIT_V
#undef PG8_WAIT_L
#undef PG8_BAR
#undef PG8_SCHED
}
}


constexpr int NWAVES = 8;
constexpr int DM = 1024, NB = 4, SEQ = 4096, CTXL = 256, TK = SEQ + CTXL;
constexpr int MLAT = NB * SEQ, MCTX = NB * CTXL, MALL = MLAT + MCTX;
constexpr int INW = 5024, NIN = 5120;
constexpr int NH = 8;
constexpr float EPS = 1e-6f;
constexpr float LOG2E = 1.4426950408889634f;
constexpr float MLA_C2 = 0.10206207261596577f * LOG2E;
constexpr float NA_C2 = 0.125f * LOG2E;

constexpr size_t MiB = 1u << 20;
constexpr size_t WS_CTL = 0, CTL_ZERO_BYTES = 64 * 1024;
constexpr size_t WS_WIN = 2 * MiB;
constexpr size_t WS_WUQ = 12 * MiB;
constexpr size_t WS_WUKV = 12 * MiB + 512 * 1024;
constexpr size_t WS_WOA = 13 * MiB, WS_WOB = 14 * MiB, WS_WOUT = 15 * MiB;
constexpr size_t WS_MOD = 17 * MiB;
constexpr size_t WS_ROPE = 17 * MiB + 256 * 1024;
constexpr size_t WS_SSQQ = 17 * MiB + 512 * 1024;
constexpr size_t WS_SSQKV = 18 * MiB;
constexpr size_t WS_SSQO = 18 * MiB + 512 * 1024;
constexpr size_t WS_H = 20 * MiB;
constexpr size_t WS_QA = 20 * MiB;
constexpr size_t WS_T0 = 54 * MiB;
constexpr size_t WS_CQ = 63 * MiB;
constexpr size_t WS_KB = 71 * MiB;
constexpr size_t WS_VBT = 88 * MiB;
constexpr size_t WS_M = 71 * MiB;
constexpr size_t WS_QB = 105 * MiB;
constexpr size_t WS_SZA = 121 * MiB;
constexpr size_t WS_SZB = 137 * MiB;
constexpr size_t WS_SGA = 153 * MiB;
constexpr size_t WS_SGB = 185 * MiB;
constexpr size_t WS_END = 217 * MiB;
constexpr size_t DO_KA = 0, DO_VAT = 26 * MiB;
constexpr int CW_BAR = 1024;

constexpr int RING_BYTES = 131072, MISC_OFF = RING_BYTES + 320, LDS_BYTES = 147456;

#define GAS __attribute__((address_space(1)))
#define LAS __attribute__((address_space(3)))
typedef unsigned short bf16;
typedef unsigned v4u __attribute__((ext_vector_type(4)));
typedef unsigned v2u __attribute__((ext_vector_type(2)));
typedef float f32x4 __attribute__((ext_vector_type(4)));
typedef float f32x16 __attribute__((ext_vector_type(16)));
typedef short bf16x8 __attribute__((ext_vector_type(8)));
typedef short s16x4 __attribute__((ext_vector_type(4)));
__device__ __forceinline__ unsigned f2bf(float f) { unsigned u = __builtin_bit_cast(unsigned, f); return (u + 0x7fffu + ((u >> 16) & 1u)) >> 16; }
__device__ __forceinline__ unsigned pk2(float lo, float hi) { return f2bf(lo) | (f2bf(hi) << 16); }
__device__ __forceinline__ float bf_lo(unsigned w) { return __builtin_bit_cast(float, w << 16); }
__device__ __forceinline__ float bf_hi(unsigned w) { return __builtin_bit_cast(float, w & 0xffff0000u); }
__device__ __forceinline__ float fast_rcp(float x) { return __builtin_amdgcn_rcpf(x); }
__device__ __forceinline__ float sigmoidf_(float x) { return fast_rcp(1.f + __builtin_amdgcn_exp2f(-x * LOG2E)); }
__device__ __forceinline__ float siluf_(float x) { return x * sigmoidf_(x); }
#define XB_TMO      128
#define XB_XCNT(j)  (256  + 64 * (j))
#define XB_XSUB(j)  (1280 + 64 * (j))
#define XB_XGEN(j)  (2304 + 64 * (j))
#define XB_TOP      3328
#define XB_TOPGEN   3392
#define XCD_BAR_WORDS 3456
#define XB_SPIN_CAP (1u << 18)

__device__ __forceinline__ unsigned xb_ld(unsigned* p)              { return __hip_atomic_load(p, __ATOMIC_RELAXED, __HIP_MEMORY_SCOPE_AGENT); }
__device__ __forceinline__ unsigned xb_add(unsigned* p, unsigned v) { return __hip_atomic_fetch_add(p, v, __ATOMIC_RELAXED, __HIP_MEMORY_SCOPE_AGENT); }
__device__ __forceinline__ unsigned xb_xcc_id() { return (unsigned)__builtin_amdgcn_s_getreg((3 << 11) | 20) & 0xFu; }
#define XB_SPIN(cond, bar) do { unsigned _sp = 0; while (cond) { __builtin_amdgcn_s_sleep(1); \
    if ((++_sp & 255u) == 0u) { if (xb_ld(&(bar)[XB_TMO])) break; if (_sp > XB_SPIN_CAP) { atomicAdd(&(bar)[XB_TMO], 1u); break; } } } } while (0)

struct XcdBarrier {
    unsigned* bar; unsigned x;
    volatile LAS unsigned* st;
};

__device__ __forceinline__ XcdBarrier xcd_barrier_post(unsigned* bar, volatile LAS unsigned* st) {
    XcdBarrier b; b.bar = bar; b.x = xb_xcc_id(); b.st = st;
    if (threadIdx.x == 0) (void)xb_add(&bar[XB_XCNT(b.x)], 1u);
    return b;
}
__device__ __forceinline__ void xcd_barrier_complete(unsigned* bar, unsigned x, unsigned& nloc, unsigned& nx) {
    const unsigned G = gridDim.x * gridDim.y * gridDim.z;
    unsigned sum, cnt, mine, sp = 0u;
    for (;;) {
        sum = 0u; cnt = 0u; mine = 0u;
#pragma unroll
        for (unsigned j = 0; j < 16; ++j) { const unsigned c = xb_ld(&bar[XB_XCNT(j)]); sum += c; cnt += (c > 0u) ? 1u : 0u; mine = (j == x) ? c : mine; }
        if (sum == G) break;
        __builtin_amdgcn_s_sleep(1);
        if ((++sp & 255u) == 0u) { if (xb_ld(&bar[XB_TMO])) break; if (sp > XB_SPIN_CAP) { atomicAdd(&bar[XB_TMO], 1u); break; } }
    }
    nloc = mine > 0u ? mine : 1u; nx = cnt > 0u ? cnt : 1u;
}

__device__ __forceinline__ void xcd_barrier(const XcdBarrier& b) {
    asm volatile("s_waitcnt vmcnt(0)" ::: "memory");
    __syncthreads();
    if (threadIdx.x == 0) {
        unsigned* bar = b.bar;
        __builtin_amdgcn_s_waitcnt(0);
        unsigned nloc = b.st[0], nx = b.st[1];
        if (nloc == 0u) { xcd_barrier_complete(bar, b.x, nloc, nx); b.st[0] = nloc; b.st[1] = nx; }
        const unsigned old = xb_add(&bar[XB_XSUB(b.x)], 1u);
        const unsigned gen = old / nloc;
        if (old + 1u == (gen + 1u) * nloc) {
            __builtin_amdgcn_fence(__ATOMIC_RELEASE, "agent");
            asm volatile("s_waitcnt vmcnt(0)" ::: "memory");
            const unsigned og = xb_add(&bar[XB_TOP], 1u);
            const unsigned tg = og / nx;
            if (og + 1u == (tg + 1u) * nx) xb_add(&bar[XB_TOPGEN], 1u);
            else XB_SPIN(xb_ld(&bar[XB_TOPGEN]) == tg, bar);
            __builtin_amdgcn_fence(__ATOMIC_ACQUIRE, "agent");
            xb_add(&bar[XB_XGEN(b.x)], 1u);
            asm volatile("s_waitcnt vmcnt(0)" ::: "memory");
        } else {
            XB_SPIN(xb_ld(&bar[XB_XGEN(b.x)]) == gen, bar);
            __builtin_amdgcn_fence(__ATOMIC_ACQUIRE, "agent");
            asm volatile("s_waitcnt vmcnt(0)" ::: "memory");
        }
    }
    __syncthreads();
}

#define LDS_WAIT() asm volatile("s_waitcnt lgkmcnt(0)" ::: "memory")
#define VM_WAIT() asm volatile("s_waitcnt vmcnt(0)" ::: "memory")
__device__ __forceinline__ float wave_sum(float v) {
#pragma unroll
    for (int o = 1; o < 64; o <<= 1) v += __shfl_xor(v, o);
    return v;
}
__device__ __forceinline__ void tile_remap(int L, int nM, int nN, int& pm, int& pn) {
    const int nwg = nM * nN; int wgid = L;
    { const int q = nwg / 8, r = nwg % 8, xcd = wgid % 8, off = wgid / 8; wgid = (xcd < r ? xcd * (q + 1) : r * (q + 1) + (xcd - r) * q) + off; }
    const int nig = 8 * nN, gid = wgid / nig, fm = gid * 8, gsz = (nM - fm) < 8 ? (nM - fm) : 8;
    pm = fm + ((wgid % nig) % gsz); pn = (wgid % nig) / gsz;
}
__device__ __forceinline__ void row_bt(int row, int& b, int& t) {
    if (row < MLAT) { b = row >> 12; t = row & 4095; } else { const int r = row - MLAT; b = r >> 8; t = SEQ + (r & 255); }
}

__device__ __forceinline__ void transpose_item(const float* W, int ldw, int k0, int n0, bf16* WT, int KD, int drow0, const float* g, LAS float* scr, int lane) {
#pragma unroll 8
    for (int i = 0; i < 32; ++i) { const int kk = 2 * i + (lane >> 5); float v = W[(size_t)(k0 + kk) * ldw + n0 + (lane & 31)]; if (g) v *= g[k0 + kk]; scr[kk * 33 + (lane & 31)] = v; }
    LDS_WAIT(); asm volatile("" ::: "memory");
    const int c = lane & 7;
#pragma unroll
    for (int j = 0; j < 4; ++j) { const int n = (lane >> 3) + 8 * j; const LAS float* s = scr + (8 * c) * 33 + n;
        v4u o; o.x = pk2(s[0 * 33], s[1 * 33]); o.y = pk2(s[2 * 33], s[3 * 33]); o.z = pk2(s[4 * 33], s[5 * 33]); o.w = pk2(s[6 * 33], s[7 * 33]);
        *(v4u*)(WT + (size_t)(drow0 + n) * KD + k0 + 8 * c) = o; }
    LDS_WAIT(); asm volatile("" ::: "memory");
}

struct Ptrs {
    const float *x, *c, *ctx, *c_ctx, *w_mod, *b_mod, *norm_g, *w_in, *g_cq, *w_uq, *g_ckv, *w_ukv, *rpb, *w_oa, *w_ob, *w_out, *final_g;
    float* out; unsigned char* ws;
};

__device__ __forceinline__ void p0_weights(const Ptrs& P, LAS unsigned char* lds, int tid, int lane, int wave, int G) {
    LAS float* scr = (LAS float*)(lds + wave * 16384);
    const int gw = blockIdx.x * NWAVES + wave, NGW = G * NWAVES;
    unsigned char* ws = P.ws;
    constexpr int I_IN = 16 * 157, I_UQ = 4 * 24, I_UKV = 2 * 32, I_OA = 8 * 32, I_OUT = 16 * 32;
    constexpr int NITEMS = I_IN + I_UQ + I_UKV + 2 * I_OA + I_OUT;
    for (int it = gw; it < NITEMS; it += NGW) {
        int r = it;
        if (r < I_IN) { const int kb = r / 157, nb = r % 157, n0 = 32 * nb; transpose_item(P.w_in, INW, 64 * kb, n0, (bf16*)(ws + WS_WIN), 1024, n0 + (n0 >= 160 ? 96 : 0), nullptr, scr, lane); continue; } r -= I_IN;
        if (r < I_UQ) { const int kb = r / 24, nb = r % 24, h = nb / 3, j = nb % 3; transpose_item(P.w_uq, 768, 64 * kb, 32 * nb, (bf16*)(ws + WS_WUQ), 256, j < 2 ? h * 64 + 32 * j : 512 + 32 * h, P.g_cq, scr, lane); continue; } r -= I_UQ;
        if (r < I_UKV) { const int kb = r / 32, nb = r % 32, h = nb / 4, j = nb % 4; transpose_item(P.w_ukv, 1024, 64 * kb, 32 * nb, (bf16*)(ws + WS_WUKV), 256, j < 2 ? h * 64 + 32 * j : 512 + h * 64 + 32 * (j - 2), P.g_ckv, scr, lane); continue; } r -= I_UKV;
        if (r < I_OA) { const int kb = r / 32, nb = r % 32; transpose_item(P.w_oa, 1024, 64 * kb, 32 * nb, (bf16*)(ws + WS_WOA), 512, 32 * nb, nullptr, scr, lane); continue; } r -= I_OA;
        if (r < I_OA) { const int kb = r / 32, nb = r % 32; transpose_item(P.w_ob, 1024, 64 * kb, 32 * nb, (bf16*)(ws + WS_WOB), 512, 32 * nb, nullptr, scr, lane); continue; } r -= I_OA;
        { const int kb = r / 32, nb = r % 32; transpose_item(P.w_out, 1024, 64 * kb, 32 * nb, (bf16*)(ws + WS_WOUT), 1024, 32 * nb, nullptr, scr, lane); }
    }
    { const int gt = blockIdx.x * (NWAVES * 64) + tid, NT = G * NWAVES * 64; const v4u z = {0u, 0u, 0u, 0u};
      for (int ch = gt; ch < 12288; ch += NT) *(v4u*)(ws + WS_WIN + (size_t)160 * 2048 + (size_t)ch * 16) = z;
      for (int ch = gt; ch < 16384; ch += NT) *(v4u*)(ws + WS_WUKV + (size_t)(ch >> 4) * 512 + 256 + (ch & 15) * 16) = z; }
    if (blockIdx.x == 0) {
        const int p = tid >> 3, i = tid & 7;
        const float fr = (i == 0) ? 1.0f : (i == 1) ? 0.31622776601683794f : (i == 2) ? 0.1f : (i == 3) ? 0.031622776601683794f : (i == 4) ? 0.01f : (i == 5) ? 0.0031622776601683794f : (i == 6) ? 0.001f : 0.00031622776601683794f;
        const float ang = (float)p * fr;
        float2 cs; cs.x = cosf(ang); cs.y = sinf(ang);
        ((float2*)(ws + WS_ROPE))[tid] = cs;
    }
}
__device__ __forceinline__ void p0_gemv(const Ptrs& P, LAS unsigned char* lds, int tid, int lane, int wave, int G) {
    unsigned char* ws = P.ws;
    __syncthreads();
    LAS float* red = (LAS float*)(lds + 7 * 16384 + 12288);
    for (int cgp = blockIdx.x; cgp < 256; cgp += G) {
        const int c0 = 12 * cgp;
        float acc[5][12];
#pragma unroll
        for (int b = 0; b < 5; ++b)
#pragma unroll
            for (int j = 0; j < 12; ++j) acc[b][j] = 0.f;
#pragma unroll
        for (int h = 0; h < 2; ++h) {
            const int kk = tid + 512 * h;
            float s[5];
#pragma unroll
            for (int b = 0; b < 4; ++b) s[b] = siluf_(P.c[b * 1024 + kk]);
            s[4] = siluf_(P.c_ctx[kk]);
            const f32x4* wp = (const f32x4*)(P.w_mod + (size_t)kk * 3072 + c0);
            const f32x4 w0 = wp[0], w1 = wp[1], w2 = wp[2];
            const float w[12] = {w0[0], w0[1], w0[2], w0[3], w1[0], w1[1], w1[2], w1[3], w2[0], w2[1], w2[2], w2[3]};
#pragma unroll
            for (int b = 0; b < 5; ++b)
#pragma unroll
                for (int j = 0; j < 12; ++j) acc[b][j] += s[b] * w[j];
        }
#pragma unroll
        for (int b = 0; b < 5; ++b)
#pragma unroll
            for (int j = 0; j < 12; ++j) { const float v = wave_sum(acc[b][j]); if (lane == 0) red[wave * 60 + b * 12 + j] = v; }
        __syncthreads();
        if (tid < 60) { float v = 0.f;
#pragma unroll
            for (int w8 = 0; w8 < 8; ++w8) v += red[w8 * 60 + tid];
            const int b = tid / 12, j = tid % 12;
            ((float*)(ws + WS_MOD))[b * 3072 + c0 + j] = v + P.b_mod[c0 + j]; }
        __syncthreads();
    }
}

__device__ __forceinline__ void p1_hconv(const Ptrs& P, int lane, int wave, int G) {
    const int gw = blockIdx.x * NWAVES + wave, NGW = G * NWAVES;
    const float* MOD = (const float*)(P.ws + WS_MOD);
    bf16* H = (bf16*)(P.ws + WS_H);
    for (int row = gw; row < MALL; row += NGW) {
        const float* xr = row < MLAT ? P.x + (size_t)row * DM : P.ctx + (size_t)(row - MLAT) * DM;
        const int mb = row < MLAT ? (row >> 12) : 4;
        const f32x4* x4 = (const f32x4*)xr + lane;
        f32x4 v[4]; float s = 0.f;
#pragma unroll
        for (int j = 0; j < 4; ++j) { v[j] = x4[64 * j]; s += (v[j][0] * v[j][0] + v[j][1] * v[j][1]) + (v[j][2] * v[j][2] + v[j][3] * v[j][3]); }
        const float rstd = 1.0f / sqrtf(wave_sum(s) * (1.f / DM) + EPS);
        const f32x4* g4 = (const f32x4*)P.norm_g + lane;
        const f32x4* sh4 = (const f32x4*)(MOD + mb * 3072) + lane;
        const f32x4* sc4 = (const f32x4*)(MOD + mb * 3072 + 1024) + lane;
        unsigned long long* o8 = (unsigned long long*)(H + (size_t)row * DM) + lane;
#pragma unroll
        for (int j = 0; j < 4; ++j) {
            const f32x4 g = g4[64 * j], sh = sh4[64 * j], sc = sc4[64 * j];
            f32x4 h;
#pragma unroll
            for (int e = 0; e < 4; ++e) h[e] = (v[j][e] * rstd * g[e]) * (1.f + sc[e]) + sh[e];
            o8[64 * j] = (unsigned long long)pk2(h[0], h[1]) | ((unsigned long long)pk2(h[2], h[3]) << 32);
        }
    }
}

using pg8::Unit;
using pg8::cvt_pk_bf16;
__device__ __forceinline__ v4u pack8(const f32x4& a, const f32x4& b) { v4u w; w.x = cvt_pk_bf16(a[0], a[1]); w.y = cvt_pk_bf16(a[2], a[3]); w.z = cvt_pk_bf16(b[0], b[1]); w.w = cvt_pk_bf16(b[2], b[3]); return w; }

__device__ __forceinline__ void rope8(float (&v)[8], int fq, int t, const float2* tab) {
    const int pos = (fq < 2) ? (t >> 6) : (t & 63);
    const float sgn = (fq & 1) ? 1.f : -1.f;
#pragma unroll
    for (int i = 0; i < 8; ++i) { const float pv = __shfl_xor(v[i], 16); const float2 cs = tab[pos * 8 + i]; v[i] = v[i] * cs.x + sgn * pv * cs.y; }
}

struct SchedG1 {
    int G, c; const char* H; const char* W;
    static constexpr size_t TS = (size_t)256 * 1024 * 2;
    __device__ __forceinline__ bool next(int i, Unit& u) const {
        const int L = i * G + c; if (L >= 1280) return false;
        int pm, pn;
        tile_remap(L, 64, 20, pm, pn);
        if (pn == 3 || pn == 4) { u.kind = 1; u.ta = pn; u.tb = pm; } else { u.kind = 0; u.ta = pm; u.tb = pn; }
        return true;
    }
    __device__ __forceinline__ const char* aptr(const Unit& u) const { return (u.kind == 1 ? W : H) + (size_t)u.ta * TS; }
    __device__ __forceinline__ const char* bptr(const Unit& u) const { return (u.kind == 1 ? H : W) + (size_t)u.tb * TS; }
};
struct SchedG1C {
    int nC, c; const char* H; const char* W;
    static constexpr size_t TS = (size_t)256 * 1024 * 2;
    __device__ __forceinline__ bool next(int i, Unit& u) const {
        if (c >= nC) return false;
        const int k = i * nC + c; if (k >= 20) return false;
        const int pm = 64 + k / 5, pn = k % 5;
        if (pn == 3 || pn == 4) { u.kind = 1; u.ta = pn; u.tb = pm; } else { u.kind = 0; u.ta = pm; u.tb = pn; }
        return true;
    }
    __device__ __forceinline__ const char* aptr(const Unit& u) const { return (u.kind == 1 ? W : H) + (size_t)u.ta * TS; }
    __device__ __forceinline__ const char* bptr(const Unit& u) const { return (u.kind == 1 ? H : W) + (size_t)u.tb * TS; }
};
struct EpiG1 {
    static constexpr bool PERM = true, AFTER_DRAIN = false;
    unsigned char* ws; unsigned char* dout;
    __device__ __forceinline__ void operator()(const f32x4 (&acc)[2][2][4][2], const Unit& u, int wr, int wc, int fr, int fq) const {
        using pg8::HALF;
        if (u.kind == 1) {
            bf16* VBT = (bf16*)(ws + WS_VBT);
#pragma unroll
            for (int bj = 0; bj < 2; ++bj) {
                int b, t; row_bt(256 * u.tb + HALF * bj + 32 * wc + 8 * fq, b, t);
#pragma unroll
                for (int ai = 0; ai < 2; ++ai)
#pragma unroll
                    for (int m = 0; m < 4; ++m) { const int vc = 256 * (u.ta - 3) + HALF * ai + 64 * wr + 16 * m + fr, h = vc >> 6, dv = vc & 63;
                        *(v4u*)(VBT + ((size_t)((b * NH + h) * 64 + dv)) * TK + t) = pack8(acc[ai][bj][m][0], acc[ai][bj][m][1]); }
            }
            return;
        }
        const int pn = u.tb;
        const float2* tab = (const float2*)(ws + WS_ROPE);
#pragma unroll
        for (int ai = 0; ai < 2; ++ai)
#pragma unroll
            for (int m = 0; m < 4; ++m) {
                const int row = 256 * u.ta + HALF * ai + 64 * wr + 16 * m + fr; int b, t; row_bt(row, b, t);
                float qq = 0.f;
#pragma unroll
                for (int bj = 0; bj < 2; ++bj) {
                    const int col = HALF * bj + 32 * wc + 8 * fq;
                    const f32x4 v0 = acc[ai][bj][m][0], v1 = acc[ai][bj][m][1];
                    if (pn == 0) {
                        *(v4u*)((bf16*)(ws + WS_T0) + (size_t)row * 256 + col) = pack8(v0, v1);
                        if (bj == 0) { float q = (v0[0] * v0[0] + v0[1] * v0[1]) + (v0[2] * v0[2] + v0[3] * v0[3]) + (v1[0] * v1[0] + v1[1] * v1[1]) + (v1[2] * v1[2] + v1[3] * v1[3]);
                            q += __shfl_xor(q, 16); q += __shfl_xor(q, 32); if (fq == 0) ((float*)(ws + WS_SSQKV))[row * 4 + wc] = q; }
                        else if (wc == 0) {
                            float v[8] = {v0[0], v0[1], v0[2], v0[3], v1[0], v1[1], v1[2], v1[3]};
                            if (u.ta < 64) rope8(v, fq, t, tab);
                            v4u w; w.x = cvt_pk_bf16(v[0], v[1]); w.y = cvt_pk_bf16(v[2], v[3]); w.z = cvt_pk_bf16(v[4], v[5]); w.w = cvt_pk_bf16(v[6], v[7]);
                            bf16* KA = (bf16*)(dout + DO_KA);
#pragma unroll
                            for (int h = 0; h < NH; ++h) *(v4u*)(KA + ((size_t)(b * NH + h) * TK + t) * 96 + 64 + 8 * fq) = w;
                        }
                    } else if (pn <= 2) {
                        const int kc = 256 * (pn - 1) + col, h = kc >> 6, d = kc & 63;
                        *(v4u*)((bf16*)(ws + WS_KB) + ((size_t)(b * NH + h) * TK + t) * 64 + d) = pack8(v0, v1);
                    } else if (pn == 5) {
                        *(v4u*)((bf16*)(ws + WS_CQ) + (size_t)row * 256 + col) = pack8(v0, v1);
                        qq += (v0[0] * v0[0] + v0[1] * v0[1]) + (v0[2] * v0[2] + v0[3] * v0[3]) + (v1[0] * v1[0] + v1[1] * v1[1]) + (v1[2] * v1[2] + v1[3] * v1[3]);
                    } else if (pn <= 7 || (pn >= 10 && pn <= 11)) {
                        bf16* dst = (bf16*)(ws + (pn <= 7 ? WS_SZA : WS_SZB)) + (size_t)row * 512 + 256 * (pn <= 7 ? pn - 6 : pn - 10) + col;
                        f32x4 a, c2;
#pragma unroll
                        for (int e = 0; e < 4; ++e) { a[e] = siluf_(v0[e]); c2[e] = siluf_(v1[e]); }
                        *(v4u*)dst = pack8(a, c2);
                    } else if (pn <= 9) {
                        const int qc = 256 * (pn - 8) + col, h = qc >> 6, d = qc & 63;
                        *(v4u*)((bf16*)(ws + WS_QB) + ((size_t)(b * NH + h) * SEQ + t) * 64 + d) = pack8(v0 * NA_C2, v1 * NA_C2);
                    } else {
                        bf16* dst = (bf16*)(ws + (pn <= 15 ? WS_SGA : WS_SGB)) + (size_t)row * 1024 + 256 * (pn <= 15 ? pn - 12 : pn - 16) + col;
                        f32x4 a, c2;
#pragma unroll
                        for (int e = 0; e < 4; ++e) { a[e] = sigmoidf_(v0[e]); c2[e] = sigmoidf_(v1[e]); }
                        *(v4u*)dst = pack8(a, c2);
                    }
                }
                if (pn == 5) { qq += __shfl_xor(qq, 16); qq += __shfl_xor(qq, 32); if (fq == 0) ((float*)(ws + WS_SSQQ))[row * 4 + wc] = qq; }
            }
    }
};

struct SchedG23 {
    int first, cnt, c; const char* wsb;
    static constexpr size_t TS = (size_t)256 * 256 * 2;
    __device__ __forceinline__ bool next(int i, Unit& u) const {
        if (c < first) return false;
        const int L = i * cnt + (c - first); if (L >= 448) return false;
        if (L < 192) { u.kind = 0; u.ta = L % 64; u.tb = L / 64; return true; }
        const int k = L - 192, pm = k % 64, pn = k / 64;
        if (pn < 2) { u.kind = 1; u.ta = pm; u.tb = pn; } else { u.kind = 2; u.ta = pn; u.tb = pm; }
        return true;
    }
    __device__ __forceinline__ const char* aptr(const Unit& u) const { const size_t o = (u.kind == 0) ? WS_CQ : (u.kind == 1) ? WS_T0 : WS_WUKV; return wsb + o + (size_t)u.ta * TS; }
    __device__ __forceinline__ const char* bptr(const Unit& u) const { const size_t o = (u.kind == 0) ? WS_WUQ : (u.kind == 1) ? WS_WUKV : WS_T0; return wsb + o + (size_t)u.tb * TS; }
};
struct EpiG23 {
    static constexpr bool PERM = true, AFTER_DRAIN = false;
    unsigned char* ws; unsigned char* dout;
    __device__ __forceinline__ void operator()(const f32x4 (&acc)[2][2][4][2], const Unit& u, int wr, int wc, int fr, int fq) const {
        using pg8::HALF;
        const float* SSQKV = (const float*)(ws + WS_SSQKV);
        if (u.kind == 2) {
            bf16* VAT = (bf16*)(dout + DO_VAT);
#pragma unroll
            for (int bj = 0; bj < 2; ++bj) {
                const int tok0 = 256 * u.tb + HALF * bj + 32 * wc + 8 * fq; int b, t; row_bt(tok0, b, t);
                float rs[8];
                { const f32x4 ss = *(const f32x4*)(SSQKV + (size_t)(tok0 + (fr & 7)) * 4); const float mine = 1.0f / sqrtf(((ss[0] + ss[1]) + (ss[2] + ss[3])) * (1.f / 128.f) + EPS);
#pragma unroll
                  for (int i = 0; i < 8; ++i) rs[i] = __shfl(mine, (fq << 4) + i); }
#pragma unroll
                for (int ai = 0; ai < 2; ++ai)
#pragma unroll
                    for (int m = 0; m < 4; ++m) { const int vc = 256 * (u.ta - 2) + HALF * ai + 64 * wr + 16 * m + fr, h = vc >> 6, dv = vc & 63;
                        f32x4 a = acc[ai][bj][m][0], c2 = acc[ai][bj][m][1];
#pragma unroll
                        for (int e = 0; e < 4; ++e) { a[e] *= rs[e]; c2[e] *= rs[4 + e]; }
                        *(v4u*)(VAT + ((size_t)((b * NH + h) * 64 + dv)) * TK + t) = pack8(a, c2); }
            }
            return;
        }
        const float2* tab = (const float2*)(ws + WS_ROPE);
#pragma unroll
        for (int ai = 0; ai < 2; ++ai)
#pragma unroll
            for (int m = 0; m < 4; ++m) {
                const int row = 256 * u.ta + HALF * ai + 64 * wr + 16 * m + fr; int b, t; row_bt(row, b, t);
                if (u.kind == 0) {
                    const f32x4 ss = *(const f32x4*)((const float*)(ws + WS_SSQQ) + (size_t)row * 4);
                    const float f = MLA_C2 / sqrtf(((ss[0] + ss[1]) + (ss[2] + ss[3])) * (1.f / 256.f) + EPS);
                    bf16* QA = (bf16*)(ws + WS_QA);
#pragma unroll
                    for (int bj = 0; bj < 2; ++bj) {
                        const f32x4 v0 = acc[ai][bj][m][0] * f, v1 = acc[ai][bj][m][1] * f;
                        if (u.tb < 2) { const int qc = 256 * u.tb + HALF * bj + 32 * wc + 8 * fq, h = qc >> 6, d = qc & 63;
                            *(v4u*)(QA + ((size_t)(b * NH + h) * SEQ + t) * 96 + d) = pack8(v0, v1);
                        } else { const int h = 4 * bj + wc;
                            float v[8] = {v0[0], v0[1], v0[2], v0[3], v1[0], v1[1], v1[2], v1[3]};
                            rope8(v, fq, t, tab);
                            v4u w; w.x = cvt_pk_bf16(v[0], v[1]); w.y = cvt_pk_bf16(v[2], v[3]); w.z = cvt_pk_bf16(v[4], v[5]); w.w = cvt_pk_bf16(v[6], v[7]);
                            *(v4u*)(QA + ((size_t)(b * NH + h) * SEQ + t) * 96 + 64 + 8 * fq) = w; }
                    }
                } else {
                    const f32x4 ss = *(const f32x4*)(SSQKV + (size_t)row * 4);
                    const float f = 1.0f / sqrtf(((ss[0] + ss[1]) + (ss[2] + ss[3])) * (1.f / 128.f) + EPS);
                    bf16* KA = (bf16*)(dout + DO_KA);
#pragma unroll
                    for (int bj = 0; bj < 2; ++bj) { const int kc = 256 * u.tb + HALF * bj + 32 * wc + 8 * fq, h = kc >> 6, d = kc & 63;
                        *(v4u*)(KA + ((size_t)(b * NH + h) * TK + t) * 96 + d) = pack8(acc[ai][bj][m][0] * f, acc[ai][bj][m][1] * f); }
                }
            }
    }
};

struct SchedG23C {
    int nC, c; const char* wsb;
    static constexpr size_t TS = (size_t)256 * 256 * 2;
    __device__ __forceinline__ bool next(int i, Unit& u) const {
        if (c >= nC) return false;
        const int k = i * nC + c; if (k >= 16) return false;
        if (k < 8) { u.kind = 1; u.ta = 64 + (k >> 1); u.tb = k & 1; } else { const int kk = k - 8; u.kind = 2; u.ta = 2 + (kk >> 2); u.tb = 64 + (kk & 3); }
        return true;
    }
    __device__ __forceinline__ const char* aptr(const Unit& u) const { const size_t o = (u.kind == 1) ? WS_T0 : WS_WUKV; return wsb + o + (size_t)u.ta * TS; }
    __device__ __forceinline__ const char* bptr(const Unit& u) const { const size_t o = (u.kind == 1) ? WS_WUKV : WS_T0; return wsb + o + (size_t)u.tb * TS; }
};
struct SchedG4 {
    int G, c; const char* OA; const char* OB; const char* WOA; const char* WOB;
    static constexpr size_t TS = (size_t)256 * 512 * 2;
    __device__ __forceinline__ bool next(int j, Unit& u) const {
        const int tile = c + (j >> 1) * G; if (tile >= 256) return false;
        tile_remap(tile, 64, 4, u.ta, u.tb); u.kind = j & 1; return true;
    }
    __device__ __forceinline__ const char* aptr(const Unit& u) const { return (u.kind ? OB : OA) + (size_t)u.ta * TS; }
    __device__ __forceinline__ const char* bptr(const Unit& u) const { return (u.kind ? WOB : WOA) + (size_t)u.tb * TS; }
};
struct EpiG4 {
    static constexpr bool PERM = true, AFTER_DRAIN = false;
    unsigned char* ws; float* scratch;
    __device__ __forceinline__ void operator()(const f32x4 (&acc)[2][2][4][2], const Unit& u, int wr, int wc, int fr, int fq) const {
        using pg8::HALF;
        const bf16* SG = (const bf16*)(ws + (u.kind ? WS_SGB : WS_SGA));
        bf16* Mb = (bf16*)(ws + WS_M);
#pragma unroll
        for (int ai = 0; ai < 2; ++ai) {
            v4u g[4][2], t1[4][2];
#pragma unroll
            for (int m = 0; m < 4; ++m)
#pragma unroll
                for (int bj = 0; bj < 2; ++bj) {
                    const size_t off = (size_t)(256 * u.ta + HALF * ai + 64 * wr + 16 * m + fr) * 1024 + 256 * u.tb + HALF * bj + 32 * wc + 8 * fq;
                    g[m][bj] = *(const v4u*)(SG + off);
                    if (u.kind) t1[m][bj] = *(const v4u*)(Mb + off); else t1[m][bj] = (v4u){0u, 0u, 0u, 0u};
                }
#pragma unroll
            for (int m = 0; m < 4; ++m)
#pragma unroll
                for (int bj = 0; bj < 2; ++bj) {
                    const size_t off = (size_t)(256 * u.ta + HALF * ai + 64 * wr + 16 * m + fr) * 1024 + 256 * u.tb + HALF * bj + 32 * wc + 8 * fq;
                    const v4u gg = g[m][bj], tt = t1[m][bj];
                    f32x4 v0 = acc[ai][bj][m][0], v1 = acc[ai][bj][m][1];
                    v0[0] = v0[0] * bf_lo(gg.x) + bf_lo(tt.x); v0[1] = v0[1] * bf_hi(gg.x) + bf_hi(tt.x); v0[2] = v0[2] * bf_lo(gg.y) + bf_lo(tt.y); v0[3] = v0[3] * bf_hi(gg.y) + bf_hi(tt.y);
                    v1[0] = v1[0] * bf_lo(gg.z) + bf_lo(tt.z); v1[1] = v1[1] * bf_hi(gg.z) + bf_hi(tt.z); v1[2] = v1[2] * bf_lo(gg.w) + bf_lo(tt.w); v1[3] = v1[3] * bf_hi(gg.w) + bf_hi(tt.w);
                    *(v4u*)(Mb + off) = pack8(v0, v1);
                }
        }
    }
};

struct SchedG5 {
    int G, c; const char* M; const char* W;
    static constexpr size_t TS = (size_t)256 * 1024 * 2;
    __device__ __forceinline__ bool next(int i, Unit& u) const { const int L = i * G + c; if (L >= 256) return false; tile_remap(L, 64, 4, u.ta, u.tb); u.kind = 0; return true; }
    __device__ __forceinline__ const char* aptr(const Unit& u) const { return M + (size_t)u.ta * TS; }
    __device__ __forceinline__ const char* bptr(const Unit& u) const { return W + (size_t)u.tb * TS; }
};
struct EpiG5 {
    static constexpr bool PERM = true, AFTER_DRAIN = false;
    unsigned char* ws; const float* x; float* out;
    __device__ __forceinline__ void operator()(const f32x4 (&acc)[2][2][4][2], const Unit& u, int wr, int wc, int fr, int fq) const {
        using pg8::HALF;
        const float* MOD = (const float*)(ws + WS_MOD) + ((256 * u.ta) >> 12) * 3072 + 2048;
        f32x4 gt[2][2];
#pragma unroll
        for (int bj = 0; bj < 2; ++bj) { const int col = 256 * u.tb + HALF * bj + 32 * wc + 8 * fq; gt[bj][0] = *(const f32x4*)(MOD + col); gt[bj][1] = *(const f32x4*)(MOD + col + 4); }
#pragma unroll
        for (int ai = 0; ai < 2; ++ai) {
            f32x4 xa[4][2][2];
#pragma unroll
            for (int m = 0; m < 4; ++m)
#pragma unroll
                for (int bj = 0; bj < 2; ++bj) {
                    const size_t off = (size_t)(256 * u.ta + HALF * ai + 64 * wr + 16 * m + fr) * 1024 + 256 * u.tb + HALF * bj + 32 * wc + 8 * fq;
                    xa[m][bj][0] = *(const f32x4*)(x + off); xa[m][bj][1] = *(const f32x4*)(x + off + 4);
                }
#pragma unroll
            for (int m = 0; m < 4; ++m) {
                const int row = 256 * u.ta + HALF * ai + 64 * wr + 16 * m + fr;
                float q = 0.f;
#pragma unroll
                for (int bj = 0; bj < 2; ++bj) {
                    const size_t off = (size_t)row * 1024 + 256 * u.tb + HALF * bj + 32 * wc + 8 * fq;
                    const f32x4 o0 = xa[m][bj][0] + gt[bj][0] * acc[ai][bj][m][0], o1 = xa[m][bj][1] + gt[bj][1] * acc[ai][bj][m][1];
                    *(f32x4*)(out + off) = o0; *(f32x4*)(out + off + 4) = o1;
                    q += (o0[0] * o0[0] + o0[1] * o0[1]) + (o0[2] * o0[2] + o0[3] * o0[3]) + (o1[0] * o1[0] + o1[1] * o1[1]) + (o1[2] * o1[2] + o1[3] * o1[3]);
                }
                q += __shfl_xor(q, 16); q += __shfl_xor(q, 32);
                if (fq == 0) ((float*)(ws + WS_SSQO))[(size_t)row * 16 + u.tb * 4 + wc] = q;
            }
        }
    }
};

constexpr int CW_PANEL = 8192;
struct EpiG5F {
    static constexpr bool PERM = true, AFTER_DRAIN = true;
    unsigned char* ws; const float* x; float* out; const float* final_g;
    __device__ __forceinline__ void operator()(const f32x4 (&)[2][2][4][2], const Unit&, int, int, int, int) const {}
    __device__ __forceinline__ void fused(f32x4 (&acc)[2][2][4][2], const Unit& u, int wr, int wc, int fr, int fq, LAS unsigned char* lds, int wid, int lane) const {
        using pg8::HALF;
        const float* MOD = (const float*)(ws + WS_MOD) + ((256 * u.ta) >> 12) * 3072 + 2048;
        LAS float* Pq = (LAS float*)lds;
        LAS float* Sr = (LAS float*)(lds + 4096);
        float* slots = (float*)(ws + WS_SSQO);
        unsigned* cnt = (unsigned*)(ws + WS_CTL) + CW_PANEL + 64 * u.ta;
        f32x4 gt[2][2];
#pragma unroll
        for (int bj = 0; bj < 2; ++bj) { const int col = 256 * u.tb + HALF * bj + 32 * wc + 8 * fq; gt[bj][0] = *(const f32x4*)(MOD + col); gt[bj][1] = *(const f32x4*)(MOD + col + 4); }
#pragma unroll
        for (int ai = 0; ai < 2; ++ai) {
            f32x4 xa[4][2][2];
#pragma unroll
            for (int m = 0; m < 4; ++m)
#pragma unroll
                for (int bj = 0; bj < 2; ++bj) {
                    const size_t off = (size_t)(256 * u.ta + HALF * ai + 64 * wr + 16 * m + fr) * 1024 + 256 * u.tb + HALF * bj + 32 * wc + 8 * fq;
                    xa[m][bj][0] = *(const f32x4*)(x + off); xa[m][bj][1] = *(const f32x4*)(x + off + 4);
                }
#pragma unroll
            for (int m = 0; m < 4; ++m) {
                float q = 0.f;
#pragma unroll
                for (int bj = 0; bj < 2; ++bj) {
                    const f32x4 o0 = xa[m][bj][0] + gt[bj][0] * acc[ai][bj][m][0], o1 = xa[m][bj][1] + gt[bj][1] * acc[ai][bj][m][1];
                    acc[ai][bj][m][0] = o0; acc[ai][bj][m][1] = o1;
                    q += (o0[0] * o0[0] + o0[1] * o0[1]) + (o0[2] * o0[2] + o0[3] * o0[3]) + (o1[0] * o1[0] + o1[1] * o1[1]) + (o1[2] * o1[2] + o1[3] * o1[3]);
                }
                q += __shfl_xor(q, 16); q += __shfl_xor(q, 32);
                if (fq == 0) Pq[(HALF * ai + 64 * wr + 16 * m + fr) * 4 + wc] = q;
            }
        }
        asm volatile("s_waitcnt lgkmcnt(0)" ::: "memory"); __builtin_amdgcn_s_barrier(); asm volatile("" ::: "memory");
        const int row = wid * 32 + (lane & 31);
        if (lane < 32) { const float t = (Pq[row * 4 + 0] + Pq[row * 4 + 1]) + (Pq[row * 4 + 2] + Pq[row * 4 + 3]);
            __hip_atomic_store(slots + (size_t)(256 * u.ta + row) * 16 + 4 * u.tb, t, __ATOMIC_RELAXED, __HIP_MEMORY_SCOPE_AGENT); }
        asm volatile("s_waitcnt vmcnt(0)" ::: "memory");
        if (lane == 0) __hip_atomic_fetch_add(cnt, 1u, __ATOMIC_RELAXED, __HIP_MEMORY_SCOPE_AGENT);
        if (wid == 0) {
            unsigned spins = 0;
            while ((unsigned)__builtin_amdgcn_readfirstlane(__hip_atomic_load(cnt, __ATOMIC_RELAXED, __HIP_MEMORY_SCOPE_AGENT)) < 32u) { __builtin_amdgcn_s_sleep(2); if (++spins > (1u << 22)) break; }
            __builtin_amdgcn_fence(__ATOMIC_ACQUIRE, "agent");
        }
        asm volatile("s_waitcnt vmcnt(0) lgkmcnt(0)" ::: "memory"); __builtin_amdgcn_s_barrier(); asm volatile("" ::: "memory");
        if (lane < 32) { const float* sl = slots + (size_t)(256 * u.ta + row) * 16; float t = 0.f;
#pragma unroll
            for (int k = 0; k < 4; ++k) t += __hip_atomic_load(sl + 4 * k, __ATOMIC_RELAXED, __HIP_MEMORY_SCOPE_AGENT);
            Sr[row] = 1.0f / sqrtf(t * (1.f / DM) + EPS); }
        asm volatile("s_waitcnt vmcnt(0) lgkmcnt(0)" ::: "memory"); __builtin_amdgcn_s_barrier(); asm volatile("" ::: "memory");
        f32x4 fg[2][2];
#pragma unroll
        for (int bj = 0; bj < 2; ++bj) { const int col = 256 * u.tb + HALF * bj + 32 * wc + 8 * fq; fg[bj][0] = *(const f32x4*)(final_g + col); fg[bj][1] = *(const f32x4*)(final_g + col + 4); }
#pragma unroll
        for (int ai = 0; ai < 2; ++ai)
#pragma unroll
            for (int m = 0; m < 4; ++m) { const int r = HALF * ai + 64 * wr + 16 * m + fr; const float rs = Sr[r];
#pragma unroll
                for (int bj = 0; bj < 2; ++bj) { const size_t off = (size_t)(256 * u.ta + r) * 1024 + 256 * u.tb + HALF * bj + 32 * wc + 8 * fq;
                    *(f32x4*)(out + off) = acc[ai][bj][m][0] * rs * fg[bj][0]; *(f32x4*)(out + off + 4) = acc[ai][bj][m][1] * rs * fg[bj][1]; } }
    }
};

__device__ __forceinline__ void p7_final(const Ptrs& P, int lane, int wave, int G) {
    const int gw = blockIdx.x * NWAVES + wave, NGW = G * NWAVES;
    const float* SSQO = (const float*)(P.ws + WS_SSQO);
    for (int row = gw; row < MLAT; row += NGW) {
        float s = 0.f;
        { const f32x4* p = (const f32x4*)(SSQO + (size_t)row * 16); const f32x4 a = p[0], b = p[1], c = p[2], d = p[3];
          s = ((a[0] + a[1]) + (a[2] + a[3])) + ((b[0] + b[1]) + (b[2] + b[3])) + ((c[0] + c[1]) + (c[2] + c[3])) + ((d[0] + d[1]) + (d[2] + d[3])); }
        const float rstd = 1.0f / sqrtf(s * (1.f / DM) + EPS);
        f32x4* o4 = (f32x4*)(P.out + (size_t)row * DM) + lane;
        const f32x4* g4 = (const f32x4*)P.final_g + lane;
#pragma unroll
        for (int j = 0; j < 4; ++j) { f32x4 v = o4[64 * j]; const f32x4 g = g4[64 * j]; v = v * rstd * g; o4[64 * j] = v; }
    }
}

__device__ __forceinline__ int crow(int r, int hi) { return (r & 3) + 8 * (r >> 2) + 4 * hi; }
constexpr int VROW = 136;
constexpr int ATT_RPB_OFF = 96 * 1024;

template <int DK, bool NA>
__device__ __forceinline__ void attn_unit(LAS unsigned char* lds, const bf16* Qg, const bf16* Kg, const bf16* Vtg, bf16* SZ, const float* rpb, int b, int h, int qblk, int tid, int lane, int wave) {
    constexpr int KROW = DK * 2 + 16, KCH = DK / 8  , NKC = 64 * KCH, KT_BYTES = 64 * KROW, VT_BYTES = 64 * VROW, BUF = KT_BYTES + VT_BYTES;
    const int r32 = lane & 31, hi = lane >> 5;
    const int q0 = qblk * 256;
    const bf16* Kh = Kg + (size_t)(b * NH + h) * TK * DK;
    const bf16* Vh = Vtg + (size_t)(b * NH + h) * 64 * TK;
    int ntiles, kr_lo = 0, nwin = 0, rq = 0, cq = 0, rs = 0, cs = 0;
    if (NA) { const int r0 = qblk * 4; auto rst = [](int r) { int s = r - 4; s = s < 0 ? 0 : s; return s > 56 ? 56 : s; };
        kr_lo = rst(r0); nwin = rst(r0 + 3) + 8 - kr_lo; ntiles = nwin + 4;
        rq = r0 + (wave >> 1); cq = 32 * (wave & 1) + r32; rs = rst(rq); cs = cq - 8; cs = cs < 0 ? 0 : cs; cs = cs > 48 ? 48 : cs;
        LAS float* bt = (LAS float*)(lds + ATT_RPB_OFF);
        for (int i = tid; i < 15 * 31; i += 512) bt[i] = rpb[h * 465 + i] * LOG2E;
    } else ntiles = TK / 64;
    bf16x8 qf[DK / 16];
    { const bf16* qp = Qg + ((size_t)(b * NH + h) * SEQ + q0 + 32 * wave + r32) * DK + 8 * hi;
#pragma unroll
      for (int s = 0; s < DK / 16; ++s) qf[s] = *(const bf16x8*)(qp + 16 * s); }
    auto tile_tok = [&](int j) -> int { if (NA) return j < nwin ? (kr_lo + j) * 64 : SEQ + (j - nwin) * 64; return j * 64; };
    v4u kreg0, kreg1, vreg;
    const int kc0 = tid, kc1 = tid + 512;
    auto gload = [&](int j) { const int tok = tile_tok(j);
        const unsigned char* kb = (const unsigned char*)(Kh + (size_t)tok * DK);
        kreg0 = *(const v4u*)(kb + (size_t)kc0 * 16);
        if (kc1 < NKC) kreg1 = *(const v4u*)(kb + (size_t)kc1 * 16);
        vreg = *(const v4u*)((const unsigned char*)(Vh + (size_t)(tid >> 3) * TK + tok) + (tid & 7) * 16); };
    auto lstore = [&](int buf) { LAS unsigned char* base = lds + buf * BUF;
        *(LAS v4u*)(base + (kc0 / KCH) * KROW + (kc0 % KCH) * 16) = kreg0;
        if (kc1 < NKC) *(LAS v4u*)(base + (kc1 / KCH) * KROW + (kc1 % KCH) * 16) = kreg1;
        LAS unsigned char* vp = base + KT_BYTES + (tid >> 3) * VROW + (tid & 7) * 16;
        *(LAS v2u*)vp = (v2u){vreg.x, vreg.y}; *(LAS v2u*)(vp + 8) = (v2u){vreg.z, vreg.w}; };
    float m_run = -1e30f, l_run = 0.f;
    f32x16 o0 = {}, o1 = {};
    gload(0); lstore(0); __syncthreads();
    for (int j = 0; j < ntiles; ++j) {
        const bool more = (j + 1 < ntiles);
        if (more) gload(j + 1);
        bool active = true; int krow = 0;
        if (NA && j < nwin) { krow = kr_lo + j; active = (krow >= rs && krow < rs + 8); }
        if (active) {
            const LAS unsigned char* kb = lds + (j & 1) * BUF;
            const LAS unsigned char* vb = kb + KT_BYTES;
            f32x16 s0 = {}, s1 = {};
#pragma unroll
            for (int s = 0; s < DK / 16; ++s) {
                const bf16x8 k0 = *(const LAS bf16x8*)(kb + r32 * KROW + (16 * s + 8 * hi) * 2);
                const bf16x8 k1 = *(const LAS bf16x8*)(kb + (32 + r32) * KROW + (16 * s + 8 * hi) * 2);
                s0 = __builtin_amdgcn_mfma_f32_32x32x16_bf16(k0, qf[s], s0, 0, 0, 0);
                s1 = __builtin_amdgcn_mfma_f32_32x32x16_bf16(k1, qf[s], s1, 0, 0, 0);
            }
            if (NA && j < nwin) {
                const LAS float* bt = (const LAS float*)(lds + ATT_RPB_OFF) + (krow - rq + 7) * 31 + (15 - cq);
#pragma unroll
                for (int i = 0; i < 16; ++i) {
                    const int kc = crow(i, hi);
                    { const bool ok = (unsigned)(kc - cs) < 16u; const float bv = bt[ok ? kc : cq]; s0[i] = ok ? s0[i] + bv : -1e30f; }
                    { const int kc2 = kc + 32; const bool ok = (unsigned)(kc2 - cs) < 16u; const float bv = bt[ok ? kc2 : cq]; s1[i] = ok ? s1[i] + bv : -1e30f; }
                }
            }
            float mx = fmaxf(s0[0], s1[0]);
#pragma unroll
            for (int i = 1; i < 16; ++i) mx = fmaxf(mx, fmaxf(s0[i], s1[i]));
            mx = fmaxf(mx, __shfl_xor(mx, 32));
            if (__any(mx > m_run + 4.0f)) {
                const float mnew = fmaxf(m_run, mx);
                const float alpha = __builtin_amdgcn_exp2f(m_run - mnew);
                m_run = mnew; l_run *= alpha;
#pragma unroll
                for (int i = 0; i < 16; ++i) { o0[i] *= alpha; o1[i] *= alpha; }
            }
            float ls = 0.f;
#pragma unroll
            for (int i = 0; i < 16; ++i) { s0[i] = __builtin_amdgcn_exp2f(s0[i] - m_run); s1[i] = __builtin_amdgcn_exp2f(s1[i] - m_run); ls += s0[i] + s1[i]; }
            l_run += ls;
            bf16x8 pb[2][2];
#pragma unroll
            for (int kk = 0; kk < 2; ++kk) {
                v4u w0, w1;
                w0.x = cvt_pk_bf16(s0[8 * kk + 0], s0[8 * kk + 1]); w0.y = cvt_pk_bf16(s0[8 * kk + 2], s0[8 * kk + 3]); w0.z = cvt_pk_bf16(s0[8 * kk + 4], s0[8 * kk + 5]); w0.w = cvt_pk_bf16(s0[8 * kk + 6], s0[8 * kk + 7]);
                w1.x = cvt_pk_bf16(s1[8 * kk + 0], s1[8 * kk + 1]); w1.y = cvt_pk_bf16(s1[8 * kk + 2], s1[8 * kk + 3]); w1.z = cvt_pk_bf16(s1[8 * kk + 4], s1[8 * kk + 5]); w1.w = cvt_pk_bf16(s1[8 * kk + 6], s1[8 * kk + 7]);
                pb[0][kk] = __builtin_bit_cast(bf16x8, w0); pb[1][kk] = __builtin_bit_cast(bf16x8, w1);
            }
#pragma unroll
            for (int u = 0; u < 2; ++u)
#pragma unroll
                for (int kk = 0; kk < 2; ++kk) {
                    const int koff = (32 * u + 16 * kk + 4 * hi) * 2;
                    const LAS unsigned char* v0p = vb + r32 * VROW + koff;
                    const LAS unsigned char* v1p = vb + (32 + r32) * VROW + koff;
                    const s16x4 a0 = *(const LAS s16x4*)v0p, a1 = *(const LAS s16x4*)(v0p + 16);
                    const s16x4 c0 = *(const LAS s16x4*)v1p, c1 = *(const LAS s16x4*)(v1p + 16);
                    const bf16x8 vf0 = {a0[0], a0[1], a0[2], a0[3], a1[0], a1[1], a1[2], a1[3]};
                    const bf16x8 vf1 = {c0[0], c0[1], c0[2], c0[3], c1[0], c1[1], c1[2], c1[3]};
                    o0 = __builtin_amdgcn_mfma_f32_32x32x16_bf16(vf0, pb[u][kk], o0, 0, 0, 0);
                    o1 = __builtin_amdgcn_mfma_f32_32x32x16_bf16(vf1, pb[u][kk], o1, 0, 0, 0);
                }
        }
        if (more) lstore((j + 1) & 1);
        __syncthreads();
    }
    const float lt = l_run + __shfl_xor(l_run, 32);
    const float inv = 1.0f / lt;
    bf16* zp = SZ + ((size_t)(b * SEQ + q0 + 32 * wave + r32)) * 512 + h * 64;
#pragma unroll
    for (int dt = 0; dt < 2; ++dt)
#pragma unroll
        for (int g = 0; g < 4; ++g) {
            bf16* p = zp + 32 * dt + 8 * g + 4 * hi;
            const v2u z = *(const v2u*)p;
            const f32x16& o = dt ? o1 : o0;
            v2u w; w.x = cvt_pk_bf16(o[4 * g + 0] * inv * bf_lo(z.x), o[4 * g + 1] * inv * bf_hi(z.x)); w.y = cvt_pk_bf16(o[4 * g + 2] * inv * bf_lo(z.y), o[4 * g + 3] * inv * bf_hi(z.y));
            *(v2u*)p = w;
        }
}


__device__ __forceinline__ void attn_unit_na2(LAS unsigned char* lds, const bf16* Qg, const bf16* Kg, const bf16* Vtg, bf16* SZ, const float* rpb, int b, int h, int qblk, int tid, int lane, int wave) {
    constexpr int DK = 64; constexpr bool NA = true;
    constexpr int KROW = DK * 2 + 16, KCH = DK / 8  , NKC = 64 * KCH, KT_BYTES = 64 * KROW, VT_BYTES = 64 * VROW, SUB = KT_BYTES + VT_BYTES, BUF = 2 * SUB;
    const int r32 = lane & 31, hi = lane >> 5;
    const int q0 = qblk * 256;
    const bf16* Kh = Kg + (size_t)(b * NH + h) * TK * DK;
    const bf16* Vh = Vtg + (size_t)(b * NH + h) * 64 * TK;
    int ntiles, kr_lo = 0, nwin = 0, rq = 0, cq = 0, rs = 0, cs = 0;
    unsigned vmask0 = 0u, vmask1 = 0u;
    if (NA) { const int r0 = qblk * 4; auto rst = [](int r) { int s = r - 4; s = s < 0 ? 0 : s; return s > 56 ? 56 : s; };
        kr_lo = rst(r0); nwin = rst(r0 + 3) + 8 - kr_lo; ntiles = nwin + 4;
        rq = r0 + (wave >> 1); cq = 32 * (wave & 1) + r32; rs = rst(rq); cs = cq - 8; cs = cs < 0 ? 0 : cs; cs = cs > 48 ? 48 : cs;
        for (int i = 0; i < 16; ++i) { const int kc = crow(i, hi); vmask0 |= ((unsigned)(kc - cs) < 16u ? 1u : 0u) << i; vmask1 |= ((unsigned)(kc + 32 - cs) < 16u ? 1u : 0u) << i; }
        LAS float* bt = (LAS float*)(lds + ATT_RPB_OFF);
        for (int i = tid; i < 15 * 31; i += 512) bt[i] = rpb[h * 465 + i] * LOG2E;
    } else ntiles = TK / 64;
    bf16x8 qf[DK / 16];
    { const bf16* qp = Qg + ((size_t)(b * NH + h) * SEQ + q0 + 32 * wave + r32) * DK + 8 * hi;
#pragma unroll
      for (int s = 0; s < DK / 16; ++s) qf[s] = *(const bf16x8*)(qp + 16 * s); }
    auto tile_tok = [&](int j) -> int { if (NA) return j < nwin ? (kr_lo + j) * 64 : SEQ + (j - nwin) * 64; return j * 64; };
    v4u kreg[2], vreg[2];
    const int kc0 = tid;
    auto gload = [&](int jp) {
#pragma unroll
        for (int sub = 0; sub < 2; ++sub) { const int j = 2 * jp + sub; if (j < ntiles) { const int tok = tile_tok(j);
            kreg[sub] = *(const v4u*)((const unsigned char*)(Kh + (size_t)tok * DK) + (size_t)kc0 * 16);
            vreg[sub] = *(const v4u*)((const unsigned char*)(Vh + (size_t)(tid >> 3) * TK + tok) + (tid & 7) * 16); } } };
    auto lstore = [&](int buf, int jp) {
#pragma unroll
        for (int sub = 0; sub < 2; ++sub) { if (2 * jp + sub < ntiles) { LAS unsigned char* base = lds + buf * BUF + sub * SUB;
            *(LAS v4u*)(base + (kc0 / KCH) * KROW + (kc0 % KCH) * 16) = kreg[sub];
            LAS unsigned char* vp = base + KT_BYTES + (tid >> 3) * VROW + (tid & 7) * 16;
            *(LAS v2u*)vp = (v2u){vreg[sub].x, vreg[sub].y}; *(LAS v2u*)(vp + 8) = (v2u){vreg[sub].z, vreg[sub].w}; } } };
    float m_run = -1e30f, l_run = 0.f;
    f32x16 o0 = {}, o1 = {};
    const int npairs = (ntiles + 1) >> 1;
    gload(0); lstore(0, 0); __syncthreads();
    for (int jp = 0; jp < npairs; ++jp) {
        const bool more = (jp + 1 < npairs);
        if (more) gload(jp + 1);
#pragma unroll
        for (int sub = 0; sub < 2; ++sub) {
        const int j = 2 * jp + sub;
        bool active = (j < ntiles); int krow = 0;
        if (NA && j < nwin) { krow = kr_lo + j; active = (krow >= rs && krow < rs + 8); }
        if (active) {
            const LAS unsigned char* kb = lds + (jp & 1) * BUF + sub * SUB;
            const LAS unsigned char* vb = kb + KT_BYTES;
            f32x16 s0 = {}, s1 = {};
#pragma unroll
            for (int s = 0; s < DK / 16; ++s) {
                const bf16x8 k0 = *(const LAS bf16x8*)(kb + r32 * KROW + (16 * s + 8 * hi) * 2);
                const bf16x8 k1 = *(const LAS bf16x8*)(kb + (32 + r32) * KROW + (16 * s + 8 * hi) * 2);
                s0 = __builtin_amdgcn_mfma_f32_32x32x16_bf16(k0, qf[s], s0, 0, 0, 0);
                s1 = __builtin_amdgcn_mfma_f32_32x32x16_bf16(k1, qf[s], s1, 0, 0, 0);
            }
            if (NA && j < nwin) {
                const LAS float* bt = (const LAS float*)(lds + ATT_RPB_OFF) + (krow - rq + 7) * 31 + (15 - cq);
#pragma unroll
                for (int i = 0; i < 16; ++i) {
                    const LAS float* bp = bt + 4 * hi;
                    const int kci = (i & 3) + 8 * (i >> 2);
                    { const float bv = bp[kci]; s0[i] = ((vmask0 >> i) & 1u) ? s0[i] + bv : -1e30f; }
                    { const float bv = bp[kci + 32]; s1[i] = ((vmask1 >> i) & 1u) ? s1[i] + bv : -1e30f; }
                }
            }
            float mx = fmaxf(s0[0], s1[0]);
#pragma unroll
            for (int i = 1; i < 16; ++i) mx = fmaxf(mx, fmaxf(s0[i], s1[i]));
            mx = fmaxf(mx, __shfl_xor(mx, 32));
            if (__any(mx > m_run + 4.0f)) {
                const float mnew = fmaxf(m_run, mx);
                const float alpha = __builtin_amdgcn_exp2f(m_run - mnew);
                m_run = mnew; l_run *= alpha;
#pragma unroll
                for (int i = 0; i < 16; ++i) { o0[i] *= alpha; o1[i] *= alpha; }
            }
            float ls = 0.f;
#pragma unroll
            for (int i = 0; i < 16; ++i) { s0[i] = __builtin_amdgcn_exp2f(s0[i] - m_run); s1[i] = __builtin_amdgcn_exp2f(s1[i] - m_run); ls += s0[i] + s1[i]; }
            l_run += ls;
            bf16x8 pb[2][2];
#pragma unroll
            for (int kk = 0; kk < 2; ++kk) {
                v4u w0, w1;
                w0.x = cvt_pk_bf16(s0[8 * kk + 0], s0[8 * kk + 1]); w0.y = cvt_pk_bf16(s0[8 * kk + 2], s0[8 * kk + 3]); w0.z = cvt_pk_bf16(s0[8 * kk + 4], s0[8 * kk + 5]); w0.w = cvt_pk_bf16(s0[8 * kk + 6], s0[8 * kk + 7]);
                w1.x = cvt_pk_bf16(s1[8 * kk + 0], s1[8 * kk + 1]); w1.y = cvt_pk_bf16(s1[8 * kk + 2], s1[8 * kk + 3]); w1.z = cvt_pk_bf16(s1[8 * kk + 4], s1[8 * kk + 5]); w1.w = cvt_pk_bf16(s1[8 * kk + 6], s1[8 * kk + 7]);
                pb[0][kk] = __builtin_bit_cast(bf16x8, w0); pb[1][kk] = __builtin_bit_cast(bf16x8, w1);
            }
#pragma unroll
            for (int u = 0; u < 2; ++u)
#pragma unroll
                for (int kk = 0; kk < 2; ++kk) {
                    const int koff = (32 * u + 16 * kk + 4 * hi) * 2;
                    const LAS unsigned char* v0p = vb + r32 * VROW + koff;
                    const LAS unsigned char* v1p = vb + (32 + r32) * VROW + koff;
                    const s16x4 a0 = *(const LAS s16x4*)v0p, a1 = *(const LAS s16x4*)(v0p + 16);
                    const s16x4 c0 = *(const LAS s16x4*)v1p, c1 = *(const LAS s16x4*)(v1p + 16);
                    const bf16x8 vf0 = {a0[0], a0[1], a0[2], a0[3], a1[0], a1[1], a1[2], a1[3]};
                    const bf16x8 vf1 = {c0[0], c0[1], c0[2], c0[3], c1[0], c1[1], c1[2], c1[3]};
                    o0 = __builtin_amdgcn_mfma_f32_32x32x16_bf16(vf0, pb[u][kk], o0, 0, 0, 0);
                    o1 = __builtin_amdgcn_mfma_f32_32x32x16_bf16(vf1, pb[u][kk], o1, 0, 0, 0);
                }
        }
        }
        if (more) lstore((jp + 1) & 1, jp + 1);
        __syncthreads();
    }
    const float lt = l_run + __shfl_xor(l_run, 32);
    const float inv = 1.0f / lt;
    bf16* zp = SZ + ((size_t)(b * SEQ + q0 + 32 * wave + r32)) * 512 + h * 64;
#pragma unroll
    for (int dt = 0; dt < 2; ++dt)
#pragma unroll
        for (int g = 0; g < 4; ++g) {
            bf16* p = zp + 32 * dt + 8 * g + 4 * hi;
            const v2u z = *(const v2u*)p;
            const f32x16& o = dt ? o1 : o0;
            v2u w; w.x = cvt_pk_bf16(o[4 * g + 0] * inv * bf_lo(z.x), o[4 * g + 1] * inv * bf_hi(z.x)); w.y = cvt_pk_bf16(o[4 * g + 2] * inv * bf_lo(z.y), o[4 * g + 3] * inv * bf_hi(z.y));
            *(v2u*)p = w;
        }
}


__device__ __forceinline__ void attn_unit_mla2(LAS unsigned char* lds, const bf16* Qg, const bf16* Kg, const bf16* Vtg, bf16* SZ, int b, int h, int qblk, int tid, int lane, int wave) {
    constexpr int DK = 96, KROW = DK * 2 + 16, KCH = DK / 8, NKC = 64 * KCH, KT_BYTES = 64 * KROW, VT_BYTES = 64 * VROW, SUB = KT_BYTES + VT_BYTES, BUF = 2 * SUB;
    const int r32 = lane & 31, hi = lane >> 5;
    const int q0 = qblk * 256;
    const bf16* Kh = Kg + (size_t)(b * NH + h) * TK * DK;
    const bf16* Vh = Vtg + (size_t)(b * NH + h) * 64 * TK;
    constexpr int ntiles = TK / 128;
    bf16x8 qf[DK / 16];
    { const bf16* qp = Qg + ((size_t)(b * NH + h) * SEQ + q0 + 32 * wave + r32) * DK + 8 * hi;
#pragma unroll
      for (int s = 0; s < DK / 16; ++s) qf[s] = *(const bf16x8*)(qp + 16 * s); }
    v4u kreg[2][2], vreg[2];
    const int kc0 = tid, kc1 = tid + 512;
    auto gload = [&](int j) {
#pragma unroll
        for (int sub = 0; sub < 2; ++sub) { const int tok = j * 128 + 64 * sub;
            const unsigned char* kb = (const unsigned char*)(Kh + (size_t)tok * DK);
            kreg[sub][0] = *(const v4u*)(kb + (size_t)kc0 * 16);
            if (kc1 < NKC) kreg[sub][1] = *(const v4u*)(kb + (size_t)kc1 * 16);
            vreg[sub] = *(const v4u*)((const unsigned char*)(Vh + (size_t)(tid >> 3) * TK + tok) + (tid & 7) * 16); } };
    auto lstore = [&](int buf) {
#pragma unroll
        for (int sub = 0; sub < 2; ++sub) { LAS unsigned char* base = lds + buf * BUF + sub * SUB;
            *(LAS v4u*)(base + (kc0 / KCH) * KROW + (kc0 % KCH) * 16) = kreg[sub][0];
            if (kc1 < NKC) *(LAS v4u*)(base + (kc1 / KCH) * KROW + (kc1 % KCH) * 16) = kreg[sub][1];
            LAS unsigned char* vp = base + KT_BYTES + (tid >> 3) * VROW + (tid & 7) * 16;
            *(LAS v2u*)vp = (v2u){vreg[sub].x, vreg[sub].y}; *(LAS v2u*)(vp + 8) = (v2u){vreg[sub].z, vreg[sub].w}; } };
    float m_run = 0.f, l_run = 0.f;
    f32x16 o0 = {}, o1 = {};
    gload(0); lstore(0); __syncthreads();
    for (int j = 0; j < ntiles; ++j) {
        const bool more = (j + 1 < ntiles);
        if (more) gload(j + 1);
        const LAS unsigned char* tb = lds + (j & 1) * BUF;
        f32x16 s[2][2];
        f32x16 negm;
#pragma unroll
        for (int i = 0; i < 16; ++i) negm[i] = -m_run;
        const LAS unsigned char* kp0 = tb + r32 * KROW + 16 * hi;
        const LAS unsigned char* vp0 = tb + KT_BYTES + r32 * VROW + 8 * hi;
#define KFRAG(sub, u, st) (*(const LAS bf16x8*)(kp0 + (sub) * SUB + (u) * 32 * KROW + (st) * 32))
        bf16x8 ka[DK / 16][2], kb2[DK / 16][2];
#pragma unroll
        for (int st = 0; st < DK / 16; ++st) { ka[st][0] = KFRAG(0, 0, st); ka[st][1] = KFRAG(0, 1, st); }
        __builtin_amdgcn_sched_barrier(0);
#pragma unroll
        for (int st = 0; st < DK / 16; ++st) {
            kb2[st][0] = KFRAG(1, 0, st); kb2[st][1] = KFRAG(1, 1, st);
            s[0][0] = __builtin_amdgcn_mfma_f32_32x32x16_bf16(ka[st][0], qf[st], st == 0 ? negm : s[0][0], 0, 0, 0);
            s[0][1] = __builtin_amdgcn_mfma_f32_32x32x16_bf16(ka[st][1], qf[st], st == 0 ? negm : s[0][1], 0, 0, 0);
        }
        __builtin_amdgcn_sched_barrier(0);
        s16x4 va[2][2][2][2];
#define VFRAG(sub, u, kk, dt, half) (*(const LAS s16x4*)(vp0 + (sub) * SUB + (dt) * 32 * VROW + (32 * (u) + 16 * (kk)) * 2 + (half) * 16))
#pragma unroll
        for (int u = 0; u < 2; ++u)
#pragma unroll
            for (int kk = 0; kk < 2; ++kk)
#pragma unroll
                for (int dt = 0; dt < 2; ++dt) { va[u][kk][dt][0] = VFRAG(0, u, kk, dt, 0); va[u][kk][dt][1] = VFRAG(0, u, kk, dt, 1); }
#pragma unroll
        for (int st = 0; st < DK / 16; ++st) {
            s[1][0] = __builtin_amdgcn_mfma_f32_32x32x16_bf16(kb2[st][0], qf[st], st == 0 ? negm : s[1][0], 0, 0, 0);
            s[1][1] = __builtin_amdgcn_mfma_f32_32x32x16_bf16(kb2[st][1], qf[st], st == 0 ? negm : s[1][1], 0, 0, 0);
        }
        __builtin_amdgcn_sched_barrier(0);
        float mx = fmaxf(fmaxf(s[0][0][0], s[0][1][0]), fmaxf(s[1][0][0], s[1][1][0]));
#pragma unroll
        for (int i = 1; i < 16; ++i) mx = fmaxf(mx, fmaxf(fmaxf(s[0][0][i], s[0][1][i]), fmaxf(s[1][0][i], s[1][1][i])));
        mx = fmaxf(mx, __shfl_xor(mx, 32));
        if (j == 0 || __any(mx > 4.0f)) {
            const float d = (j == 0) ? mx : fmaxf(mx, 0.f);
            const float alpha = (j == 0) ? 0.f : __builtin_amdgcn_exp2f(-d);
            m_run += d; l_run *= alpha;
#pragma unroll
            for (int i = 0; i < 16; ++i) { o0[i] *= alpha; o1[i] *= alpha; }
#pragma unroll
            for (int sub = 0; sub < 2; ++sub)
#pragma unroll
                for (int u = 0; u < 2; ++u)
#pragma unroll
                    for (int i = 0; i < 16; ++i) s[sub][u][i] -= d;
        }
        float ls = 0.f;
#pragma unroll
        for (int sub = 0; sub < 2; ++sub)
#pragma unroll
            for (int u = 0; u < 2; ++u)
#pragma unroll
                for (int i = 0; i < 16; ++i) { s[sub][u][i] = __builtin_amdgcn_exp2f(s[sub][u][i]); ls += s[sub][u][i]; }
        l_run += ls;
        __builtin_amdgcn_sched_barrier(0);
        s16x4 vb2[2][2][2][2];
#define PFRAG(sub, u, kk) ({ v4u w_; const f32x16& sv_ = s[sub][u]; w_.x = cvt_pk_bf16(sv_[8 * (kk) + 0], sv_[8 * (kk) + 1]); w_.y = cvt_pk_bf16(sv_[8 * (kk) + 2], sv_[8 * (kk) + 3]); \
            w_.z = cvt_pk_bf16(sv_[8 * (kk) + 4], sv_[8 * (kk) + 5]); w_.w = cvt_pk_bf16(sv_[8 * (kk) + 6], sv_[8 * (kk) + 7]); __builtin_bit_cast(bf16x8, w_); })
#define V8(a_) ((bf16x8){(a_)[0][0], (a_)[0][1], (a_)[0][2], (a_)[0][3], (a_)[1][0], (a_)[1][1], (a_)[1][2], (a_)[1][3]})
#pragma unroll
        for (int u = 0; u < 2; ++u)
#pragma unroll
            for (int kk = 0; kk < 2; ++kk) {
#pragma unroll
                for (int dt = 0; dt < 2; ++dt) { vb2[u][kk][dt][0] = VFRAG(1, u, kk, dt, 0); vb2[u][kk][dt][1] = VFRAG(1, u, kk, dt, 1); }
                const bf16x8 pb = PFRAG(0, u, kk);
                o0 = __builtin_amdgcn_mfma_f32_32x32x16_bf16(V8(va[u][kk][0]), pb, o0, 0, 0, 0);
                o1 = __builtin_amdgcn_mfma_f32_32x32x16_bf16(V8(va[u][kk][1]), pb, o1, 0, 0, 0);
            }
        __builtin_amdgcn_sched_barrier(0);
#pragma unroll
        for (int u = 0; u < 2; ++u)
#pragma unroll
            for (int kk = 0; kk < 2; ++kk) {
                const bf16x8 pb = PFRAG(1, u, kk);
                o0 = __builtin_amdgcn_mfma_f32_32x32x16_bf16(V8(vb2[u][kk][0]), pb, o0, 0, 0, 0);
                o1 = __builtin_amdgcn_mfma_f32_32x32x16_bf16(V8(vb2[u][kk][1]), pb, o1, 0, 0, 0);
            }
#undef KFRAG
#undef VFRAG
#undef PFRAG
#undef V8
        if (more) lstore((j + 1) & 1);
        __syncthreads();
    }
    const float lt = l_run + __shfl_xor(l_run, 32);
    const float inv = 1.0f / lt;
    bf16* zp = SZ + ((size_t)(b * SEQ + q0 + 32 * wave + r32)) * 512 + h * 64;
#pragma unroll
    for (int dt = 0; dt < 2; ++dt)
#pragma unroll
        for (int g = 0; g < 4; ++g) {
            bf16* p = zp + 32 * dt + 8 * g + 4 * hi;
            const v2u z = *(const v2u*)p;
            const f32x16& o = dt ? o1 : o0;
            v2u w; w.x = cvt_pk_bf16(o[4 * g + 0] * inv * bf_lo(z.x), o[4 * g + 1] * inv * bf_hi(z.x)); w.y = cvt_pk_bf16(o[4 * g + 2] * inv * bf_lo(z.y), o[4 * g + 3] * inv * bf_hi(z.y));
            *(v2u*)p = w;
        }
}

constexpr int CW_CTXKV = 12288;
__device__ __forceinline__ void p4_attention(const Ptrs& P, LAS unsigned char* lds, int tid, int lane, int wave, int G) {
    const int bx = blockIdx.x; const int vcu = (G % 8 == 0) ? (bx % 8) * (G / 8) + bx / 8 : bx;
    for (int u = vcu; u < 512; u += G) { const int bh = u >> 4, qb = u & 15;
        attn_unit_na2(lds, (const bf16*)(P.ws + WS_QB), (const bf16*)(P.ws + WS_KB), (const bf16*)(P.ws + WS_VBT), (bf16*)(P.ws + WS_SZB), P.rpb, bh >> 3, bh & 7, qb, tid, lane, wave); }
    if (tid == 0) { unsigned* cnt = (unsigned*)(P.ws + WS_CTL) + CW_CTXKV; unsigned spins = 0;
        while (__hip_atomic_load(cnt, __ATOMIC_RELAXED, __HIP_MEMORY_SCOPE_AGENT) < 16u) { __builtin_amdgcn_s_sleep(2); if (++spins > (1u << 22)) break; }
        __builtin_amdgcn_fence(__ATOMIC_ACQUIRE, "agent"); asm volatile("s_waitcnt vmcnt(0)" ::: "memory"); }
    __syncthreads();
    for (int u = vcu; u < 512; u += G) { const int bh = u >> 4, qb = u & 15;
        attn_unit_mla2(lds, (const bf16*)(P.ws + WS_QA), (const bf16*)((unsigned char*)P.out + DO_KA), (const bf16*)((unsigned char*)P.out + DO_VAT), (bf16*)(P.ws + WS_SZA), bh >> 3, bh & 7, qb, tid, lane, wave); }
}

struct Args { Ptrs p; int ph_lo, ph_hi; };
constexpr int N_PHASES = 8;
__global__ void __launch_bounds__(NWAVES * 64, 2) mk_fwd(Args args) {
    extern __shared__ __attribute__((aligned(16))) unsigned char lds_raw[];
    LAS unsigned char* lds = (LAS unsigned char*)lds_raw;
    const Ptrs& P = args.p;
    const int tid = threadIdx.x, lane = tid & 63, wave = __builtin_amdgcn_readfirstlane(tid >> 6);
    const int G = gridDim.x;
    volatile LAS unsigned* MISC = (volatile LAS unsigned*)(lds + MISC_OFF);
    for (int u = tid; u < 32; u += NWAVES * 64) MISC[u] = 0u;
    __syncthreads();
    XcdBarrier bar; bar.bar = (unsigned*)(P.ws + WS_CTL) + CW_BAR; bar.x = 0; bar.st = nullptr;
    if (MK_N_LAUNCHES == 1) bar = xcd_barrier_post((unsigned*)(P.ws + WS_CTL) + CW_BAR, MISC + 8);
    const int lo = args.ph_lo, hi = args.ph_hi;
    int K1024 = 1024, K512 = 512, K256 = 256; asm volatile("" : "+s"(K1024), "+s"(K512), "+s"(K256));
#ifndef PH_MASK
#define PH_MASK 0xff
#endif
#define IN(k) (((PH_MASK >> (k)) & 1) && lo <= (k) && (k) < hi)
#define SEAM(k) do { if (IN(k) && IN((k) + 1)) xcd_barrier(bar); } while (0)
    unsigned char* ws = P.ws; unsigned char* dout = (unsigned char*)P.out;

    if (IN(0)) { p0_gemv(P, lds, tid, lane, wave, G); }
    SEAM(0);
    if (IN(1)) { p0_weights(P, lds, tid, lane, wave, G); p1_hconv(P, lane, wave, G); }
    SEAM(1);
    if (IN(2)) { SchedG1 S{G, (int)blockIdx.x, (const char*)(ws + WS_H), (const char*)(ws + WS_WIN)}; EpiG1 E{ws, dout};
        pg8::gemm_phase<EpiG1, SchedG1, true, true>(lds, K1024, S, E); }
    SEAM(2);
    const int nCtx = (G >= 64) ? 20 : G, g23_first = (G >= 64) ? 20 : 0;
    if (IN(3)) { { SchedG1C S{nCtx, (int)blockIdx.x, (const char*)(ws + WS_H), (const char*)(ws + WS_WIN)}; EpiG1 E{ws, dout}; pg8::gemm_phase<EpiG1, SchedG1C, true, true>(lds, K1024, S, E); }
        { SchedG23 S{g23_first, G - g23_first, (int)blockIdx.x, (const char*)ws}; EpiG23 E{ws, dout}; pg8::gemm_phase<EpiG23, SchedG23, true, true>(lds, K256, S, E); } }
    SEAM(3);
    if (IN(4)) {
        const int nKv = (G >= 16) ? 16 : G; int my_units = 0; for (int k = (int)blockIdx.x; k < 16 && (int)blockIdx.x < nKv; k += nKv) ++my_units;
        { SchedG23C S{nKv, (int)blockIdx.x, (const char*)ws}; EpiG23 E{ws, dout}; pg8::gemm_phase<EpiG23, SchedG23C, true, true>(lds, K256, S, E); }
        if (my_units > 0) {
            asm volatile("s_waitcnt vmcnt(0)" ::: "memory"); __syncthreads();
            if (tid == 0) { __builtin_amdgcn_fence(__ATOMIC_RELEASE, "agent"); asm volatile("s_waitcnt vmcnt(0)" ::: "memory");
                __hip_atomic_fetch_add((unsigned*)(ws + WS_CTL) + CW_CTXKV, (unsigned)my_units, __ATOMIC_RELAXED, __HIP_MEMORY_SCOPE_AGENT); }
        }
        p4_attention(P, lds, tid, lane, wave, G); }
    SEAM(4);
    if (IN(5)) { SchedG4 S{G, (int)blockIdx.x, (const char*)(ws + WS_SZA), (const char*)(ws + WS_SZB), (const char*)(ws + WS_WOA), (const char*)(ws + WS_WOB)}; EpiG4 E{ws, P.out};
        pg8::gemm_phase<EpiG4, SchedG4, true, true>(lds, K512, S, E); }
    SEAM(5);
    const bool fuse_final = (G == 256) && IN(6) && IN(7);
    if (IN(6)) { SchedG5 S{G, (int)blockIdx.x, (const char*)(ws + WS_M), (const char*)(ws + WS_WOUT)};
        if (fuse_final) { EpiG5F E{ws, P.x, P.out, P.final_g}; pg8::gemm_phase<EpiG5F, SchedG5, false, true>(lds, K1024, S, E); }
        else { EpiG5 E{ws, P.x, P.out}; pg8::gemm_phase<EpiG5, SchedG5, true, true>(lds, K1024, S, E); } }
    if (!fuse_final) {
    SEAM(6);
    if (IN(7)) { p7_final(P, lane, wave, G); }
    }
#undef IN
#undef SEAM
}

extern "C" void kernel_launch(void* const* d_in, const int* in_sizes, int n_in, void* d_out, int out_size, void* d_ws, size_t ws_size, hipStream_t stream) {
    static int grid = 0;
    if (grid == 0) {
        if (n_in != 17 || in_sizes[0] != MLAT * DM || out_size != MLAT * DM || ws_size < WS_END) { fprintf(stderr, "kernel_launch: unexpected shapes (n_in %d, ws %zu); nothing launched\n", n_in, ws_size); grid = -1; return; }
        int dev = 0, cus = 0, per_cu = 0;
        if (hipGetDevice(&dev) != hipSuccess || hipDeviceGetAttribute(&cus, hipDeviceAttributeMultiprocessorCount, dev) != hipSuccess) { grid = -1; return; }
        if (hipFuncSetAttribute((const void*)mk_fwd, hipFuncAttributeMaxDynamicSharedMemorySize, LDS_BYTES) != hipSuccess) { fprintf(stderr, "kernel_launch: hipFuncSetAttribute failed\n"); grid = -1; return; }
        if (hipOccupancyMaxActiveBlocksPerMultiprocessor(&per_cu, (const void*)mk_fwd, NWAVES * 64, LDS_BYTES) != hipSuccess || per_cu < 1) fprintf(stderr, "kernel_launch: occupancy query says %d\n", per_cu);
        (void)hipGetLastError();
        grid = cus;
    }
    if (grid < 0) return;
    if (hipMemsetAsync((char*)d_ws + WS_CTL, 0, CTL_ZERO_BYTES, stream) != hipSuccess) { fprintf(stderr, "kernel_launch: memset failed\n"); return; }
    Args a{};
    const float** pp = (const float**)&a.p;
    for (int i = 0; i < 17; ++i) pp[i] = (const float*)d_in[i];
    a.p.out = (float*)d_out; a.p.ws = (unsigned char*)d_ws;
    if (MK_N_LAUNCHES == 1) {
        a.ph_lo = 0; a.ph_hi = N_PHASES;
        void* kargs[] = {&a};
        hipError_t e = hipLaunchCooperativeKernel((const void*)mk_fwd, dim3(grid), dim3(NWAVES * 64), kargs, LDS_BYTES, stream);
        if (e != hipSuccess) fprintf(stderr, "kernel_launch: cooperative launch failed: %s (grid %d)\n", hipGetErrorString(e), grid);
    } else {
        for (int k = 0; k < N_PHASES; ++k) { a.ph_lo = k; a.ph_hi = k + 1; hipLaunchKernelGGL(mk_fwd, dim3(grid), dim3(NWAVES * 64), LDS_BYTES, stream, a); }
    }
}
```

```cpp
#include <hip/hip_runtime.h>
#include <hip/hip_bf16.h>
#include <cstdio>
#include <cstdint>
#include <cmath>

#ifndef MK_N_LAUNCHES
#define MK_N_LAUNCHES 1
#endif

namespace pg8 {
#define PG8_LAS __attribute__((address_space(3)))
typedef unsigned short bf16_t;
typedef short bf16x8 __attribute__((ext_vector_type(8)));
typedef float f32x4 __attribute__((ext_vector_type(4)));
typedef unsigned u32x4 __attribute__((ext_vector_type(4)));
typedef unsigned u32x2 __attribute__((ext_vector_type(2)));
constexpr int BM = 256, BK = 64, HALF = 128, HTB = HALF * BK * 2  , STAGE_BYTES = 8 * HTB, NXCD = 8, WGM = 8;

__host__ __device__ __forceinline__ int lds_byte(int r, int c) { const int st = (r >> 4) * 2 + (c >> 5), rr = r & 15, cc = c & 31, ob = rr * 64 + cc * 2; return st * 1024 + (ob ^ (((ob >> 9) & 1) << 5)); }
__host__ __device__ __forceinline__ void stage_rc(int b, int& R, int& C) { const int st = b / 1024, sb = b % 1024, swz = sb ^ (((sb >> 9) & 1) << 5); R = (st >> 1) * 16 + swz / 64; C = (st & 1) * 32 + (swz % 64) / 2; }
__host__ __device__ __forceinline__ int perm32(int rho) { const int n = rho >> 4, i = rho & 15; return 8 * (i >> 2) + 4 * n + (i & 3); }

struct Unit { int ta, tb, kind; };
typedef float f32x2_cv __attribute__((ext_vector_type(2))); typedef __bf16 bf16x2_cv __attribute__((ext_vector_type(2)));
__device__ __forceinline__ unsigned cvt_pk_bf16(float lo, float hi) { const f32x2_cv v = {lo, hi}; const bf16x2_cv b = __builtin_convertvector(v, bf16x2_cv); return __builtin_bit_cast(unsigned, b); }

template <class Epi, class Sched, bool ALIGN_EPI = false, bool SP2 = false>
__device__ __forceinline__ void gemm_phase(PG8_LAS unsigned char* lds, const int K, const Sched& S, const Epi& E) {
    int tid = threadIdx.x; asm volatile("" : "+v"(tid));
    const int wid = __builtin_amdgcn_readfirstlane(tid >> 6), lane = tid & 63, wr = wid >> 2, wc = wid & 3, fr = lane & 15, fq = lane >> 4;
    const int nt = K / BK;
    unsigned voffA[2], voffB[2];
#pragma unroll
    for (int i = 0; i < 2; ++i) { int R, C; stage_rc(tid * 16 + i * 8192, R, C); const int Rb = Epi::PERM ? ((R & ~31) + perm32(R & 31)) : R;
        voffA[i] = (unsigned)(R * K + C) * 2u; voffB[i] = (unsigned)(Rb * K + C) * 2u; }
    const size_t kstep = (size_t)(BK * 2);
    const size_t hstep = (size_t)HALF * K * 2;
    const unsigned ldsw = (unsigned)wid * 1024u;
    const int aoff = lds_byte(wr * 64 + fr, fq * 8), boff = lds_byte(wc * 32 + fr, fq * 8);
#define PG8_SA(b, h) (((b) * 2 + (h)) * HTB)
#define PG8_SB(b, h) ((4 + (b) * 2 + (h)) * HTB)
#define PG8_STAGE(bufoff, gbase, voff) do { _Pragma("unroll") for (int _i = 0; _i < 2; ++_i) \
        __builtin_amdgcn_global_load_lds((const unsigned*)((const char*)(gbase) + (voff)[_i]), (PG8_LAS unsigned*)(lds + (bufoff) + ldsw + _i * 8192), 16, 0, 0); } while (0)
#define PG8_LDA(dst, b, h) do { _Pragma("unroll") for (int m = 0; m < 4; ++m) _Pragma("unroll") for (int k = 0; k < 2; ++k) dst[m][k] = *(const PG8_LAS bf16x8*)(lds + PG8_SA(b, h) + aoff + m * 2048 + k * 1024); } while (0)
#define PG8_LDB(dst, b, h) do { _Pragma("unroll") for (int n = 0; n < 2; ++n) _Pragma("unroll") for (int k = 0; k < 2; ++k) dst[n][k] = *(const PG8_LAS bf16x8*)(lds + PG8_SB(b, h) + boff + n * 2048 + k * 1024); } while (0)
#define PG8_MMA(ai, bj, At, Bt) do { __builtin_amdgcn_s_setprio(1); _Pragma("unroll") for (int m = 0; m < 4; ++m) _Pragma("unroll") for (int n = 0; n < 2; ++n) _Pragma("unroll") for (int k = 0; k < 2; ++k) \
        acc[ai][bj][m][n] = __builtin_amdgcn_mfma_f32_16x16x32_bf16(Bt[n][k], At[m][k], acc[ai][bj][m][n], 0, 0, 0); __builtin_amdgcn_s_setprio(0); } while (0)
#define PG8_WAIT_V(n) asm volatile("s_waitcnt vmcnt(" #n ")" ::: "memory")
#define PG8_WAIT_L(n) asm volatile("s_waitcnt lgkmcnt(" #n ")" ::: "memory")
#define PG8_BAR __builtin_amdgcn_s_barrier()
#define PG8_SCHED __builtin_amdgcn_sched_barrier(0)
    Unit cur, nxt; int ui = 0;
    if (!S.next(0, cur)) return;
    f32x4 acc[2][2][4][2];
#pragma unroll
    for (int a = 0; a < 2; ++a)
#pragma unroll
        for (int b = 0; b < 2; ++b)
#pragma unroll
            for (int m = 0; m < 4; ++m)
#pragma unroll
                for (int n = 0; n < 2; ++n) acc[a][b][m][n] = (f32x4){0.f, 0.f, 0.f, 0.f};
    bf16x8 At[4][2], B0[2][2], B1[2][2];
    const char* cA = S.aptr(cur); const char* cB = S.bptr(cur);
    if constexpr (SP2) {
        PG8_STAGE(PG8_SB(0, 0), cB, voffB); PG8_STAGE(PG8_SB(0, 1), cB + hstep, voffB); PG8_STAGE(PG8_SA(0, 0), cA, voffA); PG8_STAGE(PG8_SA(0, 1), cA + hstep, voffA);
        if (wr == 1) PG8_BAR;
        PG8_WAIT_V(2); PG8_BAR;
        PG8_STAGE(PG8_SB(1, 0), cB + kstep, voffB); PG8_STAGE(PG8_SA(1, 0), cA + kstep, voffA); PG8_STAGE(PG8_SB(1, 1), cB + hstep + kstep, voffB);
        PG8_WAIT_V(6); PG8_BAR;
    } else {
        PG8_STAGE(PG8_SB(0, 0), cB, voffB); PG8_STAGE(PG8_SA(0, 0), cA, voffA); PG8_STAGE(PG8_SB(0, 1), cB + hstep, voffB); PG8_STAGE(PG8_SA(0, 1), cA + hstep, voffA);
        if (wr == 1) PG8_BAR;
        PG8_WAIT_V(4); PG8_BAR;
        PG8_STAGE(PG8_SB(1, 0), cB + kstep, voffB); PG8_STAGE(PG8_SA(1, 0), cA + kstep, voffA); PG8_STAGE(PG8_SB(1, 1), cB + hstep + kstep, voffB);
        PG8_WAIT_V(6); PG8_BAR;
    }
    for (;;) {
        const bool has_next = S.next(ui + 1, nxt);
        const char* nA = has_next ? S.aptr(nxt) : cA; const char* nB = has_next ? S.bptr(nxt) : cB;
        for (int t = 0; t < nt; t += 2) {
            const bool last = (t == nt - 2);
            const char* a1 = cA + (size_t)(t + 1) * kstep;
            const char* a2 = last ? nA : cA + (size_t)(t + 2) * kstep; const char* b2 = last ? nB : cB + (size_t)(t + 2) * kstep;
            const char* a3 = a2 + kstep; const char* b3 = b2 + kstep;
            if constexpr (SP2) {
            PG8_LDB(B0, 0, 0); PG8_LDB(B1, 0, 1); PG8_SCHED; PG8_LDA(At, 0, 0); PG8_STAGE(PG8_SA(1, 1), a1 + hstep, voffA);
            PG8_WAIT_V(8); PG8_WAIT_L(0); PG8_BAR; PG8_MMA(0, 0, At, B0); PG8_MMA(0, 1, At, B1); PG8_BAR; PG8_SCHED;
            PG8_LDA(At, 0, 1); PG8_STAGE(PG8_SB(0, 0), b2, voffB); PG8_STAGE(PG8_SB(0, 1), b2 + hstep, voffB); PG8_STAGE(PG8_SA(0, 0), a2, voffA);
            PG8_WAIT_V(8); PG8_WAIT_L(0); PG8_BAR; PG8_MMA(1, 0, At, B0); PG8_MMA(1, 1, At, B1); PG8_BAR; PG8_SCHED;
            PG8_LDB(B0, 1, 0); PG8_LDB(B1, 1, 1); PG8_SCHED; PG8_LDA(At, 1, 0); PG8_STAGE(PG8_SA(0, 1), a2 + hstep, voffA);
            PG8_WAIT_V(8); PG8_WAIT_L(0); PG8_BAR; PG8_MMA(0, 0, At, B0); PG8_MMA(0, 1, At, B1); PG8_BAR; PG8_SCHED;
            PG8_LDA(At, 1, 1); PG8_STAGE(PG8_SB(1, 0), b3, voffB); PG8_STAGE(PG8_SB(1, 1), b3 + hstep, voffB); PG8_STAGE(PG8_SA(1, 0), a3, voffA);
            PG8_WAIT_V(8); PG8_WAIT_L(0); PG8_BAR; PG8_MMA(1, 0, At, B0); PG8_MMA(1, 1, At, B1); PG8_BAR; PG8_SCHED;
            } else {
            PG8_LDB(B0, 0, 0); PG8_SCHED; PG8_LDA(At, 0, 0); PG8_STAGE(PG8_SA(1, 1), a1 + hstep, voffA);
            PG8_WAIT_L(8); PG8_BAR; PG8_WAIT_L(0); PG8_MMA(0, 0, At, B0); PG8_BAR; PG8_SCHED;
            PG8_LDB(B1, 0, 1); PG8_STAGE(PG8_SB(0, 0), b2, voffB);
            PG8_BAR; PG8_WAIT_L(0); PG8_MMA(0, 1, At, B1); PG8_BAR;
            PG8_LDA(At, 0, 1); PG8_STAGE(PG8_SA(0, 0), a2, voffA);
            PG8_BAR; PG8_WAIT_L(0); PG8_MMA(1, 0, At, B0); PG8_BAR; PG8_SCHED;
            PG8_STAGE(PG8_SB(0, 1), b2 + hstep, voffB);
            PG8_WAIT_V(6); PG8_BAR; PG8_MMA(1, 1, At, B1); PG8_BAR;
            PG8_LDB(B0, 1, 0); PG8_SCHED; PG8_LDA(At, 1, 0); PG8_STAGE(PG8_SA(0, 1), a2 + hstep, voffA);
            PG8_WAIT_L(8); PG8_BAR; PG8_WAIT_L(0); PG8_MMA(0, 0, At, B0); PG8_BAR; PG8_SCHED;
            PG8_LDB(B1, 1, 1); PG8_STAGE(PG8_SB(1, 0), b3, voffB);
            PG8_BAR; PG8_WAIT_L(0); PG8_MMA(0, 1, At, B1); PG8_BAR;
            PG8_LDA(At, 1, 1); PG8_STAGE(PG8_SA(1, 0), a3, voffA);
            PG8_BAR; PG8_WAIT_L(0); PG8_MMA(1, 0, At, B0); PG8_BAR; PG8_SCHED;
            PG8_STAGE(PG8_SB(1, 1), b3 + hstep, voffB);
            PG8_WAIT_V(6); PG8_BAR; PG8_MMA(1, 1, At, B1); PG8_BAR;
            }
        }
        if constexpr (ALIGN_EPI) { if (wr == 0) PG8_BAR; }
        if constexpr (!Epi::AFTER_DRAIN) { E(acc, cur, wr, wc, fr, fq); }
        if (!has_next) break;
#pragma unroll
        for (int a = 0; a < 2; ++a)
#pragma unroll
            for (int b = 0; b < 2; ++b)
#pragma unroll
                for (int m = 0; m < 4; ++m)
#pragma unroll
                    for (int n = 0; n < 2; ++n) acc[a][b][m][n] = (f32x4){0.f, 0.f, 0.f, 0.f};
        cur = nxt; cA = nA; cB = nB; ++ui;
        if constexpr (ALIGN_EPI) { if (wr == 1) PG8_BAR; }
    }
    PG8_WAIT_V(0);
    if constexpr (!ALIGN_EPI) { if (wr == 0) PG8_BAR; }
    PG8_BAR;
    if constexpr (Epi::AFTER_DRAIN) { E.fused(acc, cur, wr, wc, fr, fq, lds, wid, lane); }
#undef PG8_SA
#undef PG8_SB
#undef PG8_STAGE
#undef PG8_LDA
#undef PG8_LDB
#undef PG8_MMA
#undef PG8_WAIT_V
#undef PG8_WAIT_L
#undef PG8_BAR
#undef PG8_SCHED
}
}


constexpr int NWAVES = 8;
constexpr int DM = 1024, NB = 4, SEQ = 4096, CTXL = 256, TK = SEQ + CTXL;
constexpr int MLAT = NB * SEQ, MCTX = NB * CTXL, MALL = MLAT + MCTX;
constexpr int INW = 5024, NIN = 5120;
constexpr int NH = 8;
constexpr float EPS = 1e-6f;
constexpr float LOG2E = 1.4426950408889634f;
constexpr float MLA_C2 = 0.10206207261596577f * LOG2E;
constexpr float NA_C2 = 0.125f * LOG2E;

constexpr size_t MiB = 1u << 20;
constexpr size_t WS_CTL = 0, CTL_ZERO_BYTES = 64 * 1024;
constexpr size_t WS_WIN = 2 * MiB;
constexpr size_t WS_WUQ = 12 * MiB;
constexpr size_t WS_WUKV = 12 * MiB + 512 * 1024;
constexpr size_t WS_WOA = 13 * MiB, WS_WOB = 14 * MiB, WS_WOUT = 15 * MiB;
constexpr size_t WS_MOD = 17 * MiB;
constexpr size_t WS_ROPE = 17 * MiB + 256 * 1024;
constexpr size_t WS_SSQQ = 17 * MiB + 512 * 1024;
constexpr size_t WS_SSQKV = 18 * MiB;
constexpr size_t WS_SSQO = 18 * MiB + 512 * 1024;
constexpr size_t WS_H = 20 * MiB;
constexpr size_t WS_QA = 20 * MiB;
constexpr size_t WS_T0 = 54 * MiB;
constexpr size_t WS_CQ = 63 * MiB;
constexpr size_t WS_KB = 71 * MiB;
constexpr size_t WS_VBT = 88 * MiB;
constexpr size_t WS_M = 71 * MiB;
constexpr size_t WS_QB = 105 * MiB;
constexpr size_t WS_SZA = 121 * MiB;
constexpr size_t WS_SZB = 137 * MiB;
constexpr size_t WS_SGA = 153 * MiB;
constexpr size_t WS_SGB = 185 * MiB;
constexpr size_t WS_END = 217 * MiB;
constexpr size_t DO_KA = 0, DO_VAT = 26 * MiB;
constexpr int CW_BAR = 1024;

constexpr int RING_BYTES = 131072, MISC_OFF = RING_BYTES + 320, LDS_BYTES = 147456;

#define GAS __attribute__((address_space(1)))
#define LAS __attribute__((address_space(3)))
typedef unsigned short bf16;
typedef unsigned v4u __attribute__((ext_vector_type(4)));
typedef unsigned v2u __attribute__((ext_vector_type(2)));
typedef float f32x4 __attribute__((ext_vector_type(4)));
typedef float f32x16 __attribute__((ext_vector_type(16)));
typedef short bf16x8 __attribute__((ext_vector_type(8)));
typedef short s16x4 __attribute__((ext_vector_type(4)));
__device__ __forceinline__ unsigned f2bf(float f) { unsigned u = __builtin_bit_cast(unsigned, f); return (u + 0x7fffu + ((u >> 16) & 1u)) >> 16; }
__device__ __forceinline__ unsigned pk2(float lo, float hi) { return f2bf(lo) | (f2bf(hi) << 16); }
__device__ __forceinline__ float bf_lo(unsigned w) { return __builtin_bit_cast(float, w << 16); }
__device__ __forceinline__ float bf_hi(unsigned w) { return __builtin_bit_cast(float, w & 0xffff0000u); }
__device__ __forceinline__ float fast_rcp(float x) { return __builtin_amdgcn_rcpf(x); }
__device__ __forceinline__ float sigmoidf_(float x) { return fast_rcp(1.f + __builtin_amdgcn_exp2f(-x * LOG2E)); }
__device__ __forceinline__ float siluf_(float x) { return x * sigmoidf_(x); }
#define XB_TMO      128
#define XB_XCNT(j)  (256  + 64 * (j))
#define XB_XSUB(j)  (1280 + 64 * (j))
#define XB_XGEN(j)  (2304 + 64 * (j))
#define XB_TOP      3328
#define XB_TOPGEN   3392
#define XCD_BAR_WORDS 3456
#define XB_SPIN_CAP (1u << 18)

__device__ __forceinline__ unsigned xb_ld(unsigned* p)              { return __hip_atomic_load(p, __ATOMIC_RELAXED, __HIP_MEMORY_SCOPE_AGENT); }
__device__ __forceinline__ unsigned xb_add(unsigned* p, unsigned v) { return __hip_atomic_fetch_add(p, v, __ATOMIC_RELAXED, __HIP_MEMORY_SCOPE_AGENT); }
__device__ __forceinline__ unsigned xb_xcc_id() { return (unsigned)__builtin_amdgcn_s_getreg((3 << 11) | 20) & 0xFu; }
#define XB_SPIN(cond, bar) do { unsigned _sp = 0; while (cond) { __builtin_amdgcn_s_sleep(1); \
    if ((++_sp & 255u) == 0u) { if (xb_ld(&(bar)[XB_TMO])) break; if (_sp > XB_SPIN_CAP) { atomicAdd(&(bar)[XB_TMO], 1u); break; } } } } while (0)

struct XcdBarrier {
    unsigned* bar; unsigned x;
    volatile LAS unsigned* st;
};

__device__ __forceinline__ XcdBarrier xcd_barrier_post(unsigned* bar, volatile LAS unsigned* st) {
    XcdBarrier b; b.bar = bar; b.x = xb_xcc_id(); b.st = st;
    if (threadIdx.x == 0) (void)xb_add(&bar[XB_XCNT(b.x)], 1u);
    return b;
}
__device__ __forceinline__ void xcd_barrier_complete(unsigned* bar, unsigned x, unsigned& nloc, unsigned& nx) {
    const unsigned G = gridDim.x * gridDim.y * gridDim.z;
    unsigned sum, cnt, mine, sp = 0u;
    for (;;) {
        sum = 0u; cnt = 0u; mine = 0u;
#pragma unroll
        for (unsigned j = 0; j < 16; ++j) { const unsigned c = xb_ld(&bar[XB_XCNT(j)]); sum += c; cnt += (c > 0u) ? 1u : 0u; mine = (j == x) ? c : mine; }
        if (sum == G) break;
        __builtin_amdgcn_s_sleep(1);
        if ((++sp & 255u) == 0u) { if (xb_ld(&bar[XB_TMO])) break; if (sp > XB_SPIN_CAP) { atomicAdd(&bar[XB_TMO], 1u); break; } }
    }
    nloc = mine > 0u ? mine : 1u; nx = cnt > 0u ? cnt : 1u;
}

__device__ __forceinline__ void xcd_barrier(const XcdBarrier& b) {
    asm volatile("s_waitcnt vmcnt(0)" ::: "memory");
    __syncthreads();
    if (threadIdx.x == 0) {
        unsigned* bar = b.bar;
        __builtin_amdgcn_s_waitcnt(0);
        unsigned nloc = b.st[0], nx = b.st[1];
        if (nloc == 0u) { xcd_barrier_complete(bar, b.x, nloc, nx); b.st[0] = nloc; b.st[1] = nx; }
        const unsigned old = xb_add(&bar[XB_XSUB(b.x)], 1u);
        const unsigned gen = old / nloc;
        if (old + 1u == (gen + 1u) * nloc) {
            __builtin_amdgcn_fence(__ATOMIC_RELEASE, "agent");
            asm volatile("s_waitcnt vmcnt(0)" ::: "memory");
            const unsigned og = xb_add(&bar[XB_TOP], 1u);
            const unsigned tg = og / nx;
            if (og + 1u == (tg + 1u) * nx) xb_add(&bar[XB_TOPGEN], 1u);
            else XB_SPIN(xb_ld(&bar[XB_TOPGEN]) == tg, bar);
            __builtin_amdgcn_fence(__ATOMIC_ACQUIRE, "agent");
            xb_add(&bar[XB_XGEN(b.x)], 1u);
            asm volatile("s_waitcnt vmcnt(0)" ::: "memory");
        } else {
            XB_SPIN(xb_ld(&bar[XB_XGEN(b.x)]) == gen, bar);
            __builtin_amdgcn_fence(__ATOMIC_ACQUIRE, "agent");
            asm volatile("s_waitcnt vmcnt(0)" ::: "memory");
        }
    }
    __syncthreads();
}

#define LDS_WAIT() asm volatile("s_waitcnt lgkmcnt(0)" ::: "memory")
#define VM_WAIT() asm volatile("s_waitcnt vmcnt(0)" ::: "memory")
__device__ __forceinline__ float wave_sum(float v) {
#pragma unroll
    for (int o = 1; o < 64; o <<= 1) v += __shfl_xor(v, o);
    return v;
}
__device__ __forceinline__ void tile_remap(int L, int nM, int nN, int& pm, int& pn) {
    const int nwg = nM * nN; int wgid = L;
    { const int q = nwg / 8, r = nwg % 8, xcd = wgid % 8, off = wgid / 8; wgid = (xcd < r ? xcd * (q + 1) : r * (q + 1) + (xcd - r) * q) + off; }
    const int nig = 8 * nN, gid = wgid / nig, fm = gid * 8, gsz = (nM - fm) < 8 ? (nM - fm) : 8;
    pm = fm + ((wgid % nig) % gsz); pn = (wgid % nig) / gsz;
}
__device__ __forceinline__ void row_bt(int row, int& b, int& t) {
    if (row < MLAT) { b = row >> 12; t = row & 4095; } else { const int r = row - MLAT; b = r >> 8; t = SEQ + (r & 255); }
}

__device__ __forceinline__ void transpose_item(const float* W, int ldw, int k0, int n0, bf16* WT, int KD, int drow0, const float* g, LAS float* scr, int lane) {
    f32x4 wv[8];
#pragma unroll
    for (int i = 0; i < 8; ++i) wv[i] = *(const f32x4*)(W + (size_t)(k0 + 8 * i + (lane >> 3)) * ldw + n0 + 4 * (lane & 7));
#pragma unroll
    for (int i = 0; i < 8; ++i) { const int kk = 8 * i + (lane >> 3); f32x4 v = wv[i]; if (g) v = v * g[k0 + kk];
        LAS float* d = scr + kk * 33 + 4 * (lane & 7); d[0] = v[0]; d[1] = v[1]; d[2] = v[2]; d[3] = v[3]; }
    LDS_WAIT(); asm volatile("" ::: "memory");
    const int c = lane & 7;
#pragma unroll
    for (int j = 0; j < 4; ++j) { const int n = (lane >> 3) + 8 * j; const LAS float* s = scr + (8 * c) * 33 + n;
        v4u o; o.x = pk2(s[0 * 33], s[1 * 33]); o.y = pk2(s[2 * 33], s[3 * 33]); o.z = pk2(s[4 * 33], s[5 * 33]); o.w = pk2(s[6 * 33], s[7 * 33]);
        *(v4u*)(WT + (size_t)(drow0 + n) * KD + k0 + 8 * c) = o; }
    LDS_WAIT(); asm volatile("" ::: "memory");
}

struct Ptrs {
    const float *x, *c, *ctx, *c_ctx, *w_mod, *b_mod, *norm_g, *w_in, *g_cq, *w_uq, *g_ckv, *w_ukv, *rpb, *w_oa, *w_ob, *w_out, *final_g;
    float* out; unsigned char* ws;
};

__device__ __forceinline__ void p0_weights(const Ptrs& P, LAS unsigned char* lds, int tid, int lane, int wave, int G) {
    LAS float* scr = (LAS float*)(lds + wave * 16384);
    const int gw = blockIdx.x * NWAVES + wave, NGW = G * NWAVES;
    unsigned char* ws = P.ws;
    constexpr int I_IN = 16 * 157, I_UQ = 4 * 24, I_UKV = 2 * 32, I_OA = 8 * 32, I_OUT = 16 * 32;
    constexpr int NITEMS = I_IN + I_UQ + I_UKV + 2 * I_OA + I_OUT;
    for (int it = gw; it < NITEMS; it += NGW) {
        int r = it;
        if (r < I_IN) { const int kb = r / 157, nb = r % 157, n0 = 32 * nb; transpose_item(P.w_in, INW, 64 * kb, n0, (bf16*)(ws + WS_WIN), 1024, n0 + (n0 >= 160 ? 96 : 0), nullptr, scr, lane); continue; } r -= I_IN;
        if (r < I_UQ) { const int kb = r / 24, nb = r % 24, h = nb / 3, j = nb % 3; transpose_item(P.w_uq, 768, 64 * kb, 32 * nb, (bf16*)(ws + WS_WUQ), 256, j < 2 ? h * 64 + 32 * j : 512 + 32 * h, P.g_cq, scr, lane); continue; } r -= I_UQ;
        if (r < I_UKV) { const int kb = r / 32, nb = r % 32, h = nb / 4, j = nb % 4; transpose_item(P.w_ukv, 1024, 64 * kb, 32 * nb, (bf16*)(ws + WS_WUKV), 256, j < 2 ? h * 64 + 32 * j : 512 + h * 64 + 32 * (j - 2), P.g_ckv, scr, lane); continue; } r -= I_UKV;
        if (r < I_OA) { const int kb = r / 32, nb = r % 32; transpose_item(P.w_oa, 1024, 64 * kb, 32 * nb, (bf16*)(ws + WS_WOA), 512, 32 * nb, nullptr, scr, lane); continue; } r -= I_OA;
        if (r < I_OA) { const int kb = r / 32, nb = r % 32; transpose_item(P.w_ob, 1024, 64 * kb, 32 * nb, (bf16*)(ws + WS_WOB), 512, 32 * nb, nullptr, scr, lane); continue; } r -= I_OA;
        { const int kb = r / 32, nb = r % 32; transpose_item(P.w_out, 1024, 64 * kb, 32 * nb, (bf16*)(ws + WS_WOUT), 1024, 32 * nb, nullptr, scr, lane); }
    }
    { const int gt = blockIdx.x * (NWAVES * 64) + tid, NT = G * NWAVES * 64; const v4u z = {0u, 0u, 0u, 0u};
      for (int ch = gt; ch < 12288; ch += NT) *(v4u*)(ws + WS_WIN + (size_t)160 * 2048 + (size_t)ch * 16) = z;
      for (int ch = gt; ch < 16384; ch += NT) *(v4u*)(ws + WS_WUKV + (size_t)(ch >> 4) * 512 + 256 + (ch & 15) * 16) = z; }
    if (blockIdx.x == 0) {
        const int p = tid >> 3, i = tid & 7;
        const float fr = (i == 0) ? 1.0f : (i == 1) ? 0.31622776601683794f : (i == 2) ? 0.1f : (i == 3) ? 0.031622776601683794f : (i == 4) ? 0.01f : (i == 5) ? 0.0031622776601683794f : (i == 6) ? 0.001f : 0.00031622776601683794f;
        const float ang = (float)p * fr;
        float2 cs; cs.x = cosf(ang); cs.y = sinf(ang);
        ((float2*)(ws + WS_ROPE))[tid] = cs;
    }
}
__device__ __forceinline__ void p0_gemv(const Ptrs& P, LAS unsigned char* lds, int tid, int lane, int wave, int G) {
    unsigned char* ws = P.ws;
    __syncthreads();
    LAS float* red = (LAS float*)(lds + 7 * 16384 + 12288);
    for (int cgp = blockIdx.x; cgp < 256; cgp += G) {
        const int c0 = 12 * cgp;
        float acc[5][12];
#pragma unroll
        for (int b = 0; b < 5; ++b)
#pragma unroll
            for (int j = 0; j < 12; ++j) acc[b][j] = 0.f;
#pragma unroll
        for (int h = 0; h < 2; ++h) {
            const int kk = tid + 512 * h;
            float s[5];
#pragma unroll
            for (int b = 0; b < 4; ++b) s[b] = siluf_(P.c[b * 1024 + kk]);
            s[4] = siluf_(P.c_ctx[kk]);
            const f32x4* wp = (const f32x4*)(P.w_mod + (size_t)kk * 3072 + c0);
            const f32x4 w0 = wp[0], w1 = wp[1], w2 = wp[2];
            const float w[12] = {w0[0], w0[1], w0[2], w0[3], w1[0], w1[1], w1[2], w1[3], w2[0], w2[1], w2[2], w2[3]};
#pragma unroll
            for (int b = 0; b < 5; ++b)
#pragma unroll
                for (int j = 0; j < 12; ++j) acc[b][j] += s[b] * w[j];
        }
#pragma unroll
        for (int b = 0; b < 5; ++b)
#pragma unroll
            for (int j = 0; j < 12; ++j) { const float v = wave_sum(acc[b][j]); if (lane == 0) red[wave * 60 + b * 12 + j] = v; }
        __syncthreads();
        if (tid < 60) { float v = 0.f;
#pragma unroll
            for (int w8 = 0; w8 < 8; ++w8) v += red[w8 * 60 + tid];
            const int b = tid / 12, j = tid % 12;
            ((float*)(ws + WS_MOD))[b * 3072 + c0 + j] = v + P.b_mod[c0 + j]; }
        __syncthreads();
    }
}

__device__ __forceinline__ void p1_hconv(const Ptrs& P, int lane, int wave, int G) {
    const int gw = blockIdx.x * NWAVES + wave, NGW = G * NWAVES;
    const float* MOD = (const float*)(P.ws + WS_MOD);
    bf16* H = (bf16*)(P.ws + WS_H);
    for (int row = gw; row < MALL; row += NGW) {
        const float* xr = row < MLAT ? P.x + (size_t)row * DM : P.ctx + (size_t)(row - MLAT) * DM;
        const int mb = row < MLAT ? (row >> 12) : 4;
        const f32x4* x4 = (const f32x4*)xr + lane;
        f32x4 v[4]; float s = 0.f;
#pragma unroll
        for (int j = 0; j < 4; ++j) { v[j] = x4[64 * j]; s += (v[j][0] * v[j][0] + v[j][1] * v[j][1]) + (v[j][2] * v[j][2] + v[j][3] * v[j][3]); }
        const float rstd = 1.0f / sqrtf(wave_sum(s) * (1.f / DM) + EPS);
        const f32x4* g4 = (const f32x4*)P.norm_g + lane;
        const f32x4* sh4 = (const f32x4*)(MOD + mb * 3072) + lane;
        const f32x4* sc4 = (const f32x4*)(MOD + mb * 3072 + 1024) + lane;
        unsigned long long* o8 = (unsigned long long*)(H + (size_t)row * DM) + lane;
#pragma unroll
        for (int j = 0; j < 4; ++j) {
            const f32x4 g = g4[64 * j], sh = sh4[64 * j], sc = sc4[64 * j];
            f32x4 h;
#pragma unroll
            for (int e = 0; e < 4; ++e) h[e] = (v[j][e] * rstd * g[e]) * (1.f + sc[e]) + sh[e];
            o8[64 * j] = (unsigned long long)pk2(h[0], h[1]) | ((unsigned long long)pk2(h[2], h[3]) << 32);
        }
    }
}

using pg8::Unit;
using pg8::cvt_pk_bf16;
__device__ __forceinline__ v4u pack8(const f32x4& a, const f32x4& b) { v4u w; w.x = cvt_pk_bf16(a[0], a[1]); w.y = cvt_pk_bf16(a[2], a[3]); w.z = cvt_pk_bf16(b[0], b[1]); w.w = cvt_pk_bf16(b[2], b[3]); return w; }

__device__ __forceinline__ void rope8(float (&v)[8], int fq, int t, const float2* tab) {
    const int pos = (fq < 2) ? (t >> 6) : (t & 63);
    const float sgn = (fq & 1) ? 1.f : -1.f;
#pragma unroll
    for (int i = 0; i < 8; ++i) { const float pv = __shfl_xor(v[i], 16); const float2 cs = tab[pos * 8 + i]; v[i] = v[i] * cs.x + sgn * pv * cs.y; }
}

struct SchedG1 {
    int G, c; const char* H; const char* W;
    static constexpr size_t TS = (size_t)256 * 1024 * 2;
    __device__ __forceinline__ bool next(int i, Unit& u) const {
        const int L = i * G + c; if (L >= 1280) return false;
        int pm, pn;
        tile_remap(L, 64, 20, pm, pn);
        if (pn == 3 || pn == 4) { u.kind = 1; u.ta = pn; u.tb = pm; } else { u.kind = 0; u.ta = pm; u.tb = pn; }
        return true;
    }
    __device__ __forceinline__ const char* aptr(const Unit& u) const { return (u.kind == 1 ? W : H) + (size_t)u.ta * TS; }
    __device__ __forceinline__ const char* bptr(const Unit& u) const { return (u.kind == 1 ? H : W) + (size_t)u.tb * TS; }
};
struct SchedG1C {
    int nC, c; const char* H; const char* W;
    static constexpr size_t TS = (size_t)256 * 1024 * 2;
    __device__ __forceinline__ bool next(int i, Unit& u) const {
        if (c >= nC) return false;
        const int k = i * nC + c; if (k >= 20) return false;
        const int pm = 64 + k / 5, pn = k % 5;
        if (pn == 3 || pn == 4) { u.kind = 1; u.ta = pn; u.tb = pm; } else { u.kind = 0; u.ta = pm; u.tb = pn; }
        return true;
    }
    __device__ __forceinline__ const char* aptr(const Unit& u) const { return (u.kind == 1 ? W : H) + (size_t)u.ta * TS; }
    __device__ __forceinline__ const char* bptr(const Unit& u) const { return (u.kind == 1 ? H : W) + (size_t)u.tb * TS; }
};
struct EpiG1 {
    static constexpr bool PERM = true, AFTER_DRAIN = false;
    unsigned char* ws; unsigned char* dout;
    __device__ __forceinline__ void operator()(const f32x4 (&acc)[2][2][4][2], const Unit& u, int wr, int wc, int fr, int fq) const {
        using pg8::HALF;
        if (u.kind == 1) {
            bf16* VBT = (bf16*)(ws + WS_VBT);
#pragma unroll
            for (int bj = 0; bj < 2; ++bj) {
                int b, t; row_bt(256 * u.tb + HALF * bj + 32 * wc + 8 * fq, b, t);
#pragma unroll
                for (int ai = 0; ai < 2; ++ai)
#pragma unroll
                    for (int m = 0; m < 4; ++m) { const int vc = 256 * (u.ta - 3) + HALF * ai + 64 * wr + 16 * m + fr, h = vc >> 6, dv = vc & 63;
                        *(v4u*)(VBT + ((size_t)((b * NH + h) * 64 + dv)) * TK + t) = pack8(acc[ai][bj][m][0], acc[ai][bj][m][1]); }
            }
            return;
        }
        const int pn = u.tb;
        const float2* tab = (const float2*)(ws + WS_ROPE);
#pragma unroll
        for (int ai = 0; ai < 2; ++ai)
#pragma unroll
            for (int m = 0; m < 4; ++m) {
                const int row = 256 * u.ta + HALF * ai + 64 * wr + 16 * m + fr; int b, t; row_bt(row, b, t);
                float qq = 0.f;
#pragma unroll
                for (int bj = 0; bj < 2; ++bj) {
                    const int col = HALF * bj + 32 * wc + 8 * fq;
                    const f32x4 v0 = acc[ai][bj][m][0], v1 = acc[ai][bj][m][1];
                    if (pn == 0) {
                        *(v4u*)((bf16*)(ws + WS_T0) + (size_t)row * 256 + col) = pack8(v0, v1);
                        if (bj == 0) { float q = (v0[0] * v0[0] + v0[1] * v0[1]) + (v0[2] * v0[2] + v0[3] * v0[3]) + (v1[0] * v1[0] + v1[1] * v1[1]) + (v1[2] * v1[2] + v1[3] * v1[3]);
                            q += __shfl_xor(q, 16); q += __shfl_xor(q, 32); if (fq == 0) ((float*)(ws + WS_SSQKV))[row * 4 + wc] = q; }
                        else if (wc == 0) {
                            float v[8] = {v0[0], v0[1], v0[2], v0[3], v1[0], v1[1], v1[2], v1[3]};
                            if (u.ta < 64) rope8(v, fq, t, tab);
                            v4u w; w.x = cvt_pk_bf16(v[0], v[1]); w.y = cvt_pk_bf16(v[2], v[3]); w.z = cvt_pk_bf16(v[4], v[5]); w.w = cvt_pk_bf16(v[6], v[7]);
                            bf16* KA = (bf16*)(dout + DO_KA);
#pragma unroll
                            for (int h = 0; h < NH; ++h) *(v4u*)(KA + ((size_t)(b * NH + h) * TK + t) * 96 + 64 + 8 * fq) = w;
                        }
                    } else if (pn <= 2) {
                        const int kc = 256 * (pn - 1) + col, h = kc >> 6, d = kc & 63;
                        *(v4u*)((bf16*)(ws + WS_KB) + ((size_t)(b * NH + h) * TK + t) * 64 + d) = pack8(v0, v1);
                    } else if (pn == 5) {
                        *(v4u*)((bf16*)(ws + WS_CQ) + (size_t)row * 256 + col) = pack8(v0, v1);
                        qq += (v0[0] * v0[0] + v0[1] * v0[1]) + (v0[2] * v0[2] + v0[3] * v0[3]) + (v1[0] * v1[0] + v1[1] * v1[1]) + (v1[2] * v1[2] + v1[3] * v1[3]);
                    } else if (pn <= 7 || (pn >= 10 && pn <= 11)) {
                        bf16* dst = (bf16*)(ws + (pn <= 7 ? WS_SZA : WS_SZB)) + (size_t)row * 512 + 256 * (pn <= 7 ? pn - 6 : pn - 10) + col;
                        f32x4 a, c2;
#pragma unroll
                        for (int e = 0; e < 4; ++e) { a[e] = siluf_(v0[e]); c2[e] = siluf_(v1[e]); }
                        *(v4u*)dst = pack8(a, c2);
                    } else if (pn <= 9) {
                        const int qc = 256 * (pn - 8) + col, h = qc >> 6, d = qc & 63;
                        *(v4u*)((bf16*)(ws + WS_QB) + ((size_t)(b * NH + h) * SEQ + t) * 64 + d) = pack8(v0 * NA_C2, v1 * NA_C2);
                    } else {
                        bf16* dst = (bf16*)(ws + (pn <= 15 ? WS_SGA : WS_SGB)) + (size_t)row * 1024 + 256 * (pn <= 15 ? pn - 12 : pn - 16) + col;
                        f32x4 a, c2;
#pragma unroll
                        for (int e = 0; e < 4; ++e) { a[e] = sigmoidf_(v0[e]); c2[e] = sigmoidf_(v1[e]); }
                        *(v4u*)dst = pack8(a, c2);
                    }
                }
                if (pn == 5) { qq += __shfl_xor(qq, 16); qq += __shfl_xor(qq, 32); if (fq == 0) ((float*)(ws + WS_SSQQ))[row * 4 + wc] = qq; }
            }
    }
};

struct SchedG23 {
    int first, cnt, c; const char* wsb;
    static constexpr size_t TS = (size_t)256 * 256 * 2;
    __device__ __forceinline__ bool next(int i, Unit& u) const {
        if (c < first) return false;
        const int L = i * cnt + (c - first); if (L >= 448) return false;
        if (L < 192) { u.kind = 0; u.ta = L % 64; u.tb = L / 64; return true; }
        const int k = L - 192, pm = k % 64, pn = k / 64;
        if (pn < 2) { u.kind = 1; u.ta = pm; u.tb = pn; } else { u.kind = 2; u.ta = pn; u.tb = pm; }
        return true;
    }
    __device__ __forceinline__ const char* aptr(const Unit& u) const { const size_t o = (u.kind == 0) ? WS_CQ : (u.kind == 1) ? WS_T0 : WS_WUKV; return wsb + o + (size_t)u.ta * TS; }
    __device__ __forceinline__ const char* bptr(const Unit& u) const { const size_t o = (u.kind == 0) ? WS_WUQ : (u.kind == 1) ? WS_WUKV : WS_T0; return wsb + o + (size_t)u.tb * TS; }
};
struct EpiG23 {
    static constexpr bool PERM = true, AFTER_DRAIN = false;
    unsigned char* ws; unsigned char* dout;
    __device__ __forceinline__ void operator()(const f32x4 (&acc)[2][2][4][2], const Unit& u, int wr, int wc, int fr, int fq) const {
        using pg8::HALF;
        const float* SSQKV = (const float*)(ws + WS_SSQKV);
        if (u.kind == 2) {
            bf16* VAT = (bf16*)(dout + DO_VAT);
#pragma unroll
            for (int bj = 0; bj < 2; ++bj) {
                const int tok0 = 256 * u.tb + HALF * bj + 32 * wc + 8 * fq; int b, t; row_bt(tok0, b, t);
                float rs[8];
                { const f32x4 ss = *(const f32x4*)(SSQKV + (size_t)(tok0 + (fr & 7)) * 4); const float mine = 1.0f / sqrtf(((ss[0] + ss[1]) + (ss[2] + ss[3])) * (1.f / 128.f) + EPS);
#pragma unroll
                  for (int i = 0; i < 8; ++i) rs[i] = __shfl(mine, (fq << 4) + i); }
#pragma unroll
                for (int ai = 0; ai < 2; ++ai)
#pragma unroll
                    for (int m = 0; m < 4; ++m) { const int vc = 256 * (u.ta - 2) + HALF * ai + 64 * wr + 16 * m + fr, h = vc >> 6, dv = vc & 63;
                        f32x4 a = acc[ai][bj][m][0], c2 = acc[ai][bj][m][1];
#pragma unroll
                        for (int e = 0; e < 4; ++e) { a[e] *= rs[e]; c2[e] *= rs[4 + e]; }
                        *(v4u*)(VAT + ((size_t)((b * NH + h) * 64 + dv)) * TK + t) = pack8(a, c2); }
            }
            return;
        }
        const float2* tab = (const float2*)(ws + WS_ROPE);
#pragma unroll
        for (int ai = 0; ai < 2; ++ai)
#pragma unroll
            for (int m = 0; m < 4; ++m) {
                const int row = 256 * u.ta + HALF * ai + 64 * wr + 16 * m + fr; int b, t; row_bt(row, b, t);
                if (u.kind == 0) {
                    const f32x4 ss = *(const f32x4*)((const float*)(ws + WS_SSQQ) + (size_t)row * 4);
                    const float f = MLA_C2 / sqrtf(((ss[0] + ss[1]) + (ss[2] + ss[3])) * (1.f / 256.f) + EPS);
                    bf16* QA = (bf16*)(ws + WS_QA);
#pragma unroll
                    for (int bj = 0; bj < 2; ++bj) {
                        const f32x4 v0 = acc[ai][bj][m][0] * f, v1 = acc[ai][bj][m][1] * f;
                        if (u.tb < 2) { const int qc = 256 * u.tb + HALF * bj + 32 * wc + 8 * fq, h = qc >> 6, d = qc & 63;
                            *(v4u*)(QA + ((size_t)(b * NH + h) * SEQ + t) * 96 + d) = pack8(v0, v1);
                        } else { const int h = 4 * bj + wc;
                            float v[8] = {v0[0], v0[1], v0[2], v0[3], v1[0], v1[1], v1[2], v1[3]};
                            rope8(v, fq, t, tab);
                            v4u w; w.x = cvt_pk_bf16(v[0], v[1]); w.y = cvt_pk_bf16(v[2], v[3]); w.z = cvt_pk_bf16(v[4], v[5]); w.w = cvt_pk_bf16(v[6], v[7]);
                            *(v4u*)(QA + ((size_t)(b * NH + h) * SEQ + t) * 96 + 64 + 8 * fq) = w; }
                    }
                } else {
                    const f32x4 ss = *(const f32x4*)(SSQKV + (size_t)row * 4);
                    const float f = 1.0f / sqrtf(((ss[0] + ss[1]) + (ss[2] + ss[3])) * (1.f / 128.f) + EPS);
                    bf16* KA = (bf16*)(dout + DO_KA);
#pragma unroll
                    for (int bj = 0; bj < 2; ++bj) { const int kc = 256 * u.tb + HALF * bj + 32 * wc + 8 * fq, h = kc >> 6, d = kc & 63;
                        *(v4u*)(KA + ((size_t)(b * NH + h) * TK + t) * 96 + d) = pack8(acc[ai][bj][m][0] * f, acc[ai][bj][m][1] * f); }
                }
            }
    }
};

struct SchedG23C {
    int nC, c; const char* wsb;
    static constexpr size_t TS = (size_t)256 * 256 * 2;
    __device__ __forceinline__ bool next(int i, Unit& u) const {
        if (c >= nC) return false;
        const int k = i * nC + c; if (k >= 16) return false;
        if (k < 8) { u.kind = 1; u.ta = 64 + (k >> 1); u.tb = k & 1; } else { const int kk = k - 8; u.kind = 2; u.ta = 2 + (kk >> 2); u.tb = 64 + (kk & 3); }
        return true;
    }
    __device__ __forceinline__ const char* aptr(const Unit& u) const { const size_t o = (u.kind == 1) ? WS_T0 : WS_WUKV; return wsb + o + (size_t)u.ta * TS; }
    __device__ __forceinline__ const char* bptr(const Unit& u) const { const size_t o = (u.kind == 1) ? WS_WUKV : WS_T0; return wsb + o + (size_t)u.tb * TS; }
};
struct SchedG4 {
    int G, c; const char* OA; const char* OB; const char* WOA; const char* WOB;
    static constexpr size_t TS = (size_t)256 * 512 * 2;
    __device__ __forceinline__ bool next(int j, Unit& u) const {
        const int tile = c + (j >> 1) * G; if (tile >= 256) return false;
        tile_remap(tile, 64, 4, u.ta, u.tb); u.kind = j & 1; return true;
    }
    __device__ __forceinline__ const char* aptr(const Unit& u) const { return (u.kind ? OB : OA) + (size_t)u.ta * TS; }
    __device__ __forceinline__ const char* bptr(const Unit& u) const { return (u.kind ? WOB : WOA) + (size_t)u.tb * TS; }
};
struct EpiG4 {
    static constexpr bool PERM = true, AFTER_DRAIN = false;
    unsigned char* ws; float* scratch;
    __device__ __forceinline__ void operator()(const f32x4 (&acc)[2][2][4][2], const Unit& u, int wr, int wc, int fr, int fq) const {
        using pg8::HALF;
        const bf16* SG = (const bf16*)(ws + (u.kind ? WS_SGB : WS_SGA));
        bf16* Mb = (bf16*)(ws + WS_M);
#pragma unroll
        for (int ai = 0; ai < 2; ++ai) {
            v4u g[4][2], t1[4][2];
#pragma unroll
            for (int m = 0; m < 4; ++m)
#pragma unroll
                for (int bj = 0; bj < 2; ++bj) {
                    const size_t off = (size_t)(256 * u.ta + HALF * ai + 64 * wr + 16 * m + fr) * 1024 + 256 * u.tb + HALF * bj + 32 * wc + 8 * fq;
                    g[m][bj] = *(const v4u*)(SG + off);
                    if (u.kind) t1[m][bj] = *(const v4u*)(Mb + off); else t1[m][bj] = (v4u){0u, 0u, 0u, 0u};
                }
#pragma unroll
            for (int m = 0; m < 4; ++m)
#pragma unroll
                for (int bj = 0; bj < 2; ++bj) {
                    const size_t off = (size_t)(256 * u.ta + HALF * ai + 64 * wr + 16 * m + fr) * 1024 + 256 * u.tb + HALF * bj + 32 * wc + 8 * fq;
                    const v4u gg = g[m][bj], tt = t1[m][bj];
                    f32x4 v0 = acc[ai][bj][m][0], v1 = acc[ai][bj][m][1];
                    v0[0] = v0[0] * bf_lo(gg.x) + bf_lo(tt.x); v0[1] = v0[1] * bf_hi(gg.x) + bf_hi(tt.x); v0[2] = v0[2] * bf_lo(gg.y) + bf_lo(tt.y); v0[3] = v0[3] * bf_hi(gg.y) + bf_hi(tt.y);
                    v1[0] = v1[0] * bf_lo(gg.z) + bf_lo(tt.z); v1[1] = v1[1] * bf_hi(gg.z) + bf_hi(tt.z); v1[2] = v1[2] * bf_lo(gg.w) + bf_lo(tt.w); v1[3] = v1[3] * bf_hi(gg.w) + bf_hi(tt.w);
                    *(v4u*)(Mb + off) = pack8(v0, v1);
                }
        }
    }
};

struct SchedG5 {
    int G, c; const char* M; const char* W;
    static constexpr size_t TS = (size_t)256 * 1024 * 2;
    __device__ __forceinline__ bool next(int i, Unit& u) const { const int L = i * G + c; if (L >= 256) return false; tile_remap(L, 64, 4, u.ta, u.tb); u.kind = 0; return true; }
    __device__ __forceinline__ const char* aptr(const Unit& u) const { return M + (size_t)u.ta * TS; }
    __device__ __forceinline__ const char* bptr(const Unit& u) const { return W + (size_t)u.tb * TS; }
};
struct EpiG5 {
    static constexpr bool PERM = true, AFTER_DRAIN = false;
    unsigned char* ws; const float* x; float* out;
    __device__ __forceinline__ void operator()(const f32x4 (&acc)[2][2][4][2], const Unit& u, int wr, int wc, int fr, int fq) const {
        using pg8::HALF;
        const float* MOD = (const float*)(ws + WS_MOD) + ((256 * u.ta) >> 12) * 3072 + 2048;
        f32x4 gt[2][2];
#pragma unroll
        for (int bj = 0; bj < 2; ++bj) { const int col = 256 * u.tb + HALF * bj + 32 * wc + 8 * fq; gt[bj][0] = *(const f32x4*)(MOD + col); gt[bj][1] = *(const f32x4*)(MOD + col + 4); }
#pragma unroll
        for (int ai = 0; ai < 2; ++ai) {
            f32x4 xa[4][2][2];
#pragma unroll
            for (int m = 0; m < 4; ++m)
#pragma unroll
                for (int bj = 0; bj < 2; ++bj) {
                    const size_t off = (size_t)(256 * u.ta + HALF * ai + 64 * wr + 16 * m + fr) * 1024 + 256 * u.tb + HALF * bj + 32 * wc + 8 * fq;
                    xa[m][bj][0] = *(const f32x4*)(x + off); xa[m][bj][1] = *(const f32x4*)(x + off + 4);
                }
#pragma unroll
            for (int m = 0; m < 4; ++m) {
                const int row = 256 * u.ta + HALF * ai + 64 * wr + 16 * m + fr;
                float q = 0.f;
#pragma unroll
                for (int bj = 0; bj < 2; ++bj) {
                    const size_t off = (size_t)row * 1024 + 256 * u.tb + HALF * bj + 32 * wc + 8 * fq;
                    const f32x4 o0 = xa[m][bj][0] + gt[bj][0] * acc[ai][bj][m][0], o1 = xa[m][bj][1] + gt[bj][1] * acc[ai][bj][m][1];
                    *(f32x4*)(out + off) = o0; *(f32x4*)(out + off + 4) = o1;
                    q += (o0[0] * o0[0] + o0[1] * o0[1]) + (o0[2] * o0[2] + o0[3] * o0[3]) + (o1[0] * o1[0] + o1[1] * o1[1]) + (o1[2] * o1[2] + o1[3] * o1[3]);
                }
                q += __shfl_xor(q, 16); q += __shfl_xor(q, 32);
                if (fq == 0) ((float*)(ws + WS_SSQO))[(size_t)row * 16 + u.tb * 4 + wc] = q;
            }
        }
    }
};

constexpr int CW_PANEL = 8192;
struct EpiG5F {
    static constexpr bool PERM = true, AFTER_DRAIN = true;
    unsigned char* ws; const float* x; float* out; const float* final_g;
    __device__ __forceinline__ void operator()(const f32x4 (&)[2][2][4][2], const Unit&, int, int, int, int) const {}
    __device__ __forceinline__ void fused(f32x4 (&acc)[2][2][4][2], const Unit& u, int wr, int wc, int fr, int fq, LAS unsigned char* lds, int wid, int lane) const {
        using pg8::HALF;
        const float* MOD = (const float*)(ws + WS_MOD) + ((256 * u.ta) >> 12) * 3072 + 2048;
        LAS float* Pq = (LAS float*)lds;
        LAS float* Sr = (LAS float*)(lds + 4096);
        float* slots = (float*)(ws + WS_SSQO);
        unsigned* cnt = (unsigned*)(ws + WS_CTL) + CW_PANEL + 64 * u.ta;
        f32x4 gt[2][2];
#pragma unroll
        for (int bj = 0; bj < 2; ++bj) { const int col = 256 * u.tb + HALF * bj + 32 * wc + 8 * fq; gt[bj][0] = *(const f32x4*)(MOD + col); gt[bj][1] = *(const f32x4*)(MOD + col + 4); }
#pragma unroll
        for (int ai = 0; ai < 2; ++ai) {
            f32x4 xa[4][2][2];
#pragma unroll
            for (int m = 0; m < 4; ++m)
#pragma unroll
                for (int bj = 0; bj < 2; ++bj) {
                    const size_t off = (size_t)(256 * u.ta + HALF * ai + 64 * wr + 16 * m + fr) * 1024 + 256 * u.tb + HALF * bj + 32 * wc + 8 * fq;
                    xa[m][bj][0] = *(const f32x4*)(x + off); xa[m][bj][1] = *(const f32x4*)(x + off + 4);
                }
#pragma unroll
            for (int m = 0; m < 4; ++m) {
                float q = 0.f;
#pragma unroll
                for (int bj = 0; bj < 2; ++bj) {
                    const f32x4 o0 = xa[m][bj][0] + gt[bj][0] * acc[ai][bj][m][0], o1 = xa[m][bj][1] + gt[bj][1] * acc[ai][bj][m][1];
                    acc[ai][bj][m][0] = o0; acc[ai][bj][m][1] = o1;
                    q += (o0[0] * o0[0] + o0[1] * o0[1]) + (o0[2] * o0[2] + o0[3] * o0[3]) + (o1[0] * o1[0] + o1[1] * o1[1]) + (o1[2] * o1[2] + o1[3] * o1[3]);
                }
                q += __shfl_xor(q, 16); q += __shfl_xor(q, 32);
                if (fq == 0) Pq[(HALF * ai + 64 * wr + 16 * m + fr) * 4 + wc] = q;
            }
        }
        asm volatile("s_waitcnt lgkmcnt(0)" ::: "memory"); __builtin_amdgcn_s_barrier(); asm volatile("" ::: "memory");
        const int row = wid * 32 + (lane & 31);
        if (lane < 32) { const float t = (Pq[row * 4 + 0] + Pq[row * 4 + 1]) + (Pq[row * 4 + 2] + Pq[row * 4 + 3]);
            __hip_atomic_store(slots + (size_t)(256 * u.ta + row) * 16 + 4 * u.tb, t, __ATOMIC_RELAXED, __HIP_MEMORY_SCOPE_AGENT); }
        asm volatile("s_waitcnt vmcnt(0)" ::: "memory");
        if (lane == 0) __hip_atomic_fetch_add(cnt, 1u, __ATOMIC_RELAXED, __HIP_MEMORY_SCOPE_AGENT);
        if (wid == 0) {
            unsigned spins = 0;
            while ((unsigned)__builtin_amdgcn_readfirstlane(__hip_atomic_load(cnt, __ATOMIC_RELAXED, __HIP_MEMORY_SCOPE_AGENT)) < 32u) { __builtin_amdgcn_s_sleep(2); if (++spins > (1u << 22)) break; }
            __builtin_amdgcn_fence(__ATOMIC_ACQUIRE, "agent");
        }
        asm volatile("s_waitcnt vmcnt(0) lgkmcnt(0)" ::: "memory"); __builtin_amdgcn_s_barrier(); asm volatile("" ::: "memory");
        if (lane < 32) { const float* sl = slots + (size_t)(256 * u.ta + row) * 16; float t = 0.f;
#pragma unroll
            for (int k = 0; k < 4; ++k) t += __hip_atomic_load(sl + 4 * k, __ATOMIC_RELAXED, __HIP_MEMORY_SCOPE_AGENT);
            Sr[row] = 1.0f / sqrtf(t * (1.f / DM) + EPS); }
        asm volatile("s_waitcnt vmcnt(0) lgkmcnt(0)" ::: "memory"); __builtin_amdgcn_s_barrier(); asm volatile("" ::: "memory");
        f32x4 fg[2][2];
#pragma unroll
        for (int bj = 0; bj < 2; ++bj) { const int col = 256 * u.tb + HALF * bj + 32 * wc + 8 * fq; fg[bj][0] = *(const f32x4*)(final_g + col); fg[bj][1] = *(const f32x4*)(final_g + col + 4); }
#pragma unroll
        for (int ai = 0; ai < 2; ++ai)
#pragma unroll
            for (int m = 0; m < 4; ++m) { const int r = HALF * ai + 64 * wr + 16 * m + fr; const float rs = Sr[r];
#pragma unroll
                for (int bj = 0; bj < 2; ++bj) { const size_t off = (size_t)(256 * u.ta + r) * 1024 + 256 * u.tb + HALF * bj + 32 * wc + 8 * fq;
                    *(f32x4*)(out + off) = acc[ai][bj][m][0] * rs * fg[bj][0]; *(f32x4*)(out + off + 4) = acc[ai][bj][m][1] * rs * fg[bj][1]; } }
    }
};

__device__ __forceinline__ void p7_final(const Ptrs& P, int lane, int wave, int G) {
    const int gw = blockIdx.x * NWAVES + wave, NGW = G * NWAVES;
    const float* SSQO = (const float*)(P.ws + WS_SSQO);
    for (int row = gw; row < MLAT; row += NGW) {
        float s = 0.f;
        { const f32x4* p = (const f32x4*)(SSQO + (size_t)row * 16); const f32x4 a = p[0], b = p[1], c = p[2], d = p[3];
          s = ((a[0] + a[1]) + (a[2] + a[3])) + ((b[0] + b[1]) + (b[2] + b[3])) + ((c[0] + c[1]) + (c[2] + c[3])) + ((d[0] + d[1]) + (d[2] + d[3])); }
        const float rstd = 1.0f / sqrtf(s * (1.f / DM) + EPS);
        f32x4* o4 = (f32x4*)(P.out + (size_t)row * DM) + lane;
        const f32x4* g4 = (const f32x4*)P.final_g + lane;
#pragma unroll
        for (int j = 0; j < 4; ++j) { f32x4 v = o4[64 * j]; const f32x4 g = g4[64 * j]; v = v * rstd * g; o4[64 * j] = v; }
    }
}

__device__ __forceinline__ int crow(int r, int hi) { return (r & 3) + 8 * (r >> 2) + 4 * hi; }
constexpr int VROW = 136;
constexpr int ATT_RPB_OFF = 96 * 1024;

template <int DK, bool NA>
__device__ __forceinline__ void attn_unit(LAS unsigned char* lds, const bf16* Qg, const bf16* Kg, const bf16* Vtg, bf16* SZ, const float* rpb, int b, int h, int qblk, int tid, int lane, int wave) {
    constexpr int KROW = DK * 2 + 16, KCH = DK / 8  , NKC = 64 * KCH, KT_BYTES = 64 * KROW, VT_BYTES = 64 * VROW, BUF = KT_BYTES + VT_BYTES;
    const int r32 = lane & 31, hi = lane >> 5;
    const int q0 = qblk * 256;
    const bf16* Kh = Kg + (size_t)(b * NH + h) * TK * DK;
    const bf16* Vh = Vtg + (size_t)(b * NH + h) * 64 * TK;
    int ntiles, kr_lo = 0, nwin = 0, rq = 0, cq = 0, rs = 0, cs = 0;
    if (NA) { const int r0 = qblk * 4; auto rst = [](int r) { int s = r - 4; s = s < 0 ? 0 : s; return s > 56 ? 56 : s; };
        kr_lo = rst(r0); nwin = rst(r0 + 3) + 8 - kr_lo; ntiles = nwin + 4;
        rq = r0 + (wave >> 1); cq = 32 * (wave & 1) + r32; rs = rst(rq); cs = cq - 8; cs = cs < 0 ? 0 : cs; cs = cs > 48 ? 48 : cs;
        LAS float* bt = (LAS float*)(lds + ATT_RPB_OFF);
        for (int i = tid; i < 15 * 31; i += 512) bt[i] = rpb[h * 465 + i] * LOG2E;
    } else ntiles = TK / 64;
    bf16x8 qf[DK / 16];
    { const bf16* qp = Qg + ((size_t)(b * NH + h) * SEQ + q0 + 32 * wave + r32) * DK + 8 * hi;
#pragma unroll
      for (int s = 0; s < DK / 16; ++s) qf[s] = *(const bf16x8*)(qp + 16 * s); }
    auto tile_tok = [&](int j) -> int { if (NA) return j < nwin ? (kr_lo + j) * 64 : SEQ + (j - nwin) * 64; return j * 64; };
    v4u kreg0, kreg1, vreg;
    const int kc0 = tid, kc1 = tid + 512;
    auto gload = [&](int j) { const int tok = tile_tok(j);
        const unsigned char* kb = (const unsigned char*)(Kh + (size_t)tok * DK);
        kreg0 = *(const v4u*)(kb + (size_t)kc0 * 16);
        if (kc1 < NKC) kreg1 = *(const v4u*)(kb + (size_t)kc1 * 16);
        vreg = *(const v4u*)((const unsigned char*)(Vh + (size_t)(tid >> 3) * TK + tok) + (tid & 7) * 16); };
    auto lstore = [&](int buf) { LAS unsigned char* base = lds + buf * BUF;
        *(LAS v4u*)(base + (kc0 / KCH) * KROW + (kc0 % KCH) * 16) = kreg0;
        if (kc1 < NKC) *(LAS v4u*)(base + (kc1 / KCH) * KROW + (kc1 % KCH) * 16) = kreg1;
        LAS unsigned char* vp = base + KT_BYTES + (tid >> 3) * VROW + (tid & 7) * 16;
        *(LAS v2u*)vp = (v2u){vreg.x, vreg.y}; *(LAS v2u*)(vp + 8) = (v2u){vreg.z, vreg.w}; };
    float m_run = -1e30f, l_run = 0.f;
    f32x16 o0 = {}, o1 = {};
    gload(0); lstore(0); __syncthreads();
    for (int j = 0; j < ntiles; ++j) {
        const bool more = (j + 1 < ntiles);
        if (more) gload(j + 1);
        bool active = true; int krow = 0;
        if (NA && j < nwin) { krow = kr_lo + j; active = (krow >= rs && krow < rs + 8); }
        if (active) {
            const LAS unsigned char* kb = lds + (j & 1) * BUF;
            const LAS unsigned char* vb = kb + KT_BYTES;
            f32x16 s0 = {}, s1 = {};
#pragma unroll
            for (int s = 0; s < DK / 16; ++s) {
                const bf16x8 k0 = *(const LAS bf16x8*)(kb + r32 * KROW + (16 * s + 8 * hi) * 2);
                const bf16x8 k1 = *(const LAS bf16x8*)(kb + (32 + r32) * KROW + (16 * s + 8 * hi) * 2);
                s0 = __builtin_amdgcn_mfma_f32_32x32x16_bf16(k0, qf[s], s0, 0, 0, 0);
                s1 = __builtin_amdgcn_mfma_f32_32x32x16_bf16(k1, qf[s], s1, 0, 0, 0);
            }
            if (NA && j < nwin) {
                const LAS float* bt = (const LAS float*)(lds + ATT_RPB_OFF) + (krow - rq + 7) * 31 + (15 - cq);
#pragma unroll
                for (int i = 0; i < 16; ++i) {
                    const int kc = crow(i, hi);
                    { const bool ok = (unsigned)(kc - cs) < 16u; const float bv = bt[ok ? kc : cq]; s0[i] = ok ? s0[i] + bv : -1e30f; }
                    { const int kc2 = kc + 32; const bool ok = (unsigned)(kc2 - cs) < 16u; const float bv = bt[ok ? kc2 : cq]; s1[i] = ok ? s1[i] + bv : -1e30f; }
                }
            }
            float mx = fmaxf(s0[0], s1[0]);
#pragma unroll
            for (int i = 1; i < 16; ++i) mx = fmaxf(mx, fmaxf(s0[i], s1[i]));
            mx = fmaxf(mx, __shfl_xor(mx, 32));
            if (__any(mx > m_run + 4.0f)) {
                const float mnew = fmaxf(m_run, mx);
                const float alpha = __builtin_amdgcn_exp2f(m_run - mnew);
                m_run = mnew; l_run *= alpha;
#pragma unroll
                for (int i = 0; i < 16; ++i) { o0[i] *= alpha; o1[i] *= alpha; }
            }
            float ls = 0.f;
#pragma unroll
            for (int i = 0; i < 16; ++i) { s0[i] = __builtin_amdgcn_exp2f(s0[i] - m_run); s1[i] = __builtin_amdgcn_exp2f(s1[i] - m_run); ls += s0[i] + s1[i]; }
            l_run += ls;
            bf16x8 pb[2][2];
#pragma unroll
            for (int kk = 0; kk < 2; ++kk) {
                v4u w0, w1;
                w0.x = cvt_pk_bf16(s0[8 * kk + 0], s0[8 * kk + 1]); w0.y = cvt_pk_bf16(s0[8 * kk + 2], s0[8 * kk + 3]); w0.z = cvt_pk_bf16(s0[8 * kk + 4], s0[8 * kk + 5]); w0.w = cvt_pk_bf16(s0[8 * kk + 6], s0[8 * kk + 7]);
                w1.x = cvt_pk_bf16(s1[8 * kk + 0], s1[8 * kk + 1]); w1.y = cvt_pk_bf16(s1[8 * kk + 2], s1[8 * kk + 3]); w1.z = cvt_pk_bf16(s1[8 * kk + 4], s1[8 * kk + 5]); w1.w = cvt_pk_bf16(s1[8 * kk + 6], s1[8 * kk + 7]);
                pb[0][kk] = __builtin_bit_cast(bf16x8, w0); pb[1][kk] = __builtin_bit_cast(bf16x8, w1);
            }
#pragma unroll
            for (int u = 0; u < 2; ++u)
#pragma unroll
                for (int kk = 0; kk < 2; ++kk) {
                    const int koff = (32 * u + 16 * kk + 4 * hi) * 2;
                    const LAS unsigned char* v0p = vb + r32 * VROW + koff;
                    const LAS unsigned char* v1p = vb + (32 + r32) * VROW + koff;
                    const s16x4 a0 = *(const LAS s16x4*)v0p, a1 = *(const LAS s16x4*)(v0p + 16);
                    const s16x4 c0 = *(const LAS s16x4*)v1p, c1 = *(const LAS s16x4*)(v1p + 16);
                    const bf16x8 vf0 = {a0[0], a0[1], a0[2], a0[3], a1[0], a1[1], a1[2], a1[3]};
                    const bf16x8 vf1 = {c0[0], c0[1], c0[2], c0[3], c1[0], c1[1], c1[2], c1[3]};
                    o0 = __builtin_amdgcn_mfma_f32_32x32x16_bf16(vf0, pb[u][kk], o0, 0, 0, 0);
                    o1 = __builtin_amdgcn_mfma_f32_32x32x16_bf16(vf1, pb[u][kk], o1, 0, 0, 0);
                }
        }
        if (more) lstore((j + 1) & 1);
        __syncthreads();
    }
    const float lt = l_run + __shfl_xor(l_run, 32);
    const float inv = 1.0f / lt;
    bf16* zp = SZ + ((size_t)(b * SEQ + q0 + 32 * wave + r32)) * 512 + h * 64;
#pragma unroll
    for (int dt = 0; dt < 2; ++dt)
#pragma unroll
        for (int g = 0; g < 4; ++g) {
            bf16* p = zp + 32 * dt + 8 * g + 4 * hi;
            const v2u z = *(const v2u*)p;
            const f32x16& o = dt ? o1 : o0;
            v2u w; w.x = cvt_pk_bf16(o[4 * g + 0] * inv * bf_lo(z.x), o[4 * g + 1] * inv * bf_hi(z.x)); w.y = cvt_pk_bf16(o[4 * g + 2] * inv * bf_lo(z.y), o[4 * g + 3] * inv * bf_hi(z.y));
            *(v2u*)p = w;
        }
}


__device__ __forceinline__ void attn_unit_na2(LAS unsigned char* lds, const bf16* Qg, const bf16* Kg, const bf16* Vtg, bf16* SZ, const float* rpb, int b, int h, int qblk, int tid, int lane, int wave) {
    constexpr int DK = 64; constexpr bool NA = true;
    constexpr int KROW = DK * 2 + 16, KCH = DK / 8  , NKC = 64 * KCH, KT_BYTES = 64 * KROW, VT_BYTES = 64 * VROW, SUB = KT_BYTES + VT_BYTES, BUF = 2 * SUB;
    const int r32 = lane & 31, hi = lane >> 5;
    const int q0 = qblk * 256;
    const bf16* Kh = Kg + (size_t)(b * NH + h) * TK * DK;
    const bf16* Vh = Vtg + (size_t)(b * NH + h) * 64 * TK;
    int ntiles, kr_lo = 0, nwin = 0, rq = 0, cq = 0, rs = 0, cs = 0;
    unsigned vmask0 = 0u, vmask1 = 0u;
    if (NA) { const int r0 = qblk * 4; auto rst = [](int r) { int s = r - 4; s = s < 0 ? 0 : s; return s > 56 ? 56 : s; };
        kr_lo = rst(r0); nwin = rst(r0 + 3) + 8 - kr_lo; ntiles = nwin + 4;
        rq = r0 + (wave >> 1); cq = 32 * (wave & 1) + r32; rs = rst(rq); cs = cq - 8; cs = cs < 0 ? 0 : cs; cs = cs > 48 ? 48 : cs;
        for (int i = 0; i < 16; ++i) { const int kc = crow(i, hi); vmask0 |= ((unsigned)(kc - cs) < 16u ? 1u : 0u) << i; vmask1 |= ((unsigned)(kc + 32 - cs) < 16u ? 1u : 0u) << i; }
        LAS float* bt = (LAS float*)(lds + ATT_RPB_OFF);
        for (int i = tid; i < 15 * 31; i += 512) bt[i] = rpb[h * 465 + i] * LOG2E;
    } else ntiles = TK / 64;
    bf16x8 qf[DK / 16];
    { const bf16* qp = Qg + ((size_t)(b * NH + h) * SEQ + q0 + 32 * wave + r32) * DK + 8 * hi;
#pragma unroll
      for (int s = 0; s < DK / 16; ++s) qf[s] = *(const bf16x8*)(qp + 16 * s); }
    auto tile_tok = [&](int j) -> int { if (NA) return j < nwin ? (kr_lo + j) * 64 : SEQ + (j - nwin) * 64; return j * 64; };
    v4u kreg[2], vreg[2];
    const int kc0 = tid;
    auto gload = [&](int jp) {
#pragma unroll
        for (int sub = 0; sub < 2; ++sub) { const int j = 2 * jp + sub; if (j < ntiles) { const int tok = tile_tok(j);
            kreg[sub] = *(const v4u*)((const unsigned char*)(Kh + (size_t)tok * DK) + (size_t)kc0 * 16);
            vreg[sub] = *(const v4u*)((const unsigned char*)(Vh + (size_t)(tid >> 3) * TK + tok) + (tid & 7) * 16); } } };
    auto lstore = [&](int buf, int jp) {
#pragma unroll
        for (int sub = 0; sub < 2; ++sub) { if (2 * jp + sub < ntiles) { LAS unsigned char* base = lds + buf * BUF + sub * SUB;
            *(LAS v4u*)(base + (kc0 / KCH) * KROW + (kc0 % KCH) * 16) = kreg[sub];
            LAS unsigned char* vp = base + KT_BYTES + (tid >> 3) * VROW + (tid & 7) * 16;
            *(LAS v2u*)vp = (v2u){vreg[sub].x, vreg[sub].y}; *(LAS v2u*)(vp + 8) = (v2u){vreg[sub].z, vreg[sub].w}; } } };
    float m_run = -1e30f, l_run = 0.f;
    f32x16 o0 = {}, o1 = {};
    const int npairs = (ntiles + 1) >> 1;
    gload(0); lstore(0, 0); __syncthreads();
    for (int jp = 0; jp < npairs; ++jp) {
        const bool more = (jp + 1 < npairs);
        if (more) gload(jp + 1);
#pragma unroll
        for (int sub = 0; sub < 2; ++sub) {
        const int j = 2 * jp + sub;
        bool active = (j < ntiles); int krow = 0;
        if (NA && j < nwin) { krow = kr_lo + j; active = (krow >= rs && krow < rs + 8); }
        if (active) {
            const LAS unsigned char* kb = lds + (jp & 1) * BUF + sub * SUB;
            const LAS unsigned char* vb = kb + KT_BYTES;
            f32x16 s0 = {}, s1 = {};
#pragma unroll
            for (int s = 0; s < DK / 16; ++s) {
                const bf16x8 k0 = *(const LAS bf16x8*)(kb + r32 * KROW + (16 * s + 8 * hi) * 2);
                const bf16x8 k1 = *(const LAS bf16x8*)(kb + (32 + r32) * KROW + (16 * s + 8 * hi) * 2);
                s0 = __builtin_amdgcn_mfma_f32_32x32x16_bf16(k0, qf[s], s0, 0, 0, 0);
                s1 = __builtin_amdgcn_mfma_f32_32x32x16_bf16(k1, qf[s], s1, 0, 0, 0);
            }
            if (NA && j < nwin) {
                const LAS float* bt = (const LAS float*)(lds + ATT_RPB_OFF) + (krow - rq + 7) * 31 + (15 - cq);
#pragma unroll
                for (int i = 0; i < 16; ++i) {
                    const LAS float* bp = bt + 4 * hi;
                    const int kci = (i & 3) + 8 * (i >> 2);
                    { const float bv = bp[kci]; s0[i] = ((vmask0 >> i) & 1u) ? s0[i] + bv : -1e30f; }
                    { const float bv = bp[kci + 32]; s1[i] = ((vmask1 >> i) & 1u) ? s1[i] + bv : -1e30f; }
                }
            }
            float mx = fmaxf(s0[0], s1[0]);
#pragma unroll
            for (int i = 1; i < 16; ++i) mx = fmaxf(mx, fmaxf(s0[i], s1[i]));
            mx = fmaxf(mx, __shfl_xor(mx, 32));
            if (__any(mx > m_run + 4.0f)) {
                const float mnew = fmaxf(m_run, mx);
                const float alpha = __builtin_amdgcn_exp2f(m_run - mnew);
                m_run = mnew; l_run *= alpha;
#pragma unroll
                for (int i = 0; i < 16; ++i) { o0[i] *= alpha; o1[i] *= alpha; }
            }
            float ls = 0.f;
#pragma unroll
            for (int i = 0; i < 16; ++i) { s0[i] = __builtin_amdgcn_exp2f(s0[i] - m_run); s1[i] = __builtin_amdgcn_exp2f(s1[i] - m_run); ls += s0[i] + s1[i]; }
            l_run += ls;
            bf16x8 pb[2][2];
#pragma unroll
            for (int kk = 0; kk < 2; ++kk) {
                v4u w0, w1;
                w0.x = cvt_pk_bf16(s0[8 * kk + 0], s0[8 * kk + 1]); w0.y = cvt_pk_bf16(s0[8 * kk + 2], s0[8 * kk + 3]); w0.z = cvt_pk_bf16(s0[8 * kk + 4], s0[8 * kk + 5]); w0.w = cvt_pk_bf16(s0[8 * kk + 6], s0[8 * kk + 7]);
                w1.x = cvt_pk_bf16(s1[8 * kk + 0], s1[8 * kk + 1]); w1.y = cvt_pk_bf16(s1[8 * kk + 2], s1[8 * kk + 3]); w1.z = cvt_pk_bf16(s1[8 * kk + 4], s1[8 * kk + 5]); w1.w = cvt_pk_bf16(s1[8 * kk + 6], s1[8 * kk + 7]);
                pb[0][kk] = __builtin_bit_cast(bf16x8, w0); pb[1][kk] = __builtin_bit_cast(bf16x8, w1);
            }
#pragma unroll
            for (int u = 0; u < 2; ++u)
#pragma unroll
                for (int kk = 0; kk < 2; ++kk) {
                    const int koff = (32 * u + 16 * kk + 4 * hi) * 2;
                    const LAS unsigned char* v0p = vb + r32 * VROW + koff;
                    const LAS unsigned char* v1p = vb + (32 + r32) * VROW + koff;
                    const s16x4 a0 = *(const LAS s16x4*)v0p, a1 = *(const LAS s16x4*)(v0p + 16);
                    const s16x4 c0 = *(const LAS s16x4*)v1p, c1 = *(const LAS s16x4*)(v1p + 16);
                    const bf16x8 vf0 = {a0[0], a0[1], a0[2], a0[3], a1[0], a1[1], a1[2], a1[3]};
                    const bf16x8 vf1 = {c0[0], c0[1], c0[2], c0[3], c1[0], c1[1], c1[2], c1[3]};
                    o0 = __builtin_amdgcn_mfma_f32_32x32x16_bf16(vf0, pb[u][kk], o0, 0, 0, 0);
                    o1 = __builtin_amdgcn_mfma_f32_32x32x16_bf16(vf1, pb[u][kk], o1, 0, 0, 0);
                }
        }
        }
        if (more) lstore((jp + 1) & 1, jp + 1);
        __syncthreads();
    }
    const float lt = l_run + __shfl_xor(l_run, 32);
    const float inv = 1.0f / lt;
    bf16* zp = SZ + ((size_t)(b * SEQ + q0 + 32 * wave + r32)) * 512 + h * 64;
#pragma unroll
    for (int dt = 0; dt < 2; ++dt)
#pragma unroll
        for (int g = 0; g < 4; ++g) {
            bf16* p = zp + 32 * dt + 8 * g + 4 * hi;
            const v2u z = *(const v2u*)p;
            const f32x16& o = dt ? o1 : o0;
            v2u w; w.x = cvt_pk_bf16(o[4 * g + 0] * inv * bf_lo(z.x), o[4 * g + 1] * inv * bf_hi(z.x)); w.y = cvt_pk_bf16(o[4 * g + 2] * inv * bf_lo(z.y), o[4 * g + 3] * inv * bf_hi(z.y));
            *(v2u*)p = w;
        }
}


__device__ __forceinline__ void attn_unit_mla2(LAS unsigned char* lds, const bf16* Qg, const bf16* Kg, const bf16* Vtg, bf16* SZ, int b, int h, int qblk, int tid, int lane, int wave) {
    constexpr int DK = 96, KROW = DK * 2 + 16, KCH = DK / 8, NKC = 64 * KCH, KT_BYTES = 64 * KROW, VT_BYTES = 64 * VROW, SUB = KT_BYTES + VT_BYTES, BUF = 2 * SUB;
    const int r32 = lane & 31, hi = lane >> 5;
    const int q0 = qblk * 256;
    const bf16* Kh = Kg + (size_t)(b * NH + h) * TK * DK;
    const bf16* Vh = Vtg + (size_t)(b * NH + h) * 64 * TK;
    constexpr int ntiles = TK / 128;
    bf16x8 qf[DK / 16];
    { const bf16* qp = Qg + ((size_t)(b * NH + h) * SEQ + q0 + 32 * wave + r32) * DK + 8 * hi;
#pragma unroll
      for (int s = 0; s < DK / 16; ++s) qf[s] = *(const bf16x8*)(qp + 16 * s); }
    v4u kreg[2][2], vreg[2];
    const int kc0 = tid, kc1 = tid + 512;
    auto gload = [&](int j) {
#pragma unroll
        for (int sub = 0; sub < 2; ++sub) { const int tok = j * 128 + 64 * sub;
            const unsigned char* kb = (const unsigned char*)(Kh + (size_t)tok * DK);
            kreg[sub][0] = *(const v4u*)(kb + (size_t)kc0 * 16);
            if (kc1 < NKC) kreg[sub][1] = *(const v4u*)(kb + (size_t)kc1 * 16);
            vreg[sub] = *(const v4u*)((const unsigned char*)(Vh + (size_t)(tid >> 3) * TK + tok) + (tid & 7) * 16); } };
    auto lstore = [&](int buf) {
#pragma unroll
        for (int sub = 0; sub < 2; ++sub) { LAS unsigned char* base = lds + buf * BUF + sub * SUB;
            *(LAS v4u*)(base + (kc0 / KCH) * KROW + (kc0 % KCH) * 16) = kreg[sub][0];
            if (kc1 < NKC) *(LAS v4u*)(base + (kc1 / KCH) * KROW + (kc1 % KCH) * 16) = kreg[sub][1];
            LAS unsigned char* vp = base + KT_BYTES + (tid >> 3) * VROW + (tid & 7) * 16;
            *(LAS v2u*)vp = (v2u){vreg[sub].x, vreg[sub].y}; *(LAS v2u*)(vp + 8) = (v2u){vreg[sub].z, vreg[sub].w}; } };
    float m_run = 0.f, l_run = 0.f;
    f32x16 o0 = {}, o1 = {};
    gload(0); lstore(0); __syncthreads();
    for (int j = 0; j < ntiles; ++j) {
        const bool more = (j + 1 < ntiles);
        if (more) gload(j + 1);
        const LAS unsigned char* tb = lds + (j & 1) * BUF;
        f32x16 s[2][2];
        f32x16 negm;
#pragma unroll
        for (int i = 0; i < 16; ++i) negm[i] = -m_run;
        const LAS unsigned char* kp0 = tb + r32 * KROW + 16 * hi;
        const LAS unsigned char* vp0 = tb + KT_BYTES + r32 * VROW + 8 * hi;
#define KFRAG(sub, u, st) (*(const LAS bf16x8*)(kp0 + (sub) * SUB + (u) * 32 * KROW + (st) * 32))
        bf16x8 ka[DK / 16][2], kb2[DK / 16][2];
#pragma unroll
        for (int st = 0; st < DK / 16; ++st) { ka[st][0] = KFRAG(0, 0, st); ka[st][1] = KFRAG(0, 1, st); }
        __builtin_amdgcn_sched_barrier(0);
#pragma unroll
        for (int st = 0; st < DK / 16; ++st) {
            kb2[st][0] = KFRAG(1, 0, st); kb2[st][1] = KFRAG(1, 1, st);
            s[0][0] = __builtin_amdgcn_mfma_f32_32x32x16_bf16(ka[st][0], qf[st], st == 0 ? negm : s[0][0], 0, 0, 0);
            s[0][1] = __builtin_amdgcn_mfma_f32_32x32x16_bf16(ka[st][1], qf[st], st == 0 ? negm : s[0][1], 0, 0, 0);
        }
        __builtin_amdgcn_sched_barrier(0);
        s16x4 va[2][2][2][2];
#define VFRAG(sub, u, kk, dt, half) (*(const LAS s16x4*)(vp0 + (sub) * SUB + (dt) * 32 * VROW + (32 * (u) + 16 * (kk)) * 2 + (half) * 16))
#pragma unroll
        for (int u = 0; u < 2; ++u)
#pragma unroll
            for (int kk = 0; kk < 2; ++kk)
#pragma unroll
                for (int dt = 0; dt < 2; ++dt) { va[u][kk][dt][0] = VFRAG(0, u, kk, dt, 0); va[u][kk][dt][1] = VFRAG(0, u, kk, dt, 1); }
#pragma unroll
        for (int st = 0; st < DK / 16; ++st) {
            s[1][0] = __builtin_amdgcn_mfma_f32_32x32x16_bf16(kb2[st][0], qf[st], st == 0 ? negm : s[1][0], 0, 0, 0);
            s[1][1] = __builtin_amdgcn_mfma_f32_32x32x16_bf16(kb2[st][1], qf[st], st == 0 ? negm : s[1][1], 0, 0, 0);
        }
        __builtin_amdgcn_sched_barrier(0);
        float mx = fmaxf(fmaxf(s[0][0][0], s[0][1][0]), fmaxf(s[1][0][0], s[1][1][0]));
#pragma unroll
        for (int i = 1; i < 16; ++i) mx = fmaxf(mx, fmaxf(fmaxf(s[0][0][i], s[0][1][i]), fmaxf(s[1][0][i], s[1][1][i])));
        mx = fmaxf(mx, __shfl_xor(mx, 32));
        if (j == 0 || __any(mx > 4.0f)) {
            const float d = (j == 0) ? mx : fmaxf(mx, 0.f);
            const float alpha = (j == 0) ? 0.f : __builtin_amdgcn_exp2f(-d);
            m_run += d; l_run *= alpha;
#pragma unroll
            for (int i = 0; i < 16; ++i) { o0[i] *= alpha; o1[i] *= alpha; }
#pragma unroll
            for (int sub = 0; sub < 2; ++sub)
#pragma unroll
                for (int u = 0; u < 2; ++u)
#pragma unroll
                    for (int i = 0; i < 16; ++i) s[sub][u][i] -= d;
        }
        float ls = 0.f;
#pragma unroll
        for (int sub = 0; sub < 2; ++sub)
#pragma unroll
            for (int u = 0; u < 2; ++u)
#pragma unroll
                for (int i = 0; i < 16; ++i) { s[sub][u][i] = __builtin_amdgcn_exp2f(s[sub][u][i]); ls += s[sub][u][i]; }
        l_run += ls;
        __builtin_amdgcn_sched_barrier(0);
        s16x4 vb2[2][2][2][2];
#define PFRAG(sub, u, kk) ({ v4u w_; const f32x16& sv_ = s[sub][u]; w_.x = cvt_pk_bf16(sv_[8 * (kk) + 0], sv_[8 * (kk) + 1]); w_.y = cvt_pk_bf16(sv_[8 * (kk) + 2], sv_[8 * (kk) + 3]); \
            w_.z = cvt_pk_bf16(sv_[8 * (kk) + 4], sv_[8 * (kk) + 5]); w_.w = cvt_pk_bf16(sv_[8 * (kk) + 6], sv_[8 * (kk) + 7]); __builtin_bit_cast(bf16x8, w_); })
#define V8(a_) ((bf16x8){(a_)[0][0], (a_)[0][1], (a_)[0][2], (a_)[0][3], (a_)[1][0], (a_)[1][1], (a_)[1][2], (a_)[1][3]})
#pragma unroll
        for (int u = 0; u < 2; ++u)
#pragma unroll
            for (int kk = 0; kk < 2; ++kk) {
#pragma unroll
                for (int dt = 0; dt < 2; ++dt) { vb2[u][kk][dt][0] = VFRAG(1, u, kk, dt, 0); vb2[u][kk][dt][1] = VFRAG(1, u, kk, dt, 1); }
                const bf16x8 pb = PFRAG(0, u, kk);
                o0 = __builtin_amdgcn_mfma_f32_32x32x16_bf16(V8(va[u][kk][0]), pb, o0, 0, 0, 0);
                o1 = __builtin_amdgcn_mfma_f32_32x32x16_bf16(V8(va[u][kk][1]), pb, o1, 0, 0, 0);
            }
        __builtin_amdgcn_sched_barrier(0);
#pragma unroll
        for (int u = 0; u < 2; ++u)
#pragma unroll
            for (int kk = 0; kk < 2; ++kk) {
                const bf16x8 pb = PFRAG(1, u, kk);
                o0 = __builtin_amdgcn_mfma_f32_32x32x16_bf16(V8(vb2[u][kk][0]), pb, o0, 0, 0, 0);
                o1 = __builtin_amdgcn_mfma_f32_32x32x16_bf16(V8(vb2[u][kk][1]), pb, o1, 0, 0, 0);
            }
#undef KFRAG
#undef VFRAG
#undef PFRAG
#undef V8
        if (more) lstore((j + 1) & 1);
        __syncthreads();
    }
    const float lt = l_run + __shfl_xor(l_run, 32);
    const float inv = 1.0f / lt;
    bf16* zp = SZ + ((size_t)(b * SEQ + q0 + 32 * wave + r32)) * 512 + h * 64;
#pragma unroll
    for (int dt = 0; dt < 2; ++dt)
#pragma unroll
        for (int g = 0; g < 4; ++g) {
            bf16* p = zp + 32 * dt + 8 * g + 4 * hi;
            const v2u z = *(const v2u*)p;
            const f32x16& o = dt ? o1 : o0;
            v2u w; w.x = cvt_pk_bf16(o[4 * g + 0] * inv * bf_lo(z.x), o[4 * g + 1] * inv * bf_hi(z.x)); w.y = cvt_pk_bf16(o[4 * g + 2] * inv * bf_lo(z.y), o[4 * g + 3] * inv * bf_hi(z.y));
            *(v2u*)p = w;
        }
}

constexpr int CW_CTXKV = 12288;
__device__ __forceinline__ void p4_attention(const Ptrs& P, LAS unsigned char* lds, int tid, int lane, int wave, int G) {
    const int bx = blockIdx.x; const int vcu = (G % 8 == 0) ? (bx % 8) * (G / 8) + bx / 8 : bx;
    for (int u = vcu; u < 512; u += G) { const int bh = u >> 4, qb = u & 15;
        attn_unit_na2(lds, (const bf16*)(P.ws + WS_QB), (const bf16*)(P.ws + WS_KB), (const bf16*)(P.ws + WS_VBT), (bf16*)(P.ws + WS_SZB), P.rpb, bh >> 3, bh & 7, qb, tid, lane, wave); }
    if (tid == 0) { unsigned* cnt = (unsigned*)(P.ws + WS_CTL) + CW_CTXKV; unsigned spins = 0;
        while (__hip_atomic_load(cnt, __ATOMIC_RELAXED, __HIP_MEMORY_SCOPE_AGENT) < 16u) { __builtin_amdgcn_s_sleep(2); if (++spins > (1u << 22)) break; }
        __builtin_amdgcn_fence(__ATOMIC_ACQUIRE, "agent"); asm volatile("s_waitcnt vmcnt(0)" ::: "memory"); }
    __syncthreads();
    for (int u = vcu; u < 512; u += G) { const int bh = u >> 4, qb = u & 15;
        attn_unit_mla2(lds, (const bf16*)(P.ws + WS_QA), (const bf16*)((unsigned char*)P.out + DO_KA), (const bf16*)((unsigned char*)P.out + DO_VAT), (bf16*)(P.ws + WS_SZA), bh >> 3, bh & 7, qb, tid, lane, wave); }
}

struct Args { Ptrs p; int ph_lo, ph_hi; };
constexpr int N_PHASES = 8;
__global__ void __launch_bounds__(NWAVES * 64, 2) mk_fwd(Args args) {
    extern __shared__ __attribute__((aligned(16))) unsigned char lds_raw[];
    LAS unsigned char* lds = (LAS unsigned char*)lds_raw;
    const Ptrs& P = args.p;
    const int tid = threadIdx.x, lane = tid & 63, wave = __builtin_amdgcn_readfirstlane(tid >> 6);
    const int G = gridDim.x;
    volatile LAS unsigned* MISC = (volatile LAS unsigned*)(lds + MISC_OFF);
    for (int u = tid; u < 32; u += NWAVES * 64) MISC[u] = 0u;
    __syncthreads();
    XcdBarrier bar; bar.bar = (unsigned*)(P.ws + WS_CTL) + CW_BAR; bar.x = 0; bar.st = nullptr;
    if (MK_N_LAUNCHES == 1) bar = xcd_barrier_post((unsigned*)(P.ws + WS_CTL) + CW_BAR, MISC + 8);
    const int lo = args.ph_lo, hi = args.ph_hi;
    int K1024 = 1024, K512 = 512, K256 = 256; asm volatile("" : "+s"(K1024), "+s"(K512), "+s"(K256));
#ifndef PH_MASK
#define PH_MASK 0xff
#endif
#define IN(k) (((PH_MASK >> (k)) & 1) && lo <= (k) && (k) < hi)
#define SEAM(k) do { if (IN(k) && IN((k) + 1)) xcd_barrier(bar); } while (0)
    unsigned char* ws = P.ws; unsigned char* dout = (unsigned char*)P.out;

    if (IN(0)) { p0_gemv(P, lds, tid, lane, wave, G); }
    SEAM(0);
    if (IN(1)) { p0_weights(P, lds, tid, lane, wave, G); p1_hconv(P, lane, wave, G); }
    SEAM(1);
    if (IN(2)) { SchedG1 S{G, (int)blockIdx.x, (const char*)(ws + WS_H), (const char*)(ws + WS_WIN)}; EpiG1 E{ws, dout};
        pg8::gemm_phase<EpiG1, SchedG1, true, true>(lds, K1024, S, E); }
    SEAM(2);
    const int nCtx = (G >= 64) ? 20 : G, g23_first = (G >= 64) ? 20 : 0;
    if (IN(3)) { { SchedG1C S{nCtx, (int)blockIdx.x, (const char*)(ws + WS_H), (const char*)(ws + WS_WIN)}; EpiG1 E{ws, dout}; pg8::gemm_phase<EpiG1, SchedG1C, true, true>(lds, K1024, S, E); }
        { SchedG23 S{g23_first, G - g23_first, (int)blockIdx.x, (const char*)ws}; EpiG23 E{ws, dout}; pg8::gemm_phase<EpiG23, SchedG23, true, true>(lds, K256, S, E); } }
    SEAM(3);
    if (IN(4)) {
        const int nKv = (G >= 16) ? 16 : G; int my_units = 0; for (int k = (int)blockIdx.x; k < 16 && (int)blockIdx.x < nKv; k += nKv) ++my_units;
        { SchedG23C S{nKv, (int)blockIdx.x, (const char*)ws}; EpiG23 E{ws, dout}; pg8::gemm_phase<EpiG23, SchedG23C, true, true>(lds, K256, S, E); }
        if (my_units > 0) {
            asm volatile("s_waitcnt vmcnt(0)" ::: "memory"); __syncthreads();
            if (tid == 0) { __builtin_amdgcn_fence(__ATOMIC_RELEASE, "agent"); asm volatile("s_waitcnt vmcnt(0)" ::: "memory");
                __hip_atomic_fetch_add((unsigned*)(ws + WS_CTL) + CW_CTXKV, (unsigned)my_units, __ATOMIC_RELAXED, __HIP_MEMORY_SCOPE_AGENT); }
        }
        p4_attention(P, lds, tid, lane, wave, G); }
    SEAM(4);
    if (IN(5)) { SchedG4 S{G, (int)blockIdx.x, (const char*)(ws + WS_SZA), (const char*)(ws + WS_SZB), (const char*)(ws + WS_WOA), (const char*)(ws + WS_WOB)}; EpiG4 E{ws, P.out};
        pg8::gemm_phase<EpiG4, SchedG4, true, true>(lds, K512, S, E); }
    SEAM(5);
    const bool fuse_final = (G == 256) && IN(6) && IN(7);
    if (IN(6)) { SchedG5 S{G, (int)blockIdx.x, (const char*)(ws + WS_M), (const char*)(ws + WS_WOUT)};
        if (fuse_final) { EpiG5F E{ws, P.x, P.out, P.final_g}; pg8::gemm_phase<EpiG5F, SchedG5, false, true>(lds, K1024, S, E); }
        else { EpiG5 E{ws, P.x, P.out}; pg8::gemm_phase<EpiG5, SchedG5, true, true>(lds, K1024, S, E); } }
    if (!fuse_final) {
    SEAM(6);
    if (IN(7)) { p7_final(P, lane, wave, G); }
    }
#undef IN
#undef SEAM
}

extern "C" void kernel_launch(void* const* d_in, const int* in_sizes, int n_in, void* d_out, int out_size, void* d_ws, size_t ws_size, hipStream_t stream) {
    static int grid = 0;
    if (grid == 0) {
        if (n_in != 17 || in_sizes[0] != MLAT * DM || out_size != MLAT * DM || ws_size < WS_END) { fprintf(stderr, "kernel_launch: unexpected shapes (n_in %d, ws %zu); nothing launched\n", n_in, ws_size); grid = -1; return; }
        int dev = 0, cus = 0, per_cu = 0;
        if (hipGetDevice(&dev) != hipSuccess || hipDeviceGetAttribute(&cus, hipDeviceAttributeMultiprocessorCount, dev) != hipSuccess) { grid = -1; return; }
        if (hipFuncSetAttribute((const void*)mk_fwd, hipFuncAttributeMaxDynamicSharedMemorySize, LDS_BYTES) != hipSuccess) { fprintf(stderr, "kernel_launch: hipFuncSetAttribute failed\n"); grid = -1; return; }
        if (hipOccupancyMaxActiveBlocksPerMultiprocessor(&per_cu, (const void*)mk_fwd, NWAVES * 64, LDS_BYTES) != hipSuccess || per_cu < 1) fprintf(stderr, "kernel_launch: occupancy query says %d\n", per_cu);
        (void)hipGetLastError();
        grid = cus;
    }
    if (grid < 0) return;
    if (hipMemsetAsync((char*)d_ws + WS_CTL, 0, CTL_ZERO_BYTES, stream) != hipSuccess) { fprintf(stderr, "kernel_launch: memset failed\n"); return; }
    Args a{};
    const float** pp = (const float**)&a.p;
    for (int i = 0; i < 17; ++i) pp[i] = (const float*)d_in[i];
    a.p.out = (float*)d_out; a.p.ws = (unsigned char*)d_ws;
    if (MK_N_LAUNCHES == 1) {
        a.ph_lo = 0; a.ph_hi = N_PHASES;
        void* kargs[] = {&a};
        hipError_t e = hipLaunchCooperativeKernel((const void*)mk_fwd, dim3(grid), dim3(NWAVES * 64), kargs, LDS_BYTES, stream);
        if (e != hipSuccess) fprintf(stderr, "kernel_launch: cooperative launch failed: %s (grid %d)\n", hipGetErrorString(e), grid);
    } else {
        for (int k = 0; k < N_PHASES; ++k) { a.ph_lo = k; a.ph_hi = k + 1; hipLaunchKernelGGL(mk_fwd, dim3(grid), dim3(NWAVES * 64), LDS_BYTES, stream, a); }
    }
}
```

```cpp
#include <hip/hip_runtime.h>
#include <hip/hip_bf16.h>
#include <cstdio>
#include <cstdint>
#include <cmath>

#ifndef MK_N_LAUNCHES
#define MK_N_LAUNCHES 1
#endif

namespace pg8 {
#define PG8_LAS __attribute__((address_space(3)))
typedef unsigned short bf16_t;
typedef short bf16x8 __attribute__((ext_vector_type(8)));
typedef float f32x4 __attribute__((ext_vector_type(4)));
typedef unsigned u32x4 __attribute__((ext_vector_type(4)));
typedef unsigned u32x2 __attribute__((ext_vector_type(2)));
constexpr int BM = 256, BK = 64, HALF = 128, HTB = HALF * BK * 2  , STAGE_BYTES = 8 * HTB, NXCD = 8, WGM = 8;

__host__ __device__ __forceinline__ int lds_byte(int r, int c) { const int st = (r >> 4) * 2 + (c >> 5), rr = r & 15, cc = c & 31, ob = rr * 64 + cc * 2; return st * 1024 + (ob ^ (((ob >> 9) & 1) << 5)); }
__host__ __device__ __forceinline__ void stage_rc(int b, int& R, int& C) { const int st = b / 1024, sb = b % 1024, swz = sb ^ (((sb >> 9) & 1) << 5); R = (st >> 1) * 16 + swz / 64; C = (st & 1) * 32 + (swz % 64) / 2; }
__host__ __device__ __forceinline__ int perm32(int rho) { const int n = rho >> 4, i = rho & 15; return 8 * (i >> 2) + 4 * n + (i & 3); }

struct Unit { int ta, tb, kind; };
typedef float f32x2_cv __attribute__((ext_vector_type(2))); typedef __bf16 bf16x2_cv __attribute__((ext_vector_type(2)));
__device__ __forceinline__ unsigned cvt_pk_bf16(float lo, float hi) { const f32x2_cv v = {lo, hi}; const bf16x2_cv b = __builtin_convertvector(v, bf16x2_cv); return __builtin_bit_cast(unsigned, b); }

template <class Epi, class Sched, bool ALIGN_EPI = false, bool SP2 = false>
__device__ __forceinline__ void gemm_phase(PG8_LAS unsigned char* lds, const int K, const Sched& S, const Epi& E) {
    int tid = threadIdx.x; asm volatile("" : "+v"(tid));
    const int wid = __builtin_amdgcn_readfirstlane(tid >> 6), lane = tid & 63, wr = wid >> 2, wc = wid & 3, fr = lane & 15, fq = lane >> 4;
    const int nt = K / BK;
    unsigned voffA[2], voffB[2];
#pragma unroll
    for (int i = 0; i < 2; ++i) { int R, C; stage_rc(tid * 16 + i * 8192, R, C); const int Rb = Epi::PERM ? ((R & ~31) + perm32(R & 31)) : R;
        voffA[i] = (unsigned)(R * K + C) * 2u; voffB[i] = (unsigned)(Rb * K + C) * 2u; }
    const size_t kstep = (size_t)(BK * 2);
    const size_t hstep = (size_t)HALF * K * 2;
    const unsigned ldsw = (unsigned)wid * 1024u;
    const int aoff = lds_byte(wr * 64 + fr, fq * 8), boff = lds_byte(wc * 32 + fr, fq * 8);
#define PG8_SA(b, h) (((b) * 2 + (h)) * HTB)
#define PG8_SB(b, h) ((4 + (b) * 2 + (h)) * HTB)
#define PG8_STAGE(bufoff, gbase, voff) do { _Pragma("unroll") for (int _i = 0; _i < 2; ++_i) \
        __builtin_amdgcn_global_load_lds((const unsigned*)((const char*)(gbase) + (voff)[_i]), (PG8_LAS unsigned*)(lds + (bufoff) + ldsw + _i * 8192), 16, 0, 0); } while (0)
#define PG8_LDA(dst, b, h) do { _Pragma("unroll") for (int m = 0; m < 4; ++m) _Pragma("unroll") for (int k = 0; k < 2; ++k) dst[m][k] = *(const PG8_LAS bf16x8*)(lds + PG8_SA(b, h) + aoff + m * 2048 + k * 1024); } while (0)
#define PG8_LDB(dst, b, h) do { _Pragma("unroll") for (int n = 0; n < 2; ++n) _Pragma("unroll") for (int k = 0; k < 2; ++k) dst[n][k] = *(const PG8_LAS bf16x8*)(lds + PG8_SB(b, h) + boff + n * 2048 + k * 1024); } while (0)
#define PG8_MMA(ai, bj, At, Bt) do { __builtin_amdgcn_s_setprio(1); _Pragma("unroll") for (int m = 0; m < 4; ++m) _Pragma("unroll") for (int n = 0; n < 2; ++n) _Pragma("unroll") for (int k = 0; k < 2; ++k) \
        acc[ai][bj][m][n] = __builtin_amdgcn_mfma_f32_16x16x32_bf16(Bt[n][k], At[m][k], acc[ai][bj][m][n], 0, 0, 0); __builtin_amdgcn_s_setprio(0); } while (0)
#define PG8_WAIT_V(n) asm volatile("s_waitcnt vmcnt(" #n ")" ::: "memory")
#define PG8_WAIT_L(n) asm volatile("s_waitcnt lgkmcnt(" #n ")" ::: "memory")
#define PG8_BAR __builtin_amdgcn_s_barrier()
#define PG8_SCHED __builtin_amdgcn_sched_barrier(0)
    Unit cur, nxt; int ui = 0;
    if (!S.next(0, cur)) return;
    f32x4 acc[2][2][4][2];
#pragma unroll
    for (int a = 0; a < 2; ++a)
#pragma unroll
        for (int b = 0; b < 2; ++b)
#pragma unroll
            for (int m = 0; m < 4; ++m)
#pragma unroll
                for (int n = 0; n < 2; ++n) acc[a][b][m][n] = (f32x4){0.f, 0.f, 0.f, 0.f};
    bf16x8 At[4][2], B0[2][2], B1[2][2];
    const char* cA = S.aptr(cur); const char* cB = S.bptr(cur);
    if constexpr (SP2) {
        PG8_STAGE(PG8_SB(0, 0), cB, voffB); PG8_STAGE(PG8_SB(0, 1), cB + hstep, voffB); PG8_STAGE(PG8_SA(0, 0), cA, voffA); PG8_STAGE(PG8_SA(0, 1), cA + hstep, voffA);
        if (wr == 1) PG8_BAR;
        PG8_WAIT_V(2); PG8_BAR;
        PG8_STAGE(PG8_SB(1, 0), cB + kstep, voffB); PG8_STAGE(PG8_SA(1, 0), cA + kstep, voffA); PG8_STAGE(PG8_SB(1, 1), cB + hstep + kstep, voffB);
        PG8_WAIT_V(6); PG8_BAR;
    } else {
        PG8_STAGE(PG8_SB(0, 0), cB, voffB); PG8_STAGE(PG8_SA(0, 0), cA, voffA); PG8_STAGE(PG8_SB(0, 1), cB + hstep, voffB); PG8_STAGE(PG8_SA(0, 1), cA + hstep, voffA);
        if (wr == 1) PG8_BAR;
        PG8_WAIT_V(4); PG8_BAR;
        PG8_STAGE(PG8_SB(1, 0), cB + kstep, voffB); PG8_STAGE(PG8_SA(1, 0), cA + kstep, voffA); PG8_STAGE(PG8_SB(1, 1), cB + hstep + kstep, voffB);
        PG8_WAIT_V(6); PG8_BAR;
    }
    for (;;) {
        const bool has_next = S.next(ui + 1, nxt);
        const char* nA = has_next ? S.aptr(nxt) : cA; const char* nB = has_next ? S.bptr(nxt) : cB;
        for (int t = 0; t < nt; t += 2) {
            const bool last = (t == nt - 2);
            const char* a1 = cA + (size_t)(t + 1) * kstep;
            const char* a2 = last ? nA : cA + (size_t)(t + 2) * kstep; const char* b2 = last ? nB : cB + (size_t)(t + 2) * kstep;
            const char* a3 = a2 + kstep; const char* b3 = b2 + kstep;
            if constexpr (SP2) {
            PG8_LDB(B0, 0, 0); PG8_LDB(B1, 0, 1); PG8_SCHED; PG8_LDA(At, 0, 0); PG8_STAGE(PG8_SA(1, 1), a1 + hstep, voffA);
            PG8_WAIT_V(8); PG8_WAIT_L(0); PG8_BAR; PG8_MMA(0, 0, At, B0); PG8_MMA(0, 1, At, B1); PG8_BAR; PG8_SCHED;
            PG8_LDA(At, 0, 1); PG8_STAGE(PG8_SB(0, 0), b2, voffB); PG8_STAGE(PG8_SB(0, 1), b2 + hstep, voffB); PG8_STAGE(PG8_SA(0, 0), a2, voffA);
            PG8_WAIT_V(8); PG8_WAIT_L(0); PG8_BAR; PG8_MMA(1, 0, At, B0); PG8_MMA(1, 1, At, B1); PG8_BAR; PG8_SCHED;
            PG8_LDB(B0, 1, 0); PG8_LDB(B1, 1, 1); PG8_SCHED; PG8_LDA(At, 1, 0); PG8_STAGE(PG8_SA(0, 1), a2 + hstep, voffA);
            PG8_WAIT_V(8); PG8_WAIT_L(0); PG8_BAR; PG8_MMA(0, 0, At, B0); PG8_MMA(0, 1, At, B1); PG8_BAR; PG8_SCHED;
            PG8_LDA(At, 1, 1); PG8_STAGE(PG8_SB(1, 0), b3, voffB); PG8_STAGE(PG8_SB(1, 1), b3 + hstep, voffB); PG8_STAGE(PG8_SA(1, 0), a3, voffA);
            PG8_WAIT_V(8); PG8_WAIT_L(0); PG8_BAR; PG8_MMA(1, 0, At, B0); PG8_MMA(1, 1, At, B1); PG8_BAR; PG8_SCHED;
            } else {
            PG8_LDB(B0, 0, 0); PG8_SCHED; PG8_LDA(At, 0, 0); PG8_STAGE(PG8_SA(1, 1), a1 + hstep, voffA);
            PG8_WAIT_L(8); PG8_BAR; PG8_WAIT_L(0); PG8_MMA(0, 0, At, B0); PG8_BAR; PG8_SCHED;
            PG8_LDB(B1, 0, 1); PG8_STAGE(PG8_SB(0, 0), b2, voffB);
            PG8_BAR; PG8_WAIT_L(0); PG8_MMA(0, 1, At, B1); PG8_BAR;
            PG8_LDA(At, 0, 1); PG8_STAGE(PG8_SA(0, 0), a2, voffA);
            PG8_BAR; PG8_WAIT_L(0); PG8_MMA(1, 0, At, B0); PG8_BAR; PG8_SCHED;
            PG8_STAGE(PG8_SB(0, 1), b2 + hstep, voffB);
            PG8_WAIT_V(6); PG8_BAR; PG8_MMA(1, 1, At, B1); PG8_BAR;
            PG8_LDB(B0, 1, 0); PG8_SCHED; PG8_LDA(At, 1, 0); PG8_STAGE(PG8_SA(0, 1), a2 + hstep, voffA);
            PG8_WAIT_L(8); PG8_BAR; PG8_WAIT_L(0); PG8_MMA(0, 0, At, B0); PG8_BAR; PG8_SCHED;
            PG8_LDB(B1, 1, 1); PG8_STAGE(PG8_SB(1, 0), b3, voffB);
            PG8_BAR; PG8_WAIT_L(0); PG8_MMA(0, 1, At, B1); PG8_BAR;
            PG8_LDA(At, 1, 1); PG8_STAGE(PG8_SA(1, 0), a3, voffA);
            PG8_BAR; PG8_WAIT_L(0); PG8_MMA(1, 0, At, B0); PG8_BAR; PG8_SCHED;
            PG8_STAGE(PG8_SB(1, 1), b3 + hstep, voffB);
            PG8_WAIT_V(6); PG8_BAR; PG8_MMA(1, 1, At, B1); PG8_BAR;
            }
        }
        if constexpr (ALIGN_EPI) { if (wr == 0) PG8_BAR; }
        if constexpr (!Epi::AFTER_DRAIN) { E(acc, cur, wr, wc, fr, fq); }
        if (!has_next) break;
#pragma unroll
        for (int a = 0; a < 2; ++a)
#pragma unroll
            for (int b = 0; b < 2; ++b)
#pragma unroll
                for (int m = 0; m < 4; ++m)
#pragma unroll
                    for (int n = 0; n < 2; ++n) acc[a][b][m][n] = (f32x4){0.f, 0.f, 0.f, 0.f};
        cur = nxt; cA = nA; cB = nB; ++ui;
        if constexpr (ALIGN_EPI) { if (wr == 1) PG8_BAR; }
    }
    PG8_WAIT_V(0);
    if constexpr (!ALIGN_EPI) { if (wr == 0) PG8_BAR; }
    PG8_BAR;
    if constexpr (Epi::AFTER_DRAIN) { E.fused(acc, cur, wr, wc, fr, fq, lds, wid, lane); }
#undef PG8_SA
#undef PG8_SB
#undef PG8_STAGE
#undef PG8_LDA
#undef PG8_LDB
#undef PG8_MMA
#undef PG8_WAIT_V
#undef PG8_WAIT_L
#undef PG8_BAR
#undef PG8_SCHED
}
}


constexpr int NWAVES = 8;
constexpr int DM = 1024, NB = 4, SEQ = 4096, CTXL = 256, TK = SEQ + CTXL;
constexpr int MLAT = NB * SEQ, MCTX = NB * CTXL, MALL = MLAT + MCTX;
constexpr int INW = 5024, NIN = 5120;
constexpr int NH = 8;
constexpr float EPS = 1e-6f;
constexpr float LOG2E = 1.4426950408889634f;
constexpr float MLA_C2 = 0.10206207261596577f * LOG2E;
constexpr float NA_C2 = 0.125f * LOG2E;

constexpr size_t MiB = 1u << 20;
constexpr size_t WS_CTL = 0, CTL_ZERO_BYTES = 64 * 1024;
constexpr size_t WS_WIN = 2 * MiB;
constexpr size_t WS_WUQ = 12 * MiB;
constexpr size_t WS_WUKV = 12 * MiB + 512 * 1024;
constexpr size_t WS_WOA = 13 * MiB, WS_WOB = 14 * MiB, WS_WOUT = 15 * MiB;
constexpr size_t WS_MOD = 17 * MiB;
constexpr size_t WS_ROPE = 17 * MiB + 256 * 1024;
constexpr size_t WS_SSQQ = 17 * MiB + 512 * 1024;
constexpr size_t WS_SSQKV = 18 * MiB;
constexpr size_t WS_SSQO = 18 * MiB + 512 * 1024;
constexpr size_t WS_H = 20 * MiB;
constexpr size_t WS_QA = 20 * MiB;
constexpr size_t WS_T0 = 54 * MiB;
constexpr size_t WS_CQ = 63 * MiB;
constexpr size_t WS_KB = 71 * MiB;
constexpr size_t WS_VBT = 88 * MiB;
constexpr size_t WS_M = 71 * MiB;
constexpr size_t WS_QB = 105 * MiB;
constexpr size_t WS_SZA = 121 * MiB;
constexpr size_t WS_SZB = 137 * MiB;
constexpr size_t WS_SGA = 153 * MiB;
constexpr size_t WS_SGB = 185 * MiB;
constexpr size_t WS_END = 217 * MiB;
constexpr size_t DO_KA = 0, DO_VAT = 26 * MiB;
constexpr int CW_BAR = 1024;

constexpr int RING_BYTES = 131072, MISC_OFF = RING_BYTES + 320, LDS_BYTES = 147456;

#define GAS __attribute__((address_space(1)))
#define LAS __attribute__((address_space(3)))
typedef unsigned short bf16;
typedef unsigned v4u __attribute__((ext_vector_type(4)));
typedef unsigned v2u __attribute__((ext_vector_type(2)));
typedef float f32x4 __attribute__((ext_vector_type(4)));
typedef float f32x16 __attribute__((ext_vector_type(16)));
typedef short bf16x8 __attribute__((ext_vector_type(8)));
typedef short s16x4 __attribute__((ext_vector_type(4)));
__device__ __forceinline__ unsigned f2bf(float f) { unsigned u = __builtin_bit_cast(unsigned, f); return (u + 0x7fffu + ((u >> 16) & 1u)) >> 16; }
__device__ __forceinline__ unsigned pk2(float lo, float hi) { return f2bf(lo) | (f2bf(hi) << 16); }
__device__ __forceinline__ float bf_lo(unsigned w) { return __builtin_bit_cast(float, w << 16); }
__device__ __forceinline__ float bf_hi(unsigned w) { return __builtin_bit_cast(float, w & 0xffff0000u); }
__device__ __forceinline__ float fast_rcp(float x) { return __builtin_amdgcn_rcpf(x); }
__device__ __forceinline__ float sigmoidf_(float x) { return fast_rcp(1.f + __builtin_amdgcn_exp2f(-x * LOG2E)); }
__device__ __forceinline__ float siluf_(float x) { return x * sigmoidf_(x); }
#define XB_TMO      128
#define XB_XCNT(j)  (256  + 64 * (j))
#define XB_XSUB(j)  (1280 + 64 * (j))
#define XB_XGEN(j)  (2304 + 64 * (j))
#define XB_TOP      3328
#define XB_TOPGEN   3392
#define XCD_BAR_WORDS 3456
#define XB_SPIN_CAP (1u << 18)

__device__ __forceinline__ unsigned xb_ld(unsigned* p)              { return __hip_atomic_load(p, __ATOMIC_RELAXED, __HIP_MEMORY_SCOPE_AGENT); }
__device__ __forceinline__ unsigned xb_add(unsigned* p, unsigned v) { return __hip_atomic_fetch_add(p, v, __ATOMIC_RELAXED, __HIP_MEMORY_SCOPE_AGENT); }
__device__ __forceinline__ unsigned xb_xcc_id() { return (unsigned)__builtin_amdgcn_s_getreg((3 << 11) | 20) & 0xFu; }
#define XB_SPIN(cond, bar) do { unsigned _sp = 0; while (cond) { __builtin_amdgcn_s_sleep(1); \
    if ((++_sp & 255u) == 0u) { if (xb_ld(&(bar)[XB_TMO])) break; if (_sp > XB_SPIN_CAP) { atomicAdd(&(bar)[XB_TMO], 1u); break; } } } } while (0)

struct XcdBarrier {
    unsigned* bar; unsigned x;
    volatile LAS unsigned* st;
};

__device__ __forceinline__ XcdBarrier xcd_barrier_post(unsigned* bar, volatile LAS unsigned* st) {
    XcdBarrier b; b.bar = bar; b.x = xb_xcc_id(); b.st = st;
    if (threadIdx.x == 0) (void)xb_add(&bar[XB_XCNT(b.x)], 1u);
    return b;
}
__device__ __forceinline__ void xcd_barrier_complete(unsigned* bar, unsigned x, unsigned& nloc, unsigned& nx) {
    const unsigned G = gridDim.x * gridDim.y * gridDim.z;
    unsigned sum, cnt, mine, sp = 0u;
    for (;;) {
        sum = 0u; cnt = 0u; mine = 0u;
#pragma unroll
        for (unsigned j = 0; j < 16; ++j) { const unsigned c = xb_ld(&bar[XB_XCNT(j)]); sum += c; cnt += (c > 0u) ? 1u : 0u; mine = (j == x) ? c : mine; }
        if (sum == G) break;
        __builtin_amdgcn_s_sleep(1);
        if ((++sp & 255u) == 0u) { if (xb_ld(&bar[XB_TMO])) break; if (sp > XB_SPIN_CAP) { atomicAdd(&bar[XB_TMO], 1u); break; } }
    }
    nloc = mine > 0u ? mine : 1u; nx = cnt > 0u ? cnt : 1u;
}

__device__ __forceinline__ void xcd_barrier(const XcdBarrier& b) {
    asm volatile("s_waitcnt vmcnt(0)" ::: "memory");
    __syncthreads();
    if (threadIdx.x == 0) {
        unsigned* bar = b.bar;
        __builtin_amdgcn_s_waitcnt(0);
        unsigned nloc = b.st[0], nx = b.st[1];
        if (nloc == 0u) { xcd_barrier_complete(bar, b.x, nloc, nx); b.st[0] = nloc; b.st[1] = nx; }
        const unsigned old = xb_add(&bar[XB_XSUB(b.x)], 1u);
        const unsigned gen = old / nloc;
        if (old + 1u == (gen + 1u) * nloc) {
            __builtin_amdgcn_fence(__ATOMIC_RELEASE, "agent");
            asm volatile("s_waitcnt vmcnt(0)" ::: "memory");
            const unsigned og = xb_add(&bar[XB_TOP], 1u);
            const unsigned tg = og / nx;
            if (og + 1u == (tg + 1u) * nx) xb_add(&bar[XB_TOPGEN], 1u);
            else XB_SPIN(xb_ld(&bar[XB_TOPGEN]) == tg, bar);
            __builtin_amdgcn_fence(__ATOMIC_ACQUIRE, "agent");
            xb_add(&bar[XB_XGEN(b.x)], 1u);
            asm volatile("s_waitcnt vmcnt(0)" ::: "memory");
        } else {
            XB_SPIN(xb_ld(&bar[XB_XGEN(b.x)]) == gen, bar);
            __builtin_amdgcn_fence(__ATOMIC_ACQUIRE, "agent");
            asm volatile("s_waitcnt vmcnt(0)" ::: "memory");
        }
    }
    __syncthreads();
}

#define LDS_WAIT() asm volatile("s_waitcnt lgkmcnt(0)" ::: "memory")
#define VM_WAIT() asm volatile("s_waitcnt vmcnt(0)" ::: "memory")
__device__ __forceinline__ float wave_sum(float v) {
#pragma unroll
    for (int o = 1; o < 64; o <<= 1) v += __shfl_xor(v, o);
    return v;
}
__device__ __forceinline__ void tile_remap(int L, int nM, int nN, int& pm, int& pn) {
    const int nwg = nM * nN; int wgid = L;
    { const int q = nwg / 8, r = nwg % 8, xcd = wgid % 8, off = wgid / 8; wgid = (xcd < r ? xcd * (q + 1) : r * (q + 1) + (xcd - r) * q) + off; }
    const int nig = 8 * nN, gid = wgid / nig, fm = gid * 8, gsz = (nM - fm) < 8 ? (nM - fm) : 8;
    pm = fm + ((wgid % nig) % gsz); pn = (wgid % nig) / gsz;
}
__device__ __forceinline__ void row_bt(int row, int& b, int& t) {
    if (row < MLAT) { b = row >> 12; t = row & 4095; } else { const int r = row - MLAT; b = r >> 8; t = SEQ + (r & 255); }
}

__device__ __forceinline__ void transpose_item(const float* W, int ldw, int k0, int n0, bf16* WT, int KD, int drow0, const float* g, LAS float* scr, int lane) {
    f32x4 wv[8];
#pragma unroll
    for (int i = 0; i < 8; ++i) wv[i] = *(const f32x4*)(W + (size_t)(k0 + 8 * i + (lane >> 3)) * ldw + n0 + 4 * (lane & 7));
#pragma unroll
    for (int i = 0; i < 8; ++i) { const int kk = 8 * i + (lane >> 3); f32x4 v = wv[i]; if (g) v = v * g[k0 + kk];
        LAS float* d = scr + kk * 33 + 4 * (lane & 7); d[0] = v[0]; d[1] = v[1]; d[2] = v[2]; d[3] = v[3]; }
    LDS_WAIT(); asm volatile("" ::: "memory");
    const int c = lane & 7;
#pragma unroll
    for (int j = 0; j < 4; ++j) { const int n = (lane >> 3) + 8 * j; const LAS float* s = scr + (8 * c) * 33 + n;
        v4u o; o.x = pk2(s[0 * 33], s[1 * 33]); o.y = pk2(s[2 * 33], s[3 * 33]); o.z = pk2(s[4 * 33], s[5 * 33]); o.w = pk2(s[6 * 33], s[7 * 33]);
        *(v4u*)(WT + (size_t)(drow0 + n) * KD + k0 + 8 * c) = o; }
    LDS_WAIT(); asm volatile("" ::: "memory");
}

struct Ptrs {
    const float *x, *c, *ctx, *c_ctx, *w_mod, *b_mod, *norm_g, *w_in, *g_cq, *w_uq, *g_ckv, *w_ukv, *rpb, *w_oa, *w_ob, *w_out, *final_g;
    float* out; unsigned char* ws;
};

__device__ __forceinline__ void p0_weights(const Ptrs& P, LAS unsigned char* lds, int tid, int lane, int wave, int G) {
    LAS float* scr = (LAS float*)(lds + wave * 16384);
    const int gw = blockIdx.x * NWAVES + wave, NGW = G * NWAVES;
    unsigned char* ws = P.ws;
    constexpr int I_IN = 16 * 157, I_UQ = 4 * 24, I_UKV = 2 * 32, I_OA = 8 * 32, I_OUT = 16 * 32;
    constexpr int NITEMS = I_IN + I_UQ + I_UKV + 2 * I_OA + I_OUT;
    for (int it = gw; it < NITEMS; it += NGW) {
        int r = it;
        if (r < I_IN) { const int kb = r / 157, nb = r % 157, n0 = 32 * nb; transpose_item(P.w_in, INW, 64 * kb, n0, (bf16*)(ws + WS_WIN), 1024, n0 + (n0 >= 160 ? 96 : 0), nullptr, scr, lane); continue; } r -= I_IN;
        if (r < I_UQ) { const int kb = r / 24, nb = r % 24, h = nb / 3, j = nb % 3; transpose_item(P.w_uq, 768, 64 * kb, 32 * nb, (bf16*)(ws + WS_WUQ), 256, j < 2 ? h * 64 + 32 * j : 512 + 32 * h, P.g_cq, scr, lane); continue; } r -= I_UQ;
        if (r < I_UKV) { const int kb = r / 32, nb = r % 32, h = nb / 4, j = nb % 4; transpose_item(P.w_ukv, 1024, 64 * kb, 32 * nb, (bf16*)(ws + WS_WUKV), 256, j < 2 ? h * 64 + 32 * j : 512 + h * 64 + 32 * (j - 2), P.g_ckv, scr, lane); continue; } r -= I_UKV;
        if (r < I_OA) { const int kb = r / 32, nb = r % 32; transpose_item(P.w_oa, 1024, 64 * kb, 32 * nb, (bf16*)(ws + WS_WOA), 512, 32 * nb, nullptr, scr, lane); continue; } r -= I_OA;
        if (r < I_OA) { const int kb = r / 32, nb = r % 32; transpose_item(P.w_ob, 1024, 64 * kb, 32 * nb, (bf16*)(ws + WS_WOB), 512, 32 * nb, nullptr, scr, lane); continue; } r -= I_OA;
        { const int kb = r / 32, nb = r % 32; transpose_item(P.w_out, 1024, 64 * kb, 32 * nb, (bf16*)(ws + WS_WOUT), 1024, 32 * nb, nullptr, scr, lane); }
    }
    { const int gt = blockIdx.x * (NWAVES * 64) + tid, NT = G * NWAVES * 64; const v4u z = {0u, 0u, 0u, 0u};
      for (int ch = gt; ch < 12288; ch += NT) *(v4u*)(ws + WS_WIN + (size_t)160 * 2048 + (size_t)ch * 16) = z;
      for (int ch = gt; ch < 16384; ch += NT) *(v4u*)(ws + WS_WUKV + (size_t)(ch >> 4) * 512 + 256 + (ch & 15) * 16) = z; }
    if (blockIdx.x == 0) {
        const int p = tid >> 3, i = tid & 7;
        const float fr = (i == 0) ? 1.0f : (i == 1) ? 0.31622776601683794f : (i == 2) ? 0.1f : (i == 3) ? 0.031622776601683794f : (i == 4) ? 0.01f : (i == 5) ? 0.0031622776601683794f : (i == 6) ? 0.001f : 0.00031622776601683794f;
        const float ang = (float)p * fr;
        float2 cs; cs.x = cosf(ang); cs.y = sinf(ang);
        ((float2*)(ws + WS_ROPE))[tid] = cs;
    }
}
__device__ __forceinline__ void p0_gemv(const Ptrs& P, LAS unsigned char* lds, int tid, int lane, int wave, int G) {
    unsigned char* ws = P.ws;
    __syncthreads();
    LAS float* red = (LAS float*)(lds + 7 * 16384 + 12288);
    for (int cgp = blockIdx.x; cgp < 256; cgp += G) {
        const int c0 = 12 * cgp;
        float acc[5][12];
#pragma unroll
        for (int b = 0; b < 5; ++b)
#pragma unroll
            for (int j = 0; j < 12; ++j) acc[b][j] = 0.f;
#pragma unroll
        for (int h = 0; h < 2; ++h) {
            const int kk = tid + 512 * h;
            float s[5];
#pragma unroll
            for (int b = 0; b < 4; ++b) s[b] = siluf_(P.c[b * 1024 + kk]);
            s[4] = siluf_(P.c_ctx[kk]);
            const f32x4* wp = (const f32x4*)(P.w_mod + (size_t)kk * 3072 + c0);
            const f32x4 w0 = wp[0], w1 = wp[1], w2 = wp[2];
            const float w[12] = {w0[0], w0[1], w0[2], w0[3], w1[0], w1[1], w1[2], w1[3], w2[0], w2[1], w2[2], w2[3]};
#pragma unroll
            for (int b = 0; b < 5; ++b)
#pragma unroll
                for (int j = 0; j < 12; ++j) acc[b][j] += s[b] * w[j];
        }
#pragma unroll
        for (int b = 0; b < 5; ++b)
#pragma unroll
            for (int j = 0; j < 12; ++j) { const float v = wave_sum(acc[b][j]); if (lane == 0) red[wave * 60 + b * 12 + j] = v; }
        __syncthreads();
        if (tid < 60) { float v = 0.f;
#pragma unroll
            for (int w8 = 0; w8 < 8; ++w8) v += red[w8 * 60 + tid];
            const int b = tid / 12, j = tid % 12;
            ((float*)(ws + WS_MOD))[b * 3072 + c0 + j] = v + P.b_mod[c0 + j]; }
        __syncthreads();
    }
}

__device__ __forceinline__ void p1_hconv(const Ptrs& P, int lane, int wave, int G) {
    const int gw = blockIdx.x * NWAVES + wave, NGW = G * NWAVES;
    const float* MOD = (const float*)(P.ws + WS_MOD);
    bf16* H = (bf16*)(P.ws + WS_H);
    for (int row = gw; row < MALL; row += NGW) {
        const float* xr = row < MLAT ? P.x + (size_t)row * DM : P.ctx + (size_t)(row - MLAT) * DM;
        const int mb = row < MLAT ? (row >> 12) : 4;
        const f32x4* x4 = (const f32x4*)xr + lane;
        f32x4 v[4]; float s = 0.f;
#pragma unroll
        for (int j = 0; j < 4; ++j) { v[j] = x4[64 * j]; s += (v[j][0] * v[j][0] + v[j][1] * v[j][1]) + (v[j][2] * v[j][2] + v[j][3] * v[j][3]); }
        const float rstd = 1.0f / sqrtf(wave_sum(s) * (1.f / DM) + EPS);
        const f32x4* g4 = (const f32x4*)P.norm_g + lane;
        const f32x4* sh4 = (const f32x4*)(MOD + mb * 3072) + lane;
        const f32x4* sc4 = (const f32x4*)(MOD + mb * 3072 + 1024) + lane;
        unsigned long long* o8 = (unsigned long long*)(H + (size_t)row * DM) + lane;
#pragma unroll
        for (int j = 0; j < 4; ++j) {
            const f32x4 g = g4[64 * j], sh = sh4[64 * j], sc = sc4[64 * j];
            f32x4 h;
#pragma unroll
            for (int e = 0; e < 4; ++e) h[e] = (v[j][e] * rstd * g[e]) * (1.f + sc[e]) + sh[e];
            o8[64 * j] = (unsigned long long)pk2(h[0], h[1]) | ((unsigned long long)pk2(h[2], h[3]) << 32);
        }
    }
}

using pg8::Unit;
using pg8::cvt_pk_bf16;
__device__ __forceinline__ v4u pack8(const f32x4& a, const f32x4& b) { v4u w; w.x = cvt_pk_bf16(a[0], a[1]); w.y = cvt_pk_bf16(a[2], a[3]); w.z = cvt_pk_bf16(b[0], b[1]); w.w = cvt_pk_bf16(b[2], b[3]); return w; }

__device__ __forceinline__ void rope8(float (&v)[8], int fq, int t, const float2* tab) {
    const int pos = (fq < 2) ? (t >> 6) : (t & 63);
    const float sgn = (fq & 1) ? 1.f : -1.f;
#pragma unroll
    for (int i = 0; i < 8; ++i) { const float pv = __shfl_xor(v[i], 16); const float2 cs = tab[pos * 8 + i]; v[i] = v[i] * cs.x + sgn * pv * cs.y; }
}

struct SchedG1 {
    int G, c; const char* H; const char* W;
    static constexpr size_t TS = (size_t)256 * 1024 * 2;
    __device__ __forceinline__ bool next(int i, Unit& u) const {
        const int L = i * G + c; if (L >= 1280) return false;
        int pm, pn;
        tile_remap(L, 64, 20, pm, pn);
        if (pn == 3 || pn == 4) { u.kind = 1; u.ta = pn; u.tb = pm; } else { u.kind = 0; u.ta = pm; u.tb = pn; }
        return true;
    }
    __device__ __forceinline__ const char* aptr(const Unit& u) const { return (u.kind == 1 ? W : H) + (size_t)u.ta * TS; }
    __device__ __forceinline__ const char* bptr(const Unit& u) const { return (u.kind == 1 ? H : W) + (size_t)u.tb * TS; }
};
struct SchedG1C {
    int nC, c; const char* H; const char* W;
    static constexpr size_t TS = (size_t)256 * 1024 * 2;
    __device__ __forceinline__ bool next(int i, Unit& u) const {
        if (c >= nC) return false;
        const int k = i * nC + c; if (k >= 20) return false;
        const int pm = 64 + k / 5, pn = k % 5;
        if (pn == 3 || pn == 4) { u.kind = 1; u.ta = pn; u.tb = pm; } else { u.kind = 0; u.ta = pm; u.tb = pn; }
        return true;
    }
    __device__ __forceinline__ const char* aptr(const Unit& u) const { return (u.kind == 1 ? W : H) + (size_t)u.ta * TS; }
    __device__ __forceinline__ const char* bptr(const Unit& u) const { return (u.kind == 1 ? H : W) + (size_t)u.tb * TS; }
};
struct EpiG1 {
    static constexpr bool PERM = true, AFTER_DRAIN = false;
    unsigned char* ws; unsigned char* dout;
    __device__ __forceinline__ void operator()(const f32x4 (&acc)[2][2][4][2], const Unit& u, int wr, int wc, int fr, int fq) const {
        using pg8::HALF;
        if (u.kind == 1) {
            bf16* VBT = (bf16*)(ws + WS_VBT);
#pragma unroll
            for (int bj = 0; bj < 2; ++bj) {
                int b, t; row_bt(256 * u.tb + HALF * bj + 32 * wc + 8 * fq, b, t);
#pragma unroll
                for (int ai = 0; ai < 2; ++ai)
#pragma unroll
                    for (int m = 0; m < 4; ++m) { const int vc = 256 * (u.ta - 3) + HALF * ai + 64 * wr + 16 * m + fr, h = vc >> 6, dv = vc & 63;
                        *(v4u*)(VBT + ((size_t)((b * NH + h) * 64 + dv)) * TK + t) = pack8(acc[ai][bj][m][0], acc[ai][bj][m][1]); }
            }
            return;
        }
        const int pn = u.tb;
        const float2* tab = (const float2*)(ws + WS_ROPE);
#pragma unroll
        for (int ai = 0; ai < 2; ++ai)
#pragma unroll
            for (int m = 0; m < 4; ++m) {
                const int row = 256 * u.ta + HALF * ai + 64 * wr + 16 * m + fr; int b, t; row_bt(row, b, t);
                float qq = 0.f;
#pragma unroll
                for (int bj = 0; bj < 2; ++bj) {
                    const int col = HALF * bj + 32 * wc + 8 * fq;
                    const f32x4 v0 = acc[ai][bj][m][0], v1 = acc[ai][bj][m][1];
                    if (pn == 0) {
                        *(v4u*)((bf16*)(ws + WS_T0) + (size_t)row * 256 + col) = pack8(v0, v1);
                        if (bj == 0) { float q = (v0[0] * v0[0] + v0[1] * v0[1]) + (v0[2] * v0[2] + v0[3] * v0[3]) + (v1[0] * v1[0] + v1[1] * v1[1]) + (v1[2] * v1[2] + v1[3] * v1[3]);
                            q += __shfl_xor(q, 16); q += __shfl_xor(q, 32); if (fq == 0) ((float*)(ws + WS_SSQKV))[row * 4 + wc] = q; }
                        else if (wc == 0) {
                            float v[8] = {v0[0], v0[1], v0[2], v0[3], v1[0], v1[1], v1[2], v1[3]};
                            if (u.ta < 64) rope8(v, fq, t, tab);
                            v4u w; w.x = cvt_pk_bf16(v[0], v[1]); w.y = cvt_pk_bf16(v[2], v[3]); w.z = cvt_pk_bf16(v[4], v[5]); w.w = cvt_pk_bf16(v[6], v[7]);
                            bf16* KA = (bf16*)(dout + DO_KA);
#pragma unroll
                            for (int h = 0; h < NH; ++h) *(v4u*)(KA + ((size_t)(b * NH + h) * TK + t) * 96 + 64 + 8 * fq) = w;
                        }
                    } else if (pn <= 2) {
                        const int kc = 256 * (pn - 1) + col, h = kc >> 6, d = kc & 63;
                        *(v4u*)((bf16*)(ws + WS_KB) + ((size_t)(b * NH + h) * TK + t) * 64 + d) = pack8(v0, v1);
                    } else if (pn == 5) {
                        *(v4u*)((bf16*)(ws + WS_CQ) + (size_t)row * 256 + col) = pack8(v0, v1);
                        qq += (v0[0] * v0[0] + v0[1] * v0[1]) + (v0[2] * v0[2] + v0[3] * v0[3]) + (v1[0] * v1[0] + v1[1] * v1[1]) + (v1[2] * v1[2] + v1[3] * v1[3]);
                    } else if (pn <= 7 || (pn >= 10 && pn <= 11)) {
                        bf16* dst = (bf16*)(ws + (pn <= 7 ? WS_SZA : WS_SZB)) + (size_t)row * 512 + 256 * (pn <= 7 ? pn - 6 : pn - 10) + col;
                        f32x4 a, c2;
#pragma unroll
                        for (int e = 0; e < 4; ++e) { a[e] = siluf_(v0[e]); c2[e] = siluf_(v1[e]); }
                        *(v4u*)dst = pack8(a, c2);
                    } else if (pn <= 9) {
                        const int qc = 256 * (pn - 8) + col, h = qc >> 6, d = qc & 63;
                        *(v4u*)((bf16*)(ws + WS_QB) + ((size_t)(b * NH + h) * SEQ + t) * 64 + d) = pack8(v0 * NA_C2, v1 * NA_C2);
                    } else {
                        bf16* dst = (bf16*)(ws + (pn <= 15 ? WS_SGA : WS_SGB)) + (size_t)row * 1024 + 256 * (pn <= 15 ? pn - 12 : pn - 16) + col;
                        f32x4 a, c2;
#pragma unroll
                        for (int e = 0; e < 4; ++e) { a[e] = sigmoidf_(v0[e]); c2[e] = sigmoidf_(v1[e]); }
                        *(v4u*)dst = pack8(a, c2);
                    }
                }
                if (pn == 5) { qq += __shfl_xor(qq, 16); qq += __shfl_xor(qq, 32); if (fq == 0) ((float*)(ws + WS_SSQQ))[row * 4 + wc] = qq; }
            }
    }
};

struct SchedG23 {
    int first, cnt, c; const char* wsb;
    static constexpr size_t TS = (size_t)256 * 256 * 2;
    __device__ __forceinline__ bool next(int i, Unit& u) const {
        if (c < first) return false;
        const int L = i * cnt + (c - first); if (L >= 448) return false;
        if (L < 192) { u.kind = 0; u.ta = L % 64; u.tb = L / 64; return true; }
        const int k = L - 192, pm = k % 64, pn = k / 64;
        if (pn < 2) { u.kind = 1; u.ta = pm; u.tb = pn; } else { u.kind = 2; u.ta = pn; u.tb = pm; }
        return true;
    }
    __device__ __forceinline__ const char* aptr(const Unit& u) const { const size_t o = (u.kind == 0) ? WS_CQ : (u.kind == 1) ? WS_T0 : WS_WUKV; return wsb + o + (size_t)u.ta * TS; }
    __device__ __forceinline__ const char* bptr(const Unit& u) const { const size_t o = (u.kind == 0) ? WS_WUQ : (u.kind == 1) ? WS_WUKV : WS_T0; return wsb + o + (size_t)u.tb * TS; }
};
struct EpiG23 {
    static constexpr bool PERM = true, AFTER_DRAIN = false;
    unsigned char* ws; unsigned char* dout;
    __device__ __forceinline__ void operator()(const f32x4 (&acc)[2][2][4][2], const Unit& u, int wr, int wc, int fr, int fq) const {
        using pg8::HALF;
        const float* SSQKV = (const float*)(ws + WS_SSQKV);
        if (u.kind == 2) {
            bf16* VAT = (bf16*)(dout + DO_VAT);
#pragma unroll
            for (int bj = 0; bj < 2; ++bj) {
                const int tok0 = 256 * u.tb + HALF * bj + 32 * wc + 8 * fq; int b, t; row_bt(tok0, b, t);
                float rs[8];
                { const f32x4 ss = *(const f32x4*)(SSQKV + (size_t)(tok0 + (fr & 7)) * 4); const float mine = 1.0f / sqrtf(((ss[0] + ss[1]) + (ss[2] + ss[3])) * (1.f / 128.f) + EPS);
#pragma unroll
                  for (int i = 0; i < 8; ++i) rs[i] = __shfl(mine, (fq << 4) + i); }
#pragma unroll
                for (int ai = 0; ai < 2; ++ai)
#pragma unroll
                    for (int m = 0; m < 4; ++m) { const int vc = 256 * (u.ta - 2) + HALF * ai + 64 * wr + 16 * m + fr, h = vc >> 6, dv = vc & 63;
                        f32x4 a = acc[ai][bj][m][0], c2 = acc[ai][bj][m][1];
#pragma unroll
                        for (int e = 0; e < 4; ++e) { a[e] *= rs[e]; c2[e] *= rs[4 + e]; }
                        *(v4u*)(VAT + ((size_t)((b * NH + h) * 64 + dv)) * TK + t) = pack8(a, c2); }
            }
            return;
        }
        const float2* tab = (const float2*)(ws + WS_ROPE);
#pragma unroll
        for (int ai = 0; ai < 2; ++ai)
#pragma unroll
            for (int m = 0; m < 4; ++m) {
                const int row = 256 * u.ta + HALF * ai + 64 * wr + 16 * m + fr; int b, t; row_bt(row, b, t);
                if (u.kind == 0) {
                    const f32x4 ss = *(const f32x4*)((const float*)(ws + WS_SSQQ) + (size_t)row * 4);
                    const float f = MLA_C2 / sqrtf(((ss[0] + ss[1]) + (ss[2] + ss[3])) * (1.f / 256.f) + EPS);
                    bf16* QA = (bf16*)(ws + WS_QA);
#pragma unroll
                    for (int bj = 0; bj < 2; ++bj) {
                        const f32x4 v0 = acc[ai][bj][m][0] * f, v1 = acc[ai][bj][m][1] * f;
                        if (u.tb < 2) { const int qc = 256 * u.tb + HALF * bj + 32 * wc + 8 * fq, h = qc >> 6, d = qc & 63;
                            *(v4u*)(QA + ((size_t)(b * NH + h) * SEQ + t) * 96 + d) = pack8(v0, v1);
                        } else { const int h = 4 * bj + wc;
                            float v[8] = {v0[0], v0[1], v0[2], v0[3], v1[0], v1[1], v1[2], v1[3]};
                            rope8(v, fq, t, tab);
                            v4u w; w.x = cvt_pk_bf16(v[0], v[1]); w.y = cvt_pk_bf16(v[2], v[3]); w.z = cvt_pk_bf16(v[4], v[5]); w.w = cvt_pk_bf16(v[6], v[7]);
                            *(v4u*)(QA + ((size_t)(b * NH + h) * SEQ + t) * 96 + 64 + 8 * fq) = w; }
                    }
                } else {
                    const f32x4 ss = *(const f32x4*)(SSQKV + (size_t)row * 4);
                    const float f = 1.0f / sqrtf(((ss[0] + ss[1]) + (ss[2] + ss[3])) * (1.f / 128.f) + EPS);
                    bf16* KA = (bf16*)(dout + DO_KA);
#pragma unroll
                    for (int bj = 0; bj < 2; ++bj) { const int kc = 256 * u.tb + HALF * bj + 32 * wc + 8 * fq, h = kc >> 6, d = kc & 63;
                        *(v4u*)(KA + ((size_t)(b * NH + h) * TK + t) * 96 + d) = pack8(acc[ai][bj][m][0] * f, acc[ai][bj][m][1] * f); }
                }
            }
    }
};

struct SchedG23C {
    int nC, c; const char* wsb;
    static constexpr size_t TS = (size_t)256 * 256 * 2;
    __device__ __forceinline__ bool next(int i, Unit& u) const {
        if (c >= nC) return false;
        const int k = i * nC + c; if (k >= 16) return false;
        if (k < 8) { u.kind = 1; u.ta = 64 + (k >> 1); u.tb = k & 1; } else { const int kk = k - 8; u.kind = 2; u.ta = 2 + (kk >> 2); u.tb = 64 + (kk & 3); }
        return true;
    }
    __device__ __forceinline__ const char* aptr(const Unit& u) const { const size_t o = (u.kind == 1) ? WS_T0 : WS_WUKV; return wsb + o + (size_t)u.ta * TS; }
    __device__ __forceinline__ const char* bptr(const Unit& u) const { const size_t o = (u.kind == 1) ? WS_WUKV : WS_T0; return wsb + o + (size_t)u.tb * TS; }
};
struct SchedG4 {
    int G, c; const char* OA; const char* OB; const char* WOA; const char* WOB;
    static constexpr size_t TS = (size_t)256 * 512 * 2;
    __device__ __forceinline__ bool next(int j, Unit& u) const {
        const int tile = c + (j >> 1) * G; if (tile >= 256) return false;
        tile_remap(tile, 64, 4, u.ta, u.tb); u.kind = j & 1; return true;
    }
    __device__ __forceinline__ const char* aptr(const Unit& u) const { return (u.kind ? OB : OA) + (size_t)u.ta * TS; }
    __device__ __forceinline__ const char* bptr(const Unit& u) const { return (u.kind ? WOB : WOA) + (size_t)u.tb * TS; }
};
struct EpiG4 {
    static constexpr bool PERM = true, AFTER_DRAIN = false;
    unsigned char* ws; float* scratch;
    __device__ __forceinline__ void operator()(const f32x4 (&acc)[2][2][4][2], const Unit& u, int wr, int wc, int fr, int fq) const {
        using pg8::HALF;
        const bf16* SG = (const bf16*)(ws + (u.kind ? WS_SGB : WS_SGA));
        bf16* Mb = (bf16*)(ws + WS_M);
#pragma unroll
        for (int ai = 0; ai < 2; ++ai) {
            v4u g[4][2], t1[4][2];
#pragma unroll
            for (int m = 0; m < 4; ++m)
#pragma unroll
                for (int bj = 0; bj < 2; ++bj) {
                    const size_t off = (size_t)(256 * u.ta + HALF * ai + 64 * wr + 16 * m + fr) * 1024 + 256 * u.tb + HALF * bj + 32 * wc + 8 * fq;
                    g[m][bj] = *(const v4u*)(SG + off);
                    if (u.kind) t1[m][bj] = *(const v4u*)(Mb + off); else t1[m][bj] = (v4u){0u, 0u, 0u, 0u};
                }
#pragma unroll
            for (int m = 0; m < 4; ++m)
#pragma unroll
                for (int bj = 0; bj < 2; ++bj) {
                    const size_t off = (size_t)(256 * u.ta + HALF * ai + 64 * wr + 16 * m + fr) * 1024 + 256 * u.tb + HALF * bj + 32 * wc + 8 * fq;
                    const v4u gg = g[m][bj], tt = t1[m][bj];
                    f32x4 v0 = acc[ai][bj][m][0], v1 = acc[ai][bj][m][1];
                    v0[0] = v0[0] * bf_lo(gg.x) + bf_lo(tt.x); v0[1] = v0[1] * bf_hi(gg.x) + bf_hi(tt.x); v0[2] = v0[2] * bf_lo(gg.y) + bf_lo(tt.y); v0[3] = v0[3] * bf_hi(gg.y) + bf_hi(tt.y);
                    v1[0] = v1[0] * bf_lo(gg.z) + bf_lo(tt.z); v1[1] = v1[1] * bf_hi(gg.z) + bf_hi(tt.z); v1[2] = v1[2] * bf_lo(gg.w) + bf_lo(tt.w); v1[3] = v1[3] * bf_hi(gg.w) + bf_hi(tt.w);
                    *(v4u*)(Mb + off) = pack8(v0, v1);
                }
        }
    }
};

struct SchedG5 {
    int G, c; const char* M; const char* W;
    static constexpr size_t TS = (size_t)256 * 1024 * 2;
    __device__ __forceinline__ bool next(int i, Unit& u) const { const int L = i * G + c; if (L >= 256) return false; tile_remap(L, 64, 4, u.ta, u.tb); u.kind = 0; return true; }
    __device__ __forceinline__ const char* aptr(const Unit& u) const { return M + (size_t)u.ta * TS; }
    __device__ __forceinline__ const char* bptr(const Unit& u) const { return W + (size_t)u.tb * TS; }
};
struct EpiG5 {
    static constexpr bool PERM = true, AFTER_DRAIN = false;
    unsigned char* ws; const float* x; float* out;
    __device__ __forceinline__ void operator()(const f32x4 (&acc)[2][2][4][2], const Unit& u, int wr, int wc, int fr, int fq) const {
        using pg8::HALF;
        const float* MOD = (const float*)(ws + WS_MOD) + ((256 * u.ta) >> 12) * 3072 + 2048;
        f32x4 gt[2][2];
#pragma unroll
        for (int bj = 0; bj < 2; ++bj) { const int col = 256 * u.tb + HALF * bj + 32 * wc + 8 * fq; gt[bj][0] = *(const f32x4*)(MOD + col); gt[bj][1] = *(const f32x4*)(MOD + col + 4); }
#pragma unroll
        for (int ai = 0; ai < 2; ++ai) {
            f32x4 xa[4][2][2];
#pragma unroll
            for (int m = 0; m < 4; ++m)
#pragma unroll
                for (int bj = 0; bj < 2; ++bj) {
                    const size_t off = (size_t)(256 * u.ta + HALF * ai + 64 * wr + 16 * m + fr) * 1024 + 256 * u.tb + HALF * bj + 32 * wc + 8 * fq;
                    xa[m][bj][0] = *(const f32x4*)(x + off); xa[m][bj][1] = *(const f32x4*)(x + off + 4);
                }
#pragma unroll
            for (int m = 0; m < 4; ++m) {
                const int row = 256 * u.ta + HALF * ai + 64 * wr + 16 * m + fr;
                float q = 0.f;
#pragma unroll
                for (int bj = 0; bj < 2; ++bj) {
                    const size_t off = (size_t)row * 1024 + 256 * u.tb + HALF * bj + 32 * wc + 8 * fq;
                    const f32x4 o0 = xa[m][bj][0] + gt[bj][0] * acc[ai][bj][m][0], o1 = xa[m][bj][1] + gt[bj][1] * acc[ai][bj][m][1];
                    *(f32x4*)(out + off) = o0; *(f32x4*)(out + off + 4) = o1;
                    q += (o0[0] * o0[0] + o0[1] * o0[1]) + (o0[2] * o0[2] + o0[3] * o0[3]) + (o1[0] * o1[0] + o1[1] * o1[1]) + (o1[2] * o1[2] + o1[3] * o1[3]);
                }
                q += __shfl_xor(q, 16); q += __shfl_xor(q, 32);
                if (fq == 0) ((float*)(ws + WS_SSQO))[(size_t)row * 16 + u.tb * 4 + wc] = q;
            }
        }
    }
};

constexpr int CW_PANEL = 8192;
struct EpiG5F {
    static constexpr bool PERM = true, AFTER_DRAIN = true;
    unsigned char* ws; const float* x; float* out; const float* final_g;
    __device__ __forceinline__ void operator()(const f32x4 (&)[2][2][4][2], const Unit&, int, int, int, int) const {}
    __device__ __forceinline__ void fused(f32x4 (&acc)[2][2][4][2], const Unit& u, int wr, int wc, int fr, int fq, LAS unsigned char* lds, int wid, int lane) const {
        using pg8::HALF;
        const float* MOD = (const float*)(ws + WS_MOD) + ((256 * u.ta) >> 12) * 3072 + 2048;
        LAS float* Pq = (LAS float*)lds;
        LAS float* Sr = (LAS float*)(lds + 4096);
        float* slots = (float*)(ws + WS_SSQO);
        unsigned* cnt = (unsigned*)(ws + WS_CTL) + CW_PANEL + 64 * u.ta;
        f32x4 gt[2][2];
#pragma unroll
        for (int bj = 0; bj < 2; ++bj) { const int col = 256 * u.tb + HALF * bj + 32 * wc + 8 * fq; gt[bj][0] = *(const f32x4*)(MOD + col); gt[bj][1] = *(const f32x4*)(MOD + col + 4); }
#pragma unroll
        for (int ai = 0; ai < 2; ++ai) {
            f32x4 xa[4][2][2];
#pragma unroll
            for (int m = 0; m < 4; ++m)
#pragma unroll
                for (int bj = 0; bj < 2; ++bj) {
                    const size_t off = (size_t)(256 * u.ta + HALF * ai + 64 * wr + 16 * m + fr) * 1024 + 256 * u.tb + HALF * bj + 32 * wc + 8 * fq;
                    xa[m][bj][0] = *(const f32x4*)(x + off); xa[m][bj][1] = *(const f32x4*)(x + off + 4);
                }
#pragma unroll
            for (int m = 0; m < 4; ++m) {
                float q = 0.f;
#pragma unroll
                for (int bj = 0; bj < 2; ++bj) {
                    const f32x4 o0 = xa[m][bj][0] + gt[bj][0] * acc[ai][bj][m][0], o1 = xa[m][bj][1] + gt[bj][1] * acc[ai][bj][m][1];
                    acc[ai][bj][m][0] = o0; acc[ai][bj][m][1] = o1;
                    q += (o0[0] * o0[0] + o0[1] * o0[1]) + (o0[2] * o0[2] + o0[3] * o0[3]) + (o1[0] * o1[0] + o1[1] * o1[1]) + (o1[2] * o1[2] + o1[3] * o1[3]);
                }
                q += __shfl_xor(q, 16); q += __shfl_xor(q, 32);
                if (fq == 0) Pq[(HALF * ai + 64 * wr + 16 * m + fr) * 4 + wc] = q;
            }
        }
        asm volatile("s_waitcnt lgkmcnt(0)" ::: "memory"); __builtin_amdgcn_s_barrier(); asm volatile("" ::: "memory");
        const int row = wid * 32 + (lane & 31);
        if (lane < 32) { const float t = (Pq[row * 4 + 0] + Pq[row * 4 + 1]) + (Pq[row * 4 + 2] + Pq[row * 4 + 3]);
            __hip_atomic_store(slots + (size_t)(256 * u.ta + row) * 16 + 4 * u.tb, t, __ATOMIC_RELAXED, __HIP_MEMORY_SCOPE_AGENT); }
        asm volatile("s_waitcnt vmcnt(0)" ::: "memory");
        if (lane == 0) __hip_atomic_fetch_add(cnt, 1u, __ATOMIC_RELAXED, __HIP_MEMORY_SCOPE_AGENT);
        if (wid == 0) {
            unsigned spins = 0;
            while ((unsigned)__builtin_amdgcn_readfirstlane(__hip_atomic_load(cnt, __ATOMIC_RELAXED, __HIP_MEMORY_SCOPE_AGENT)) < 32u) { __builtin_amdgcn_s_sleep(2); if (++spins > (1u << 22)) break; }
            __builtin_amdgcn_fence(__ATOMIC_ACQUIRE, "agent");
        }
        asm volatile("s_waitcnt vmcnt(0) lgkmcnt(0)" ::: "memory"); __builtin_amdgcn_s_barrier(); asm volatile("" ::: "memory");
        if (lane < 32) { const float* sl = slots + (size_t)(256 * u.ta + row) * 16; float t = 0.f;
#pragma unroll
            for (int k = 0; k < 4; ++k) t += __hip_atomic_load(sl + 4 * k, __ATOMIC_RELAXED, __HIP_MEMORY_SCOPE_AGENT);
            Sr[row] = 1.0f / sqrtf(t * (1.f / DM) + EPS); }
        asm volatile("s_waitcnt vmcnt(0) lgkmcnt(0)" ::: "memory"); __builtin_amdgcn_s_barrier(); asm volatile("" ::: "memory");
        f32x4 fg[2][2];
#pragma unroll
        for (int bj = 0; bj < 2; ++bj) { const int col = 256 * u.tb + HALF * bj + 32 * wc + 8 * fq; fg[bj][0] = *(const f32x4*)(final_g + col); fg[bj][1] = *(const f32x4*)(final_g + col + 4); }
#pragma unroll
        for (int ai = 0; ai < 2; ++ai)
#pragma unroll
            for (int m = 0; m < 4; ++m) { const int r = HALF * ai + 64 * wr + 16 * m + fr; const float rs = Sr[r];
#pragma unroll
                for (int bj = 0; bj < 2; ++bj) { const size_t off = (size_t)(256 * u.ta + r) * 1024 + 256 * u.tb + HALF * bj + 32 * wc + 8 * fq;
                    *(f32x4*)(out + off) = acc[ai][bj][m][0] * rs * fg[bj][0]; *(f32x4*)(out + off + 4) = acc[ai][bj][m][1] * rs * fg[bj][1]; } }
    }
};

__device__ __forceinline__ void p7_final(const Ptrs& P, int lane, int wave, int G) {
    const int gw = blockIdx.x * NWAVES + wave, NGW = G * NWAVES;
    const float* SSQO = (const float*)(P.ws + WS_SSQO);
    for (int row = gw; row < MLAT; row += NGW) {
        float s = 0.f;
        { const f32x4* p = (const f32x4*)(SSQO + (size_t)row * 16); const f32x4 a = p[0], b = p[1], c = p[2], d = p[3];
          s = ((a[0] + a[1]) + (a[2] + a[3])) + ((b[0] + b[1]) + (b[2] + b[3])) + ((c[0] + c[1]) + (c[2] + c[3])) + ((d[0] + d[1]) + (d[2] + d[3])); }
        const float rstd = 1.0f / sqrtf(s * (1.f / DM) + EPS);
        f32x4* o4 = (f32x4*)(P.out + (size_t)row * DM) + lane;
        const f32x4* g4 = (const f32x4*)P.final_g + lane;
#pragma unroll
        for (int j = 0; j < 4; ++j) { f32x4 v = o4[64 * j]; const f32x4 g = g4[64 * j]; v = v * rstd * g; o4[64 * j] = v; }
    }
}

__device__ __forceinline__ int crow(int r, int hi) { return (r & 3) + 8 * (r >> 2) + 4 * hi; }
__device__ __forceinline__ float half_max(float v) { const auto rr = __builtin_amdgcn_permlane32_swap(__float_as_uint(v), __float_as_uint(v), false, false); return fmaxf(__uint_as_float(rr[0]), __uint_as_float(rr[1])); }
__device__ __forceinline__ float half_sum(float v) { const auto rr = __builtin_amdgcn_permlane32_swap(__float_as_uint(v), __float_as_uint(v), false, false); return __uint_as_float(rr[0]) + __uint_as_float(rr[1]); }
constexpr int VROW = 136;
constexpr int ATT_RPB_OFF = 96 * 1024;

template <int DK, bool NA>
__device__ __forceinline__ void attn_unit(LAS unsigned char* lds, const bf16* Qg, const bf16* Kg, const bf16* Vtg, bf16* SZ, const float* rpb, int b, int h, int qblk, int tid, int lane, int wave) {
    constexpr int KROW = DK * 2 + 16, KCH = DK / 8  , NKC = 64 * KCH, KT_BYTES = 64 * KROW, VT_BYTES = 64 * VROW, BUF = KT_BYTES + VT_BYTES;
    const int r32 = lane & 31, hi = lane >> 5;
    const int q0 = qblk * 256;
    const bf16* Kh = Kg + (size_t)(b * NH + h) * TK * DK;
    const bf16* Vh = Vtg + (size_t)(b * NH + h) * 64 * TK;
    int ntiles, kr_lo = 0, nwin = 0, rq = 0, cq = 0, rs = 0, cs = 0;
    if (NA) { const int r0 = qblk * 4; auto rst = [](int r) { int s = r - 4; s = s < 0 ? 0 : s; return s > 56 ? 56 : s; };
        kr_lo = rst(r0); nwin = rst(r0 + 3) + 8 - kr_lo; ntiles = nwin + 4;
        rq = r0 + (wave >> 1); cq = 32 * (wave & 1) + r32; rs = rst(rq); cs = cq - 8; cs = cs < 0 ? 0 : cs; cs = cs > 48 ? 48 : cs;
        LAS float* bt = (LAS float*)(lds + ATT_RPB_OFF);
        for (int i = tid; i < 15 * 31; i += 512) bt[i] = rpb[h * 465 + i] * LOG2E;
    } else ntiles = TK / 64;
    bf16x8 qf[DK / 16];
    { const bf16* qp = Qg + ((size_t)(b * NH + h) * SEQ + q0 + 32 * wave + r32) * DK + 8 * hi;
#pragma unroll
      for (int s = 0; s < DK / 16; ++s) qf[s] = *(const bf16x8*)(qp + 16 * s); }
    auto tile_tok = [&](int j) -> int { if (NA) return j < nwin ? (kr_lo + j) * 64 : SEQ + (j - nwin) * 64; return j * 64; };
    v4u kreg0, kreg1, vreg;
    const int kc0 = tid, kc1 = tid + 512;
    auto gload = [&](int j) { const int tok = tile_tok(j);
        const unsigned char* kb = (const unsigned char*)(Kh + (size_t)tok * DK);
        kreg0 = *(const v4u*)(kb + (size_t)kc0 * 16);
        if (kc1 < NKC) kreg1 = *(const v4u*)(kb + (size_t)kc1 * 16);
        vreg = *(const v4u*)((const unsigned char*)(Vh + (size_t)(tid >> 3) * TK + tok) + (tid & 7) * 16); };
    auto lstore = [&](int buf) { LAS unsigned char* base = lds + buf * BUF;
        *(LAS v4u*)(base + (kc0 / KCH) * KROW + (kc0 % KCH) * 16) = kreg0;
        if (kc1 < NKC) *(LAS v4u*)(base + (kc1 / KCH) * KROW + (kc1 % KCH) * 16) = kreg1;
        LAS unsigned char* vp = base + KT_BYTES + (tid >> 3) * VROW + (tid & 7) * 16;
        *(LAS v2u*)vp = (v2u){vreg.x, vreg.y}; *(LAS v2u*)(vp + 8) = (v2u){vreg.z, vreg.w}; };
    float m_run = -1e30f, l_run = 0.f;
    f32x16 o0 = {}, o1 = {};
    gload(0); lstore(0); __syncthreads();
    for (int j = 0; j < ntiles; ++j) {
        const bool more = (j + 1 < ntiles);
        if (more) gload(j + 1);
        bool active = true; int krow = 0;
        if (NA && j < nwin) { krow = kr_lo + j; active = (krow >= rs && krow < rs + 8); }
        if (active) {
            const LAS unsigned char* kb = lds + (j & 1) * BUF;
            const LAS unsigned char* vb = kb + KT_BYTES;
            f32x16 s0 = {}, s1 = {};
#pragma unroll
            for (int s = 0; s < DK / 16; ++s) {
                const bf16x8 k0 = *(const LAS bf16x8*)(kb + r32 * KROW + (16 * s + 8 * hi) * 2);
                const bf16x8 k1 = *(const LAS bf16x8*)(kb + (32 + r32) * KROW + (16 * s + 8 * hi) * 2);
                s0 = __builtin_amdgcn_mfma_f32_32x32x16_bf16(k0, qf[s], s0, 0, 0, 0);
                s1 = __builtin_amdgcn_mfma_f32_32x32x16_bf16(k1, qf[s], s1, 0, 0, 0);
            }
            if (NA && j < nwin) {
                const LAS float* bt = (const LAS float*)(lds + ATT_RPB_OFF) + (krow - rq + 7) * 31 + (15 - cq);
#pragma unroll
                for (int i = 0; i < 16; ++i) {
                    const int kc = crow(i, hi);
                    { const bool ok = (unsigned)(kc - cs) < 16u; const float bv = bt[ok ? kc : cq]; s0[i] = ok ? s0[i] + bv : -1e30f; }
                    { const int kc2 = kc + 32; const bool ok = (unsigned)(kc2 - cs) < 16u; const float bv = bt[ok ? kc2 : cq]; s1[i] = ok ? s1[i] + bv : -1e30f; }
                }
            }
            float mx = fmaxf(s0[0], s1[0]);
#pragma unroll
            for (int i = 1; i < 16; ++i) mx = fmaxf(mx, fmaxf(s0[i], s1[i]));
            mx = half_max(mx);
            if (__any(mx > m_run + 4.0f)) {
                const float mnew = fmaxf(m_run, mx);
                const float alpha = __builtin_amdgcn_exp2f(m_run - mnew);
                m_run = mnew; l_run *= alpha;
#pragma unroll
                for (int i = 0; i < 16; ++i) { o0[i] *= alpha; o1[i] *= alpha; }
            }
            float ls = 0.f;
#pragma unroll
            for (int i = 0; i < 16; ++i) { s0[i] = __builtin_amdgcn_exp2f(s0[i] - m_run); s1[i] = __builtin_amdgcn_exp2f(s1[i] - m_run); ls += s0[i] + s1[i]; }
            l_run += ls;
            bf16x8 pb[2][2];
#pragma unroll
            for (int kk = 0; kk < 2; ++kk) {
                v4u w0, w1;
                w0.x = cvt_pk_bf16(s0[8 * kk + 0], s0[8 * kk + 1]); w0.y = cvt_pk_bf16(s0[8 * kk + 2], s0[8 * kk + 3]); w0.z = cvt_pk_bf16(s0[8 * kk + 4], s0[8 * kk + 5]); w0.w = cvt_pk_bf16(s0[8 * kk + 6], s0[8 * kk + 7]);
                w1.x = cvt_pk_bf16(s1[8 * kk + 0], s1[8 * kk + 1]); w1.y = cvt_pk_bf16(s1[8 * kk + 2], s1[8 * kk + 3]); w1.z = cvt_pk_bf16(s1[8 * kk + 4], s1[8 * kk + 5]); w1.w = cvt_pk_bf16(s1[8 * kk + 6], s1[8 * kk + 7]);
                pb[0][kk] = __builtin_bit_cast(bf16x8, w0); pb[1][kk] = __builtin_bit_cast(bf16x8, w1);
            }
#pragma unroll
            for (int u = 0; u < 2; ++u)
#pragma unroll
                for (int kk = 0; kk < 2; ++kk) {
                    const int koff = (32 * u + 16 * kk + 4 * hi) * 2;
                    const LAS unsigned char* v0p = vb + r32 * VROW + koff;
                    const LAS unsigned char* v1p = vb + (32 + r32) * VROW + koff;
                    const s16x4 a0 = *(const LAS s16x4*)v0p, a1 = *(const LAS s16x4*)(v0p + 16);
                    const s16x4 c0 = *(const LAS s16x4*)v1p, c1 = *(const LAS s16x4*)(v1p + 16);
                    const bf16x8 vf0 = {a0[0], a0[1], a0[2], a0[3], a1[0], a1[1], a1[2], a1[3]};
                    const bf16x8 vf1 = {c0[0], c0[1], c0[2], c0[3], c1[0], c1[1], c1[2], c1[3]};
                    o0 = __builtin_amdgcn_mfma_f32_32x32x16_bf16(vf0, pb[u][kk], o0, 0, 0, 0);
                    o1 = __builtin_amdgcn_mfma_f32_32x32x16_bf16(vf1, pb[u][kk], o1, 0, 0, 0);
                }
        }
        if (more) lstore((j + 1) & 1);
        __syncthreads();
    }
    const float lt = half_sum(l_run);
    const float inv = 1.0f / lt;
    bf16* zp = SZ + ((size_t)(b * SEQ + q0 + 32 * wave + r32)) * 512 + h * 64;
#pragma unroll
    for (int dt = 0; dt < 2; ++dt)
#pragma unroll
        for (int g = 0; g < 4; ++g) {
            bf16* p = zp + 32 * dt + 8 * g + 4 * hi;
            const v2u z = *(const v2u*)p;
            const f32x16& o = dt ? o1 : o0;
            v2u w; w.x = cvt_pk_bf16(o[4 * g + 0] * inv * bf_lo(z.x), o[4 * g + 1] * inv * bf_hi(z.x)); w.y = cvt_pk_bf16(o[4 * g + 2] * inv * bf_lo(z.y), o[4 * g + 3] * inv * bf_hi(z.y));
            *(v2u*)p = w;
        }
}


__device__ __forceinline__ void attn_unit_na2(LAS unsigned char* lds, const bf16* Qg, const bf16* Kg, const bf16* Vtg, bf16* SZ, const float* rpb, int b, int h, int qblk, int tid, int lane, int wave) {
    constexpr int DK = 64; constexpr bool NA = true;
    constexpr int KROW = DK * 2 + 16, KCH = DK / 8  , NKC = 64 * KCH, KT_BYTES = 64 * KROW, VT_BYTES = 64 * VROW, SUB = KT_BYTES + VT_BYTES, BUF = 2 * SUB;
    const int r32 = lane & 31, hi = lane >> 5;
    const int q0 = qblk * 256;
    const bf16* Kh = Kg + (size_t)(b * NH + h) * TK * DK;
    const bf16* Vh = Vtg + (size_t)(b * NH + h) * 64 * TK;
    int ntiles, kr_lo = 0, nwin = 0, rq = 0, cq = 0, rs = 0, cs = 0;
    unsigned vmask0 = 0u, vmask1 = 0u;
    if (NA) { const int r0 = qblk * 4; auto rst = [](int r) { int s = r - 4; s = s < 0 ? 0 : s; return s > 56 ? 56 : s; };
        kr_lo = rst(r0); nwin = rst(r0 + 3) + 8 - kr_lo; ntiles = nwin + 4;
        rq = r0 + (wave >> 1); cq = 32 * (wave & 1) + r32; rs = rst(rq); cs = cq - 8; cs = cs < 0 ? 0 : cs; cs = cs > 48 ? 48 : cs;
        for (int i = 0; i < 16; ++i) { const int kc = crow(i, hi); vmask0 |= ((unsigned)(kc - cs) < 16u ? 1u : 0u) << i; vmask1 |= ((unsigned)(kc + 32 - cs) < 16u ? 1u : 0u) << i; }
        LAS float* bt = (LAS float*)(lds + ATT_RPB_OFF);
        for (int i = tid; i < 15 * 31; i += 512) bt[i] = rpb[h * 465 + i] * LOG2E;
    } else ntiles = TK / 64;
    bf16x8 qf[DK / 16];
    { const bf16* qp = Qg + ((size_t)(b * NH + h) * SEQ + q0 + 32 * wave + r32) * DK + 8 * hi;
#pragma unroll
      for (int s = 0; s < DK / 16; ++s) qf[s] = *(const bf16x8*)(qp + 16 * s); }
    auto tile_tok = [&](int j) -> int { if (NA) return j < nwin ? (kr_lo + j) * 64 : SEQ + (j - nwin) * 64; return j * 64; };
    v4u kreg[2], vreg[2];
    const int kc0 = tid;
    auto gload = [&](int jp) {
#pragma unroll
        for (int sub = 0; sub < 2; ++sub) { const int j = 2 * jp + sub; if (j < ntiles) { const int tok = tile_tok(j);
            kreg[sub] = *(const v4u*)((const unsigned char*)(Kh + (size_t)tok * DK) + (size_t)kc0 * 16);
            vreg[sub] = *(const v4u*)((const unsigned char*)(Vh + (size_t)(tid >> 3) * TK + tok) + (tid & 7) * 16); } } };
    auto lstore = [&](int buf, int jp) {
#pragma unroll
        for (int sub = 0; sub < 2; ++sub) { if (2 * jp + sub < ntiles) { LAS unsigned char* base = lds + buf * BUF + sub * SUB;
            *(LAS v4u*)(base + (kc0 / KCH) * KROW + (kc0 % KCH) * 16) = kreg[sub];
            LAS unsigned char* vp = base + KT_BYTES + (tid >> 3) * VROW + (tid & 7) * 16;
            *(LAS v2u*)vp = (v2u){vreg[sub].x, vreg[sub].y}; *(LAS v2u*)(vp + 8) = (v2u){vreg[sub].z, vreg[sub].w}; } } };
    float m_run = -1e30f, l_run = 0.f;
    f32x16 o0 = {}, o1 = {};
    const int npairs = (ntiles + 1) >> 1;
    gload(0); lstore(0, 0); __syncthreads();
    for (int jp = 0; jp < npairs; ++jp) {
        const bool more = (jp + 1 < npairs);
        if (more) gload(jp + 1);
#pragma unroll
        for (int sub = 0; sub < 2; ++sub) {
        const int j = 2 * jp + sub;
        bool active = (j < ntiles); int krow = 0;
        if (NA && j < nwin) { krow = kr_lo + j; active = (krow >= rs && krow < rs + 8); }
        if (active) {
            const LAS unsigned char* kb = lds + (jp & 1) * BUF + sub * SUB;
            const LAS unsigned char* vb = kb + KT_BYTES;
            f32x16 s0 = {}, s1 = {};
#pragma unroll
            for (int s = 0; s < DK / 16; ++s) {
                const bf16x8 k0 = *(const LAS bf16x8*)(kb + r32 * KROW + (16 * s + 8 * hi) * 2);
                const bf16x8 k1 = *(const LAS bf16x8*)(kb + (32 + r32) * KROW + (16 * s + 8 * hi) * 2);
                s0 = __builtin_amdgcn_mfma_f32_32x32x16_bf16(k0, qf[s], s0, 0, 0, 0);
                s1 = __builtin_amdgcn_mfma_f32_32x32x16_bf16(k1, qf[s], s1, 0, 0, 0);
            }
            if (NA && j < nwin) {
                const LAS float* bt = (const LAS float*)(lds + ATT_RPB_OFF) + (krow - rq + 7) * 31 + (15 - cq);
#pragma unroll
                for (int i = 0; i < 16; ++i) {
                    const LAS float* bp = bt + 4 * hi;
                    const int kci = (i & 3) + 8 * (i >> 2);
                    { const float bv = bp[kci]; s0[i] = ((vmask0 >> i) & 1u) ? s0[i] + bv : -1e30f; }
                    { const float bv = bp[kci + 32]; s1[i] = ((vmask1 >> i) & 1u) ? s1[i] + bv : -1e30f; }
                }
            }
            float mx = fmaxf(s0[0], s1[0]);
#pragma unroll
            for (int i = 1; i < 16; ++i) mx = fmaxf(mx, fmaxf(s0[i], s1[i]));
            mx = half_max(mx);
            if (__any(mx > m_run + 4.0f)) {
                const float mnew = fmaxf(m_run, mx);
                const float alpha = __builtin_amdgcn_exp2f(m_run - mnew);
                m_run = mnew; l_run *= alpha;
#pragma unroll
                for (int i = 0; i < 16; ++i) { o0[i] *= alpha; o1[i] *= alpha; }
            }
            float ls = 0.f;
#pragma unroll
            for (int i = 0; i < 16; ++i) { s0[i] = __builtin_amdgcn_exp2f(s0[i] - m_run); s1[i] = __builtin_amdgcn_exp2f(s1[i] - m_run); ls += s0[i] + s1[i]; }
            l_run += ls;
            bf16x8 pb[2][2];
#pragma unroll
            for (int kk = 0; kk < 2; ++kk) {
                v4u w0, w1;
                w0.x = cvt_pk_bf16(s0[8 * kk + 0], s0[8 * kk + 1]); w0.y = cvt_pk_bf16(s0[8 * kk + 2], s0[8 * kk + 3]); w0.z = cvt_pk_bf16(s0[8 * kk + 4], s0[8 * kk + 5]); w0.w = cvt_pk_bf16(s0[8 * kk + 6], s0[8 * kk + 7]);
                w1.x = cvt_pk_bf16(s1[8 * kk + 0], s1[8 * kk + 1]); w1.y = cvt_pk_bf16(s1[8 * kk + 2], s1[8 * kk + 3]); w1.z = cvt_pk_bf16(s1[8 * kk + 4], s1[8 * kk + 5]); w1.w = cvt_pk_bf16(s1[8 * kk + 6], s1[8 * kk + 7]);
                pb[0][kk] = __builtin_bit_cast(bf16x8, w0); pb[1][kk] = __builtin_bit_cast(bf16x8, w1);
            }
#pragma unroll
            for (int u = 0; u < 2; ++u)
#pragma unroll
                for (int kk = 0; kk < 2; ++kk) {
                    const int koff = (32 * u + 16 * kk + 4 * hi) * 2;
                    const LAS unsigned char* v0p = vb + r32 * VROW + koff;
                    const LAS unsigned char* v1p = vb + (32 + r32) * VROW + koff;
                    const s16x4 a0 = *(const LAS s16x4*)v0p, a1 = *(const LAS s16x4*)(v0p + 16);
                    const s16x4 c0 = *(const LAS s16x4*)v1p, c1 = *(const LAS s16x4*)(v1p + 16);
                    const bf16x8 vf0 = {a0[0], a0[1], a0[2], a0[3], a1[0], a1[1], a1[2], a1[3]};
                    const bf16x8 vf1 = {c0[0], c0[1], c0[2], c0[3], c1[0], c1[1], c1[2], c1[3]};
                    o0 = __builtin_amdgcn_mfma_f32_32x32x16_bf16(vf0, pb[u][kk], o0, 0, 0, 0);
                    o1 = __builtin_amdgcn_mfma_f32_32x32x16_bf16(vf1, pb[u][kk], o1, 0, 0, 0);
                }
        }
        }
        if (more) lstore((jp + 1) & 1, jp + 1);
        __syncthreads();
    }
    const float lt = half_sum(l_run);
    const float inv = 1.0f / lt;
    bf16* zp = SZ + ((size_t)(b * SEQ + q0 + 32 * wave + r32)) * 512 + h * 64;
#pragma unroll
    for (int dt = 0; dt < 2; ++dt)
#pragma unroll
        for (int g = 0; g < 4; ++g) {
            bf16* p = zp + 32 * dt + 8 * g + 4 * hi;
            const v2u z = *(const v2u*)p;
            const f32x16& o = dt ? o1 : o0;
            v2u w; w.x = cvt_pk_bf16(o[4 * g + 0] * inv * bf_lo(z.x), o[4 * g + 1] * inv * bf_hi(z.x)); w.y = cvt_pk_bf16(o[4 * g + 2] * inv * bf_lo(z.y), o[4 * g + 3] * inv * bf_hi(z.y));
            *(v2u*)p = w;
        }
}


__device__ __forceinline__ void attn_unit_mla2(LAS unsigned char* lds, const bf16* Qg, const bf16* Kg, const bf16* Vtg, bf16* SZ, int b, int h, int qblk, int tid, int lane, int wave) {
    constexpr int DK = 96, KROW = DK * 2 + 16, KCH = DK / 8, NKC = 64 * KCH, KT_BYTES = 64 * KROW, VT_BYTES = 64 * VROW, SUB = KT_BYTES + VT_BYTES, BUF = 2 * SUB;
    const int r32 = lane & 31, hi = lane >> 5;
    const int q0 = qblk * 256;
    const bf16* Kh = Kg + (size_t)(b * NH + h) * TK * DK;
    const bf16* Vh = Vtg + (size_t)(b * NH + h) * 64 * TK;
    constexpr int ntiles = TK / 128;
    bf16x8 qf[DK / 16];
    { const bf16* qp = Qg + ((size_t)(b * NH + h) * SEQ + q0 + 32 * wave + r32) * DK + 8 * hi;
#pragma unroll
      for (int s = 0; s < DK / 16; ++s) qf[s] = *(const bf16x8*)(qp + 16 * s); }
    v4u kreg[2][2], vreg[2];
    const int kc0 = tid, kc1 = tid + 512;
    auto gload = [&](int j) {
#pragma unroll
        for (int sub = 0; sub < 2; ++sub) { const int tok = j * 128 + 64 * sub;
            const unsigned char* kb = (const unsigned char*)(Kh + (size_t)tok * DK);
            kreg[sub][0] = *(const v4u*)(kb + (size_t)kc0 * 16);
            if (kc1 < NKC) kreg[sub][1] = *(const v4u*)(kb + (size_t)kc1 * 16);
            vreg[sub] = *(const v4u*)((const unsigned char*)(Vh + (size_t)(tid >> 3) * TK + tok) + (tid & 7) * 16); } };
    auto lstore = [&](int buf) {
#pragma unroll
        for (int sub = 0; sub < 2; ++sub) { LAS unsigned char* base = lds + buf * BUF + sub * SUB;
            *(LAS v4u*)(base + (kc0 / KCH) * KROW + (kc0 % KCH) * 16) = kreg[sub][0];
            if (kc1 < NKC) *(LAS v4u*)(base + (kc1 / KCH) * KROW + (kc1 % KCH) * 16) = kreg[sub][1];
            LAS unsigned char* vp = base + KT_BYTES + (tid >> 3) * VROW + (tid & 7) * 16;
            *(LAS v2u*)vp = (v2u){vreg[sub].x, vreg[sub].y}; *(LAS v2u*)(vp + 8) = (v2u){vreg[sub].z, vreg[sub].w}; } };
    float m_run = 0.f, l_run = 0.f;
    f32x16 o0 = {}, o1 = {};
    gload(0); lstore(0); __syncthreads();
    for (int j = 0; j < ntiles; ++j) {
        const bool more = (j + 1 < ntiles);
        if (more) gload(j + 1);
        const LAS unsigned char* tb = lds + (j & 1) * BUF;
        f32x16 s[2][2];
        f32x16 negm;
#pragma unroll
        for (int i = 0; i < 16; ++i) negm[i] = -m_run;
        const LAS unsigned char* kp0 = tb + r32 * KROW + 16 * hi;
        const LAS unsigned char* vp0 = tb + KT_BYTES + r32 * VROW + 8 * hi;
#define KFRAG(sub, u, st) (*(const LAS bf16x8*)(kp0 + (sub) * SUB + (u) * 32 * KROW + (st) * 32))
        bf16x8 ka[DK / 16][2], kb2[DK / 16][2];
#pragma unroll
        for (int st = 0; st < DK / 16; ++st) { ka[st][0] = KFRAG(0, 0, st); ka[st][1] = KFRAG(0, 1, st); }
        __builtin_amdgcn_sched_barrier(0);
#pragma unroll
        for (int st = 0; st < DK / 16; ++st) {
            kb2[st][0] = KFRAG(1, 0, st); kb2[st][1] = KFRAG(1, 1, st);
            s[0][0] = __builtin_amdgcn_mfma_f32_32x32x16_bf16(ka[st][0], qf[st], st == 0 ? negm : s[0][0], 0, 0, 0);
            s[0][1] = __builtin_amdgcn_mfma_f32_32x32x16_bf16(ka[st][1], qf[st], st == 0 ? negm : s[0][1], 0, 0, 0);
        }
        __builtin_amdgcn_sched_barrier(0);
        s16x4 va[2][2][2][2];
#define VFRAG(sub, u, kk, dt, half) (*(const LAS s16x4*)(vp0 + (sub) * SUB + (dt) * 32 * VROW + (32 * (u) + 16 * (kk)) * 2 + (half) * 16))
#pragma unroll
        for (int u = 0; u < 2; ++u)
#pragma unroll
            for (int kk = 0; kk < 2; ++kk)
#pragma unroll
                for (int dt = 0; dt < 2; ++dt) { va[u][kk][dt][0] = VFRAG(0, u, kk, dt, 0); va[u][kk][dt][1] = VFRAG(0, u, kk, dt, 1); }
#pragma unroll
        for (int st = 0; st < DK / 16; ++st) {
            s[1][0] = __builtin_amdgcn_mfma_f32_32x32x16_bf16(kb2[st][0], qf[st], st == 0 ? negm : s[1][0], 0, 0, 0);
            s[1][1] = __builtin_amdgcn_mfma_f32_32x32x16_bf16(kb2[st][1], qf[st], st == 0 ? negm : s[1][1], 0, 0, 0);
        }
        __builtin_amdgcn_sched_barrier(0);
        float mx = fmaxf(fmaxf(s[0][0][0], s[0][1][0]), fmaxf(s[1][0][0], s[1][1][0]));
#pragma unroll
        for (int i = 1; i < 16; ++i) mx = fmaxf(mx, fmaxf(fmaxf(s[0][0][i], s[0][1][i]), fmaxf(s[1][0][i], s[1][1][i])));
        mx = half_max(mx);
        if (j == 0 || __any(mx > 4.0f)) {
            const float d = (j == 0) ? mx : fmaxf(mx, 0.f);
            const float alpha = (j == 0) ? 0.f : __builtin_amdgcn_exp2f(-d);
            m_run += d; l_run *= alpha;
#pragma unroll
            for (int i = 0; i < 16; ++i) { o0[i] *= alpha; o1[i] *= alpha; }
#pragma unroll
            for (int sub = 0; sub < 2; ++sub)
#pragma unroll
                for (int u = 0; u < 2; ++u)
#pragma unroll
                    for (int i = 0; i < 16; ++i) s[sub][u][i] -= d;
        }
        float ls = 0.f;
#pragma unroll
        for (int sub = 0; sub < 2; ++sub)
#pragma unroll
            for (int u = 0; u < 2; ++u)
#pragma unroll
                for (int i = 0; i < 16; ++i) { s[sub][u][i] = __builtin_amdgcn_exp2f(s[sub][u][i]); ls += s[sub][u][i]; }
        l_run += ls;
        __builtin_amdgcn_sched_barrier(0);
        s16x4 vb2[2][2][2][2];
#define PFRAG(sub, u, kk) ({ v4u w_; const f32x16& sv_ = s[sub][u]; w_.x = cvt_pk_bf16(sv_[8 * (kk) + 0], sv_[8 * (kk) + 1]); w_.y = cvt_pk_bf16(sv_[8 * (kk) + 2], sv_[8 * (kk) + 3]); \
            w_.z = cvt_pk_bf16(sv_[8 * (kk) + 4], sv_[8 * (kk) + 5]); w_.w = cvt_pk_bf16(sv_[8 * (kk) + 6], sv_[8 * (kk) + 7]); __builtin_bit_cast(bf16x8, w_); })
#define V8(a_) ((bf16x8){(a_)[0][0], (a_)[0][1], (a_)[0][2], (a_)[0][3], (a_)[1][0], (a_)[1][1], (a_)[1][2], (a_)[1][3]})
#pragma unroll
        for (int u = 0; u < 2; ++u)
#pragma unroll
            for (int kk = 0; kk < 2; ++kk) {
#pragma unroll
                for (int dt = 0; dt < 2; ++dt) { vb2[u][kk][dt][0] = VFRAG(1, u, kk, dt, 0); vb2[u][kk][dt][1] = VFRAG(1, u, kk, dt, 1); }
                const bf16x8 pb = PFRAG(0, u, kk);
                o0 = __builtin_amdgcn_mfma_f32_32x32x16_bf16(V8(va[u][kk][0]), pb, o0, 0, 0, 0);
                o1 = __builtin_amdgcn_mfma_f32_32x32x16_bf16(V8(va[u][kk][1]), pb, o1, 0, 0, 0);
            }
        __builtin_amdgcn_sched_barrier(0);
#pragma unroll
        for (int u = 0; u < 2; ++u)
#pragma unroll
            for (int kk = 0; kk < 2; ++kk) {
                const bf16x8 pb = PFRAG(1, u, kk);
                o0 = __builtin_amdgcn_mfma_f32_32x32x16_bf16(V8(vb2[u][kk][0]), pb, o0, 0, 0, 0);
                o1 = __builtin_amdgcn_mfma_f32_32x32x16_bf16(V8(vb2[u][kk][1]), pb, o1, 0, 0, 0);
            }
#undef KFRAG
#undef VFRAG
#undef PFRAG
#undef V8
        if (more) lstore((j + 1) & 1);
        __syncthreads();
    }
    const float lt = half_sum(l_run);
    const float inv = 1.0f / lt;
    bf16* zp = SZ + ((size_t)(b * SEQ + q0 + 32 * wave + r32)) * 512 + h * 64;
#pragma unroll
    for (int dt = 0; dt < 2; ++dt)
#pragma unroll
        for (int g = 0; g < 4; ++g) {
            bf16* p = zp + 32 * dt + 8 * g + 4 * hi;
            const v2u z = *(const v2u*)p;
            const f32x16& o = dt ? o1 : o0;
            v2u w; w.x = cvt_pk_bf16(o[4 * g + 0] * inv * bf_lo(z.x), o[4 * g + 1] * inv * bf_hi(z.x)); w.y = cvt_pk_bf16(o[4 * g + 2] * inv * bf_lo(z.y), o[4 * g + 3] * inv * bf_hi(z.y));
            *(v2u*)p = w;
        }
}

constexpr int CW_CTXKV = 12288;
__device__ __forceinline__ void p4_attention(const Ptrs& P, LAS unsigned char* lds, int tid, int lane, int wave, int G) {
    const int bx = blockIdx.x; const int vcu = (G % 8 == 0) ? (bx % 8) * (G / 8) + bx / 8 : bx;
    for (int u = vcu; u < 512; u += G) { const int bh = u >> 4, qb = u & 15;
        attn_unit_na2(lds, (const bf16*)(P.ws + WS_QB), (const bf16*)(P.ws + WS_KB), (const bf16*)(P.ws + WS_VBT), (bf16*)(P.ws + WS_SZB), P.rpb, bh >> 3, bh & 7, qb, tid, lane, wave); }
    if (tid == 0) { unsigned* cnt = (unsigned*)(P.ws + WS_CTL) + CW_CTXKV; unsigned spins = 0;
        while (__hip_atomic_load(cnt, __ATOMIC_RELAXED, __HIP_MEMORY_SCOPE_AGENT) < 16u) { __builtin_amdgcn_s_sleep(2); if (++spins > (1u << 22)) break; }
        __builtin_amdgcn_fence(__ATOMIC_ACQUIRE, "agent"); asm volatile("s_waitcnt vmcnt(0)" ::: "memory"); }
    __syncthreads();
    for (int u = vcu; u < 512; u += G) { const int bh = u >> 4, qb = u & 15;
        attn_unit_mla2(lds, (const bf16*)(P.ws + WS_QA), (const bf16*)((unsigned char*)P.out + DO_KA), (const bf16*)((unsigned char*)P.out + DO_VAT), (bf16*)(P.ws + WS_SZA), bh >> 3, bh & 7, qb, tid, lane, wave); }
}

struct Args { Ptrs p; int ph_lo, ph_hi; };
constexpr int N_PHASES = 8;
__global__ void __launch_bounds__(NWAVES * 64, 2) mk_fwd(Args args) {
    extern __shared__ __attribute__((aligned(16))) unsigned char lds_raw[];
    LAS unsigned char* lds = (LAS unsigned char*)lds_raw;
    const Ptrs& P = args.p;
    const int tid = threadIdx.x, lane = tid & 63, wave = __builtin_amdgcn_readfirstlane(tid >> 6);
    const int G = gridDim.x;
    volatile LAS unsigned* MISC = (volatile LAS unsigned*)(lds + MISC_OFF);
    for (int u = tid; u < 32; u += NWAVES * 64) MISC[u] = 0u;
    __syncthreads();
    XcdBarrier bar; bar.bar = (unsigned*)(P.ws + WS_CTL) + CW_BAR; bar.x = 0; bar.st = nullptr;
    if (MK_N_LAUNCHES == 1) bar = xcd_barrier_post((unsigned*)(P.ws + WS_CTL) + CW_BAR, MISC + 8);
    const int lo = args.ph_lo, hi = args.ph_hi;
    int K1024 = 1024, K512 = 512, K256 = 256; asm volatile("" : "+s"(K1024), "+s"(K512), "+s"(K256));
#ifndef PH_MASK
#define PH_MASK 0xff
#endif
#define IN(k) (((PH_MASK >> (k)) & 1) && lo <= (k) && (k) < hi)
#define SEAM(k) do { if (IN(k) && IN((k) + 1)) xcd_barrier(bar); } while (0)
    unsigned char* ws = P.ws; unsigned char* dout = (unsigned char*)P.out;

    if (IN(0)) { p0_gemv(P, lds, tid, lane, wave, G); }
    SEAM(0);
    if (IN(1)) { p0_weights(P, lds, tid, lane, wave, G); p1_hconv(P, lane, wave, G); }
    SEAM(1);
    if (IN(2)) { SchedG1 S{G, (int)blockIdx.x, (const char*)(ws + WS_H), (const char*)(ws + WS_WIN)}; EpiG1 E{ws, dout};
        pg8::gemm_phase<EpiG1, SchedG1, true, true>(lds, K1024, S, E); }
    SEAM(2);
    const int nCtx = (G >= 64) ? 20 : G, g23_first = (G >= 64) ? 20 : 0;
    if (IN(3)) { { SchedG1C S{nCtx, (int)blockIdx.x, (const char*)(ws + WS_H), (const char*)(ws + WS_WIN)}; EpiG1 E{ws, dout}; pg8::gemm_phase<EpiG1, SchedG1C, true, true>(lds, K1024, S, E); }
        { SchedG23 S{g23_first, G - g23_first, (int)blockIdx.x, (const char*)ws}; EpiG23 E{ws, dout}; pg8::gemm_phase<EpiG23, SchedG23, true, true>(lds, K256, S, E); } }
    SEAM(3);
    if (IN(4)) {
        const int nKv = (G >= 16) ? 16 : G; int my_units = 0; for (int k = (int)blockIdx.x; k < 16 && (int)blockIdx.x < nKv; k += nKv) ++my_units;
        { SchedG23C S{nKv, (int)blockIdx.x, (const char*)ws}; EpiG23 E{ws, dout}; pg8::gemm_phase<EpiG23, SchedG23C, true, true>(lds, K256, S, E); }
        if (my_units > 0) {
            asm volatile("s_waitcnt vmcnt(0)" ::: "memory"); __syncthreads();
            if (tid == 0) { __builtin_amdgcn_fence(__ATOMIC_RELEASE, "agent"); asm volatile("s_waitcnt vmcnt(0)" ::: "memory");
                __hip_atomic_fetch_add((unsigned*)(ws + WS_CTL) + CW_CTXKV, (unsigned)my_units, __ATOMIC_RELAXED, __HIP_MEMORY_SCOPE_AGENT); }
        }
        p4_attention(P, lds, tid, lane, wave, G); }
    SEAM(4);
    if (IN(5)) { SchedG4 S{G, (int)blockIdx.x, (const char*)(ws + WS_SZA), (const char*)(ws + WS_SZB), (const char*)(ws + WS_WOA), (const char*)(ws + WS_WOB)}; EpiG4 E{ws, P.out};
        pg8::gemm_phase<EpiG4, SchedG4, true, true>(lds, K512, S, E); }
    SEAM(5);
    const bool fuse_final = (G == 256) && IN(6) && IN(7);
    if (IN(6)) { SchedG5 S{G, (int)blockIdx.x, (const char*)(ws + WS_M), (const char*)(ws + WS_WOUT)};
        if (fuse_final) { EpiG5F E{ws, P.x, P.out, P.final_g}; pg8::gemm_phase<EpiG5F, SchedG5, false, true>(lds, K1024, S, E); }
        else { EpiG5 E{ws, P.x, P.out}; pg8::gemm_phase<EpiG5, SchedG5, true, true>(lds, K1024, S, E); } }
    if (!fuse_final) {
    SEAM(6);
    if (IN(7)) { p7_final(P, lane, wave, G); }
    }
#undef IN
#undef SEAM
}

extern "C" void kernel_launch(void* const* d_in, const int* in_sizes, int n_in, void* d_out, int out_size, void* d_ws, size_t ws_size, hipStream_t stream) {
    static int grid = 0;
    if (grid == 0) {
        if (n_in != 17 || in_sizes[0] != MLAT * DM || out_size != MLAT * DM || ws_size < WS_END) { fprintf(stderr, "kernel_launch: unexpected shapes (n_in %d, ws %zu); nothing launched\n", n_in, ws_size); grid = -1; return; }
        int dev = 0, cus = 0, per_cu = 0;
        if (hipGetDevice(&dev) != hipSuccess || hipDeviceGetAttribute(&cus, hipDeviceAttributeMultiprocessorCount, dev) != hipSuccess) { grid = -1; return; }
        if (hipFuncSetAttribute((const void*)mk_fwd, hipFuncAttributeMaxDynamicSharedMemorySize, LDS_BYTES) != hipSuccess) { fprintf(stderr, "kernel_launch: hipFuncSetAttribute failed\n"); grid = -1; return; }
        if (hipOccupancyMaxActiveBlocksPerMultiprocessor(&per_cu, (const void*)mk_fwd, NWAVES * 64, LDS_BYTES) != hipSuccess || per_cu < 1) fprintf(stderr, "kernel_launch: occupancy query says %d\n", per_cu);
        (void)hipGetLastError();
        grid = cus;
    }
    if (grid < 0) return;
    if (hipMemsetAsync((char*)d_ws + WS_CTL, 0, CTL_ZERO_BYTES, stream) != hipSuccess) { fprintf(stderr, "kernel_launch: memset failed\n"); return; }
    Args a{};
    const float** pp = (const float**)&a.p;
    for (int i = 0; i < 17; ++i) pp[i] = (const float*)d_in[i];
    a.p.out = (float*)d_out; a.p.ws = (unsigned char*)d_ws;
    if (MK_N_LAUNCHES == 1) {
        a.ph_lo = 0; a.ph_hi = N_PHASES;
        void* kargs[] = {&a};
        hipError_t e = hipLaunchCooperativeKernel((const void*)mk_fwd, dim3(grid), dim3(NWAVES * 64), kargs, LDS_BYTES, stream);
        if (e != hipSuccess) fprintf(stderr, "kernel_launch: cooperative launch failed: %s (grid %d)\n", hipGetErrorString(e), grid);
    } else {
        for (int k = 0; k < N_PHASES; ++k) { a.ph_lo = k; a.ph_hi = k + 1; hipLaunchKernelGGL(mk_fwd, dim3(grid), dim3(NWAVES * 64), LDS_BYTES, stream, a); }
    }
}
```

```cpp
#include <hip/hip_runtime.h>
#include <hip/hip_bf16.h>
#include <cstdio>
#include <cstdint>
#include <cmath>

#ifndef MK_N_LAUNCHES
#define MK_N_LAUNCHES 1
#endif

namespace pg8 {
#define PG8_LAS __attribute__((address_space(3)))
typedef unsigned short bf16_t;
typedef short bf16x8 __attribute__((ext_vector_type(8)));
typedef float f32x4 __attribute__((ext_vector_type(4)));
typedef unsigned u32x4 __attribute__((ext_vector_type(4)));
typedef unsigned u32x2 __attribute__((ext_vector_type(2)));
constexpr int BM = 256, BK = 64, HALF = 128, HTB = HALF * BK * 2  , STAGE_BYTES = 8 * HTB, NXCD = 8, WGM = 8;

__host__ __device__ __forceinline__ int lds_byte(int r, int c) { const int st = (r >> 4) * 2 + (c >> 5), rr = r & 15, cc = c & 31, ob = rr * 64 + cc * 2; return st * 1024 + (ob ^ (((ob >> 9) & 1) << 5)); }
__host__ __device__ __forceinline__ void stage_rc(int b, int& R, int& C) { const int st = b / 1024, sb = b % 1024, swz = sb ^ (((sb >> 9) & 1) << 5); R = (st >> 1) * 16 + swz / 64; C = (st & 1) * 32 + (swz % 64) / 2; }
__host__ __device__ __forceinline__ int perm32(int rho) { const int n = rho >> 4, i = rho & 15; return 8 * (i >> 2) + 4 * n + (i & 3); }

struct Unit { int ta, tb, kind; };
typedef float f32x2_cv __attribute__((ext_vector_type(2))); typedef __bf16 bf16x2_cv __attribute__((ext_vector_type(2)));
__device__ __forceinline__ unsigned cvt_pk_bf16(float lo, float hi) { const f32x2_cv v = {lo, hi}; const bf16x2_cv b = __builtin_convertvector(v, bf16x2_cv); return __builtin_bit_cast(unsigned, b); }

template <class Epi, class Sched, bool ALIGN_EPI = false, bool SP2 = false>
__device__ __forceinline__ void gemm_phase(PG8_LAS unsigned char* lds, const int K, const Sched& S, const Epi& E) {
    int tid = threadIdx.x; asm volatile("" : "+v"(tid));
    const int wid = __builtin_amdgcn_readfirstlane(tid >> 6), lane = tid & 63, wr = wid >> 2, wc = wid & 3, fr = lane & 15, fq = lane >> 4;
    const int nt = K / BK;
    unsigned voffA[2], voffB[2];
#pragma unroll
    for (int i = 0; i < 2; ++i) { int R, C; stage_rc(tid * 16 + i * 8192, R, C); const int Rb = Epi::PERM ? ((R & ~31) + perm32(R & 31)) : R;
        voffA[i] = (unsigned)(R * K + C) * 2u; voffB[i] = (unsigned)(Rb * K + C) * 2u; }
    const size_t kstep = (size_t)(BK * 2);
    const size_t hstep = (size_t)HALF * K * 2;
    const unsigned ldsw = (unsigned)wid * 1024u;
    const int aoff = lds_byte(wr * 64 + fr, fq * 8), boff = lds_byte(wc * 32 + fr, fq * 8);
#define PG8_SA(b, h) (((b) * 2 + (h)) * HTB)
#define PG8_SB(b, h) ((4 + (b) * 2 + (h)) * HTB)
#define PG8_STAGE(bufoff, gbase, voff) do { _Pragma("unroll") for (int _i = 0; _i < 2; ++_i) \
        __builtin_amdgcn_global_load_lds((const unsigned*)((const char*)(gbase) + (voff)[_i]), (PG8_LAS unsigned*)(lds + (bufoff) + ldsw + _i * 8192), 16, 0, 0); } while (0)
#define PG8_LDA(dst, b, h) do { _Pragma("unroll") for (int m = 0; m < 4; ++m) _Pragma("unroll") for (int k = 0; k < 2; ++k) dst[m][k] = *(const PG8_LAS bf16x8*)(lds + PG8_SA(b, h) + aoff + m * 2048 + k * 1024); } while (0)
#define PG8_LDB(dst, b, h) do { _Pragma("unroll") for (int n = 0; n < 2; ++n) _Pragma("unroll") for (int k = 0; k < 2; ++k) dst[n][k] = *(const PG8_LAS bf16x8*)(lds + PG8_SB(b, h) + boff + n * 2048 + k * 1024); } while (0)
#define PG8_MMA(ai, bj, At, Bt) do { __builtin_amdgcn_s_setprio(1); _Pragma("unroll") for (int m = 0; m < 4; ++m) _Pragma("unroll") for (int n = 0; n < 2; ++n) _Pragma("unroll") for (int k = 0; k < 2; ++k) \
        acc[ai][bj][m][n] = __builtin_amdgcn_mfma_f32_16x16x32_bf16(Bt[n][k], At[m][k], acc[ai][bj][m][n], 0, 0, 0); __builtin_amdgcn_s_setprio(0); } while (0)
#define PG8_WAIT_V(n) asm volatile("s_waitcnt vmcnt(" #n ")" ::: "memory")
#define PG8_WAIT_L(n) asm volatile("s_waitcnt lgkmcnt(" #n ")" ::: "memory")
#define PG8_BAR __builtin_amdgcn_s_barrier()
#define PG8_SCHED __builtin_amdgcn_sched_barrier(0)
    Unit cur, nxt; int ui = 0;
    if (!S.next(0, cur)) return;
    f32x4 acc[2][2][4][2];
#pragma unroll
    for (int a = 0; a < 2; ++a)
#pragma unroll
        for (int b = 0; b < 2; ++b)
#pragma unroll
            for (int m = 0; m < 4; ++m)
#pragma unroll
                for (int n = 0; n < 2; ++n) acc[a][b][m][n] = (f32x4){0.f, 0.f, 0.f, 0.f};
    bf16x8 At[4][2], B0[2][2], B1[2][2];
    const char* cA = S.aptr(cur); const char* cB = S.bptr(cur);
    if constexpr (SP2) {
        PG8_STAGE(PG8_SB(0, 0), cB, voffB); PG8_STAGE(PG8_SB(0, 1), cB + hstep, voffB); PG8_STAGE(PG8_SA(0, 0), cA, voffA); PG8_STAGE(PG8_SA(0, 1), cA + hstep, voffA);
        if (wr == 1) PG8_BAR;
        PG8_WAIT_V(2); PG8_BAR;
        PG8_STAGE(PG8_SB(1, 0), cB + kstep, voffB); PG8_STAGE(PG8_SA(1, 0), cA + kstep, voffA); PG8_STAGE(PG8_SB(1, 1), cB + hstep + kstep, voffB);
        PG8_WAIT_V(6); PG8_BAR;
    } else {
        PG8_STAGE(PG8_SB(0, 0), cB, voffB); PG8_STAGE(PG8_SA(0, 0), cA, voffA); PG8_STAGE(PG8_SB(0, 1), cB + hstep, voffB); PG8_STAGE(PG8_SA(0, 1), cA + hstep, voffA);
        if (wr == 1) PG8_BAR;
        PG8_WAIT_V(4); PG8_BAR;
        PG8_STAGE(PG8_SB(1, 0), cB + kstep, voffB); PG8_STAGE(PG8_SA(1, 0), cA + kstep, voffA); PG8_STAGE(PG8_SB(1, 1), cB + hstep + kstep, voffB);
        PG8_WAIT_V(6); PG8_BAR;
    }
    for (;;) {
        const bool has_next = S.next(ui + 1, nxt);
        const char* nA = has_next ? S.aptr(nxt) : cA; const char* nB = has_next ? S.bptr(nxt) : cB;
        for (int t = 0; t < nt; t += 2) {
            const bool last = (t == nt - 2);
            const char* a1 = cA + (size_t)(t + 1) * kstep;
            const char* a2 = last ? nA : cA + (size_t)(t + 2) * kstep; const char* b2 = last ? nB : cB + (size_t)(t + 2) * kstep;
            const char* a3 = a2 + kstep; const char* b3 = b2 + kstep;
            if constexpr (SP2) {
            PG8_LDB(B0, 0, 0); PG8_LDB(B1, 0, 1); PG8_SCHED; PG8_LDA(At, 0, 0); PG8_STAGE(PG8_SA(1, 1), a1 + hstep, voffA);
            PG8_WAIT_V(8); PG8_WAIT_L(0); PG8_BAR; PG8_MMA(0, 0, At, B0); PG8_MMA(0, 1, At, B1); PG8_BAR; PG8_SCHED;
            PG8_LDA(At, 0, 1); PG8_STAGE(PG8_SB(0, 0), b2, voffB); PG8_STAGE(PG8_SB(0, 1), b2 + hstep, voffB); PG8_STAGE(PG8_SA(0, 0), a2, voffA);
            PG8_WAIT_V(8); PG8_WAIT_L(0); PG8_BAR; PG8_MMA(1, 0, At, B0); PG8_MMA(1, 1, At, B1); PG8_BAR; PG8_SCHED;
            PG8_LDB(B0, 1, 0); PG8_LDB(B1, 1, 1); PG8_SCHED; PG8_LDA(At, 1, 0); PG8_STAGE(PG8_SA(0, 1), a2 + hstep, voffA);
            PG8_WAIT_V(8); PG8_WAIT_L(0); PG8_BAR; PG8_MMA(0, 0, At, B0); PG8_MMA(0, 1, At, B1); PG8_BAR; PG8_SCHED;
            PG8_LDA(At, 1, 1); PG8_STAGE(PG8_SB(1, 0), b3, voffB); PG8_STAGE(PG8_SB(1, 1), b3 + hstep, voffB); PG8_STAGE(PG8_SA(1, 0), a3, voffA);
            PG8_WAIT_V(8); PG8_WAIT_L(0); PG8_BAR; PG8_MMA(1, 0, At, B0); PG8_MMA(1, 1, At, B1); PG8_BAR; PG8_SCHED;
            } else {
            PG8_LDB(B0, 0, 0); PG8_SCHED; PG8_LDA(At, 0, 0); PG8_STAGE(PG8_SA(1, 1), a1 + hstep, voffA);
            PG8_WAIT_L(8); PG8_BAR; PG8_WAIT_L(0); PG8_MMA(0, 0, At, B0); PG8_BAR; PG8_SCHED;
            PG8_LDB(B1, 0, 1); PG8_STAGE(PG8_SB(0, 0), b2, voffB);
            PG8_BAR; PG8_WAIT_L(0); PG8_MMA(0, 1, At, B1); PG8_BAR;
            PG8_LDA(At, 0, 1); PG8_STAGE(PG8_SA(0, 0), a2, voffA);
            PG8_BAR; PG8_WAIT_L(0); PG8_MMA(1, 0, At, B0); PG8_BAR; PG8_SCHED;
            PG8_STAGE(PG8_SB(0, 1), b2 + hstep, voffB);
            PG8_WAIT_V(6); PG8_BAR; PG8_MMA(1, 1, At, B1); PG8_BAR;
            PG8_LDB(B0, 1, 0); PG8_SCHED; PG8_LDA(At, 1, 0); PG8_STAGE(PG8_SA(0, 1), a2 + hstep, voffA);
            PG8_WAIT_L(8); PG8_BAR; PG8_WAIT_L(0); PG8_MMA(0, 0, At, B0); PG8_BAR; PG8_SCHED;
            PG8_LDB(B1, 1, 1); PG8_STAGE(PG8_SB(1, 0), b3, voffB);
            PG8_BAR; PG8_WAIT_L(0); PG8_MMA(0, 1, At, B1); PG8_BAR;
            PG8_LDA(At, 1, 1); PG8_STAGE(PG8_SA(1, 0), a3, voffA);
            PG8_BAR; PG8_WAIT_L(0); PG8_MMA(1, 0, At, B0); PG8_BAR; PG8_SCHED;
            PG8_STAGE(PG8_SB(1, 1), b3 + hstep, voffB);
            PG8_WAIT_V(6); PG8_BAR; PG8_MMA(1, 1, At, B1); PG8_BAR;
            }
        }
        if constexpr (ALIGN_EPI) { if (wr == 0) PG8_BAR; }
        if constexpr (!Epi::AFTER_DRAIN) { E(acc, cur, wr, wc, fr, fq); }
        if (!has_next) break;
        if (!E.keep(cur)) {
#pragma unroll
        for (int a = 0; a < 2; ++a)
#pragma unroll
            for (int b = 0; b < 2; ++b)
#pragma unroll
                for (int m = 0; m < 4; ++m)
#pragma unroll
                    for (int n = 0; n < 2; ++n) acc[a][b][m][n] = (f32x4){0.f, 0.f, 0.f, 0.f};
        }
        cur = nxt; cA = nA; cB = nB; ++ui;
        if constexpr (ALIGN_EPI) { if (wr == 1) PG8_BAR; }
    }
    PG8_WAIT_V(0);
    if constexpr (!ALIGN_EPI) { if (wr == 0) PG8_BAR; }
    PG8_BAR;
    if constexpr (Epi::AFTER_DRAIN) { E.fused(acc, cur, wr, wc, fr, fq, lds, wid, lane); }
#undef PG8_SA
#undef PG8_SB
#undef PG8_STAGE
#undef PG8_LDA
#undef PG8_LDB
#undef PG8_MMA
#undef PG8_WAIT_V
#undef PG8_WAIT_L
#undef PG8_BAR
#undef PG8_SCHED
}
}


constexpr int NWAVES = 8;
constexpr int DM = 1024, NB = 4, SEQ = 4096, CTXL = 256, TK = SEQ + CTXL;
constexpr int MLAT = NB * SEQ, MCTX = NB * CTXL, MALL = MLAT + MCTX;
constexpr int INW = 5024, NIN = 5120;
constexpr int NH = 8;
constexpr float EPS = 1e-6f;
constexpr float LOG2E = 1.4426950408889634f;
constexpr float MLA_C2 = 0.10206207261596577f * LOG2E;
constexpr float NA_C2 = 0.125f * LOG2E;

constexpr size_t MiB = 1u << 20;
constexpr size_t WS_CTL = 0, CTL_ZERO_BYTES = 64 * 1024;
constexpr size_t WS_WIN = 2 * MiB;
constexpr size_t WS_WUQ = 12 * MiB;
constexpr size_t WS_WUKV = 12 * MiB + 512 * 1024;
constexpr size_t WS_WOA = 13 * MiB, WS_WOB = 14 * MiB, WS_WOUT = 15 * MiB;
constexpr size_t WS_MOD = 17 * MiB;
constexpr size_t WS_ROPE = 17 * MiB + 256 * 1024;
constexpr size_t WS_SSQQ = 17 * MiB + 512 * 1024;
constexpr size_t WS_SSQKV = 18 * MiB;
constexpr size_t WS_SSQO = 18 * MiB + 512 * 1024;
constexpr size_t WS_H = 20 * MiB;
constexpr size_t WS_QA = 20 * MiB;
constexpr size_t WS_T0 = 54 * MiB;
constexpr size_t WS_CQ = 63 * MiB;
constexpr size_t WS_KB = 71 * MiB;
constexpr size_t WS_VBT = 88 * MiB;
constexpr size_t WS_M = 71 * MiB;
constexpr size_t WS_QB = 105 * MiB;
constexpr size_t WS_SZA = 121 * MiB;
constexpr size_t WS_SZB = 137 * MiB;
constexpr size_t WS_SGA = 153 * MiB;
constexpr size_t WS_SGB = 185 * MiB;
constexpr size_t WS_END = 217 * MiB;
constexpr size_t DO_KA = 0, DO_VAT = 26 * MiB;
constexpr int CW_BAR = 1024;

constexpr int RING_BYTES = 131072, MISC_OFF = RING_BYTES + 320, LDS_BYTES = 147456;

#define GAS __attribute__((address_space(1)))
#define LAS __attribute__((address_space(3)))
typedef unsigned short bf16;
typedef unsigned v4u __attribute__((ext_vector_type(4)));
typedef unsigned v2u __attribute__((ext_vector_type(2)));
typedef float f32x4 __attribute__((ext_vector_type(4)));
typedef float f32x16 __attribute__((ext_vector_type(16)));
typedef short bf16x8 __attribute__((ext_vector_type(8)));
typedef short s16x4 __attribute__((ext_vector_type(4)));
__device__ __forceinline__ unsigned f2bf(float f) { unsigned u = __builtin_bit_cast(unsigned, f); return (u + 0x7fffu + ((u >> 16) & 1u)) >> 16; }
__device__ __forceinline__ unsigned pk2(float lo, float hi) { return f2bf(lo) | (f2bf(hi) << 16); }
__device__ __forceinline__ float bf_lo(unsigned w) { return __builtin_bit_cast(float, w << 16); }
__device__ __forceinline__ float bf_hi(unsigned w) { return __builtin_bit_cast(float, w & 0xffff0000u); }
__device__ __forceinline__ float fast_rcp(float x) { return __builtin_amdgcn_rcpf(x); }
__device__ __forceinline__ float sigmoidf_(float x) { return fast_rcp(1.f + __builtin_amdgcn_exp2f(-x * LOG2E)); }
__device__ __forceinline__ float siluf_(float x) { return x * sigmoidf_(x); }
#define XB_TMO      128
#define XB_XCNT(j)  (256  + 64 * (j))
#define XB_XSUB(j)  (1280 + 64 * (j))
#define XB_XGEN(j)  (2304 + 64 * (j))
#define XB_TOP      3328
#define XB_TOPGEN   3392
#define XCD_BAR_WORDS 3456
#define XB_SPIN_CAP (1u << 18)

__device__ __forceinline__ unsigned xb_ld(unsigned* p)              { return __hip_atomic_load(p, __ATOMIC_RELAXED, __HIP_MEMORY_SCOPE_AGENT); }
__device__ __forceinline__ unsigned xb_add(unsigned* p, unsigned v) { return __hip_atomic_fetch_add(p, v, __ATOMIC_RELAXED, __HIP_MEMORY_SCOPE_AGENT); }
__device__ __forceinline__ unsigned xb_xcc_id() { return (unsigned)__builtin_amdgcn_s_getreg((3 << 11) | 20) & 0xFu; }
#define XB_SPIN(cond, bar) do { unsigned _sp = 0; while (cond) { __builtin_amdgcn_s_sleep(1); \
    if ((++_sp & 255u) == 0u) { if (xb_ld(&(bar)[XB_TMO])) break; if (_sp > XB_SPIN_CAP) { atomicAdd(&(bar)[XB_TMO], 1u); break; } } } } while (0)

struct XcdBarrier {
    unsigned* bar; unsigned x;
    volatile LAS unsigned* st;
};

__device__ __forceinline__ XcdBarrier xcd_barrier_post(unsigned* bar, volatile LAS unsigned* st) {
    XcdBarrier b; b.bar = bar; b.x = xb_xcc_id(); b.st = st;
    if (threadIdx.x == 0) (void)xb_add(&bar[XB_XCNT(b.x)], 1u);
    return b;
}
__device__ __forceinline__ void xcd_barrier_complete(unsigned* bar, unsigned x, unsigned& nloc, unsigned& nx) {
    const unsigned G = gridDim.x * gridDim.y * gridDim.z;
    unsigned sum, cnt, mine, sp = 0u;
    for (;;) {
        sum = 0u; cnt = 0u; mine = 0u;
#pragma unroll
        for (unsigned j = 0; j < 16; ++j) { const unsigned c = xb_ld(&bar[XB_XCNT(j)]); sum += c; cnt += (c > 0u) ? 1u : 0u; mine = (j == x) ? c : mine; }
        if (sum == G) break;
        __builtin_amdgcn_s_sleep(1);
        if ((++sp & 255u) == 0u) { if (xb_ld(&bar[XB_TMO])) break; if (sp > XB_SPIN_CAP) { atomicAdd(&bar[XB_TMO], 1u); break; } }
    }
    nloc = mine > 0u ? mine : 1u; nx = cnt > 0u ? cnt : 1u;
}

__device__ __forceinline__ void xcd_barrier(const XcdBarrier& b) {
    asm volatile("s_waitcnt vmcnt(0)" ::: "memory");
    __syncthreads();
    if (threadIdx.x == 0) {
        unsigned* bar = b.bar;
        __builtin_amdgcn_s_waitcnt(0);
        unsigned nloc = b.st[0], nx = b.st[1];
        if (nloc == 0u) { xcd_barrier_complete(bar, b.x, nloc, nx); b.st[0] = nloc; b.st[1] = nx; }
        const unsigned old = xb_add(&bar[XB_XSUB(b.x)], 1u);
        const unsigned gen = old / nloc;
        if (old + 1u == (gen + 1u) * nloc) {
            __builtin_amdgcn_fence(__ATOMIC_RELEASE, "agent");
            asm volatile("s_waitcnt vmcnt(0)" ::: "memory");
            const unsigned og = xb_add(&bar[XB_TOP], 1u);
            const unsigned tg = og / nx;
            if (og + 1u == (tg + 1u) * nx) xb_add(&bar[XB_TOPGEN], 1u);
            else XB_SPIN(xb_ld(&bar[XB_TOPGEN]) == tg, bar);
            __builtin_amdgcn_fence(__ATOMIC_ACQUIRE, "agent");
            xb_add(&bar[XB_XGEN(b.x)], 1u);
            asm volatile("s_waitcnt vmcnt(0)" ::: "memory");
        } else {
            XB_SPIN(xb_ld(&bar[XB_XGEN(b.x)]) == gen, bar);
            __builtin_amdgcn_fence(__ATOMIC_ACQUIRE, "agent");
            asm volatile("s_waitcnt vmcnt(0)" ::: "memory");
        }
    }
    __syncthreads();
}

#define LDS_WAIT() asm volatile("s_waitcnt lgkmcnt(0)" ::: "memory")
#define VM_WAIT() asm volatile("s_waitcnt vmcnt(0)" ::: "memory")
__device__ __forceinline__ float wave_sum(float v) {
#pragma unroll
    for (int o = 1; o < 64; o <<= 1) v += __shfl_xor(v, o);
    return v;
}
__device__ __forceinline__ void tile_remap(int L, int nM, int nN, int& pm, int& pn) {
    const int nwg = nM * nN; int wgid = L;
    { const int q = nwg / 8, r = nwg % 8, xcd = wgid % 8, off = wgid / 8; wgid = (xcd < r ? xcd * (q + 1) : r * (q + 1) + (xcd - r) * q) + off; }
    const int nig = 8 * nN, gid = wgid / nig, fm = gid * 8, gsz = (nM - fm) < 8 ? (nM - fm) : 8;
    pm = fm + ((wgid % nig) % gsz); pn = (wgid % nig) / gsz;
}
__device__ __forceinline__ void row_bt(int row, int& b, int& t) {
    if (row < MLAT) { b = row >> 12; t = row & 4095; } else { const int r = row - MLAT; b = r >> 8; t = SEQ + (r & 255); }
}

__device__ __forceinline__ void transpose_item(const float* W, int ldw, int k0, int n0, bf16* WT, int KD, int drow0, const float* g, LAS float* scr, int lane) {
    f32x4 wv[8];
#pragma unroll
    for (int i = 0; i < 8; ++i) wv[i] = *(const f32x4*)(W + (size_t)(k0 + 8 * i + (lane >> 3)) * ldw + n0 + 4 * (lane & 7));
#pragma unroll
    for (int i = 0; i < 8; ++i) { const int kk = 8 * i + (lane >> 3); f32x4 v = wv[i]; if (g) v = v * g[k0 + kk];
        LAS float* d = scr + kk * 33 + 4 * (lane & 7); d[0] = v[0]; d[1] = v[1]; d[2] = v[2]; d[3] = v[3]; }
    LDS_WAIT(); asm volatile("" ::: "memory");
    const int c = lane & 7;
#pragma unroll
    for (int j = 0; j < 4; ++j) { const int n = (lane >> 3) + 8 * j; const LAS float* s = scr + (8 * c) * 33 + n;
        v4u o; o.x = pk2(s[0 * 33], s[1 * 33]); o.y = pk2(s[2 * 33], s[3 * 33]); o.z = pk2(s[4 * 33], s[5 * 33]); o.w = pk2(s[6 * 33], s[7 * 33]);
        *(v4u*)(WT + (size_t)(drow0 + n) * KD + k0 + 8 * c) = o; }
    LDS_WAIT(); asm volatile("" ::: "memory");
}

struct Ptrs {
    const float *x, *c, *ctx, *c_ctx, *w_mod, *b_mod, *norm_g, *w_in, *g_cq, *w_uq, *g_ckv, *w_ukv, *rpb, *w_oa, *w_ob, *w_out, *final_g;
    float* out; unsigned char* ws;
};

__device__ __forceinline__ void p0_weights(const Ptrs& P, LAS unsigned char* lds, int tid, int lane, int wave, int G) {
    LAS float* scr = (LAS float*)(lds + wave * 16384);
    const int gw = blockIdx.x * NWAVES + wave, NGW = G * NWAVES;
    unsigned char* ws = P.ws;
    constexpr int I_IN = 16 * 157, I_UQ = 4 * 24, I_UKV = 2 * 32, I_OA = 8 * 32, I_OUT = 16 * 32;
    constexpr int NITEMS = I_IN + I_UQ + I_UKV + 2 * I_OA + I_OUT;
    for (int it = gw; it < NITEMS; it += NGW) {
        int r = it;
        if (r < I_IN) { const int kb = r / 157, nb = r % 157, n0 = 32 * nb; transpose_item(P.w_in, INW, 64 * kb, n0, (bf16*)(ws + WS_WIN), 1024, n0 + (n0 >= 160 ? 96 : 0), nullptr, scr, lane); continue; } r -= I_IN;
        if (r < I_UQ) { const int kb = r / 24, nb = r % 24, h = nb / 3, j = nb % 3; transpose_item(P.w_uq, 768, 64 * kb, 32 * nb, (bf16*)(ws + WS_WUQ), 256, j < 2 ? h * 64 + 32 * j : 512 + 32 * h, P.g_cq, scr, lane); continue; } r -= I_UQ;
        if (r < I_UKV) { const int kb = r / 32, nb = r % 32, h = nb / 4, j = nb % 4; transpose_item(P.w_ukv, 1024, 64 * kb, 32 * nb, (bf16*)(ws + WS_WUKV), 256, j < 2 ? h * 64 + 32 * j : 512 + h * 64 + 32 * (j - 2), P.g_ckv, scr, lane); continue; } r -= I_UKV;
        if (r < I_OA) { const int kb = r / 32, nb = r % 32; transpose_item(P.w_oa, 1024, 64 * kb, 32 * nb, (bf16*)(ws + WS_WOA), 512, 32 * nb, nullptr, scr, lane); continue; } r -= I_OA;
        if (r < I_OA) { const int kb = r / 32, nb = r % 32; transpose_item(P.w_ob, 1024, 64 * kb, 32 * nb, (bf16*)(ws + WS_WOB), 512, 32 * nb, nullptr, scr, lane); continue; } r -= I_OA;
        { const int kb = r / 32, nb = r % 32; transpose_item(P.w_out, 1024, 64 * kb, 32 * nb, (bf16*)(ws + WS_WOUT), 1024, 32 * nb, nullptr, scr, lane); }
    }
    { const int gt = blockIdx.x * (NWAVES * 64) + tid, NT = G * NWAVES * 64; const v4u z = {0u, 0u, 0u, 0u};
      for (int ch = gt; ch < 12288; ch += NT) *(v4u*)(ws + WS_WIN + (size_t)160 * 2048 + (size_t)ch * 16) = z;
      for (int ch = gt; ch < 16384; ch += NT) *(v4u*)(ws + WS_WUKV + (size_t)(ch >> 4) * 512 + 256 + (ch & 15) * 16) = z; }
    if (blockIdx.x == 0) {
        const int p = tid >> 3, i = tid & 7;
        const float fr = (i == 0) ? 1.0f : (i == 1) ? 0.31622776601683794f : (i == 2) ? 0.1f : (i == 3) ? 0.031622776601683794f : (i == 4) ? 0.01f : (i == 5) ? 0.0031622776601683794f : (i == 6) ? 0.001f : 0.00031622776601683794f;
        const float ang = (float)p * fr;
        float2 cs; cs.x = cosf(ang); cs.y = sinf(ang);
        ((float2*)(ws + WS_ROPE))[tid] = cs;
    }
}
__device__ __forceinline__ void p0_gemv(const Ptrs& P, LAS unsigned char* lds, int tid, int lane, int wave, int G) {
    unsigned char* ws = P.ws;
    __syncthreads();
    LAS float* red = (LAS float*)(lds + 7 * 16384 + 12288);
    for (int cgp = blockIdx.x; cgp < 256; cgp += G) {
        const int c0 = 12 * cgp;
        float acc[5][12];
#pragma unroll
        for (int b = 0; b < 5; ++b)
#pragma unroll
            for (int j = 0; j < 12; ++j) acc[b][j] = 0.f;
#pragma unroll
        for (int h = 0; h < 2; ++h) {
            const int kk = tid + 512 * h;
            float s[5];
#pragma unroll
            for (int b = 0; b < 4; ++b) s[b] = siluf_(P.c[b * 1024 + kk]);
            s[4] = siluf_(P.c_ctx[kk]);
            const f32x4* wp = (const f32x4*)(P.w_mod + (size_t)kk * 3072 + c0);
            const f32x4 w0 = wp[0], w1 = wp[1], w2 = wp[2];
            const float w[12] = {w0[0], w0[1], w0[2], w0[3], w1[0], w1[1], w1[2], w1[3], w2[0], w2[1], w2[2], w2[3]};
#pragma unroll
            for (int b = 0; b < 5; ++b)
#pragma unroll
                for (int j = 0; j < 12; ++j) acc[b][j] += s[b] * w[j];
        }
#pragma unroll
        for (int b = 0; b < 5; ++b)
#pragma unroll
            for (int j = 0; j < 12; ++j) { const float v = wave_sum(acc[b][j]); if (lane == 0) red[wave * 60 + b * 12 + j] = v; }
        __syncthreads();
        if (tid < 60) { float v = 0.f;
#pragma unroll
            for (int w8 = 0; w8 < 8; ++w8) v += red[w8 * 60 + tid];
            const int b = tid / 12, j = tid % 12;
            ((float*)(ws + WS_MOD))[b * 3072 + c0 + j] = v + P.b_mod[c0 + j]; }
        __syncthreads();
    }
}

__device__ __forceinline__ void p1_hconv(const Ptrs& P, int lane, int wave, int G) {
    const int gw = blockIdx.x * NWAVES + wave, NGW = G * NWAVES;
    const float* MOD = (const float*)(P.ws + WS_MOD);
    bf16* H = (bf16*)(P.ws + WS_H);
    for (int row = gw; row < MALL; row += NGW) {
        const float* xr = row < MLAT ? P.x + (size_t)row * DM : P.ctx + (size_t)(row - MLAT) * DM;
        const int mb = row < MLAT ? (row >> 12) : 4;
        const f32x4* x4 = (const f32x4*)xr + lane;
        f32x4 v[4]; float s = 0.f;
#pragma unroll
        for (int j = 0; j < 4; ++j) { v[j] = x4[64 * j]; s += (v[j][0] * v[j][0] + v[j][1] * v[j][1]) + (v[j][2] * v[j][2] + v[j][3] * v[j][3]); }
        const float rstd = 1.0f / sqrtf(wave_sum(s) * (1.f / DM) + EPS);
        const f32x4* g4 = (const f32x4*)P.norm_g + lane;
        const f32x4* sh4 = (const f32x4*)(MOD + mb * 3072) + lane;
        const f32x4* sc4 = (const f32x4*)(MOD + mb * 3072 + 1024) + lane;
        unsigned long long* o8 = (unsigned long long*)(H + (size_t)row * DM) + lane;
#pragma unroll
        for (int j = 0; j < 4; ++j) {
            const f32x4 g = g4[64 * j], sh = sh4[64 * j], sc = sc4[64 * j];
            f32x4 h;
#pragma unroll
            for (int e = 0; e < 4; ++e) h[e] = (v[j][e] * rstd * g[e]) * (1.f + sc[e]) + sh[e];
            o8[64 * j] = (unsigned long long)pk2(h[0], h[1]) | ((unsigned long long)pk2(h[2], h[3]) << 32);
        }
    }
}

using pg8::Unit;
using pg8::cvt_pk_bf16;
__device__ __forceinline__ v4u pack8(const f32x4& a, const f32x4& b) { v4u w; w.x = cvt_pk_bf16(a[0], a[1]); w.y = cvt_pk_bf16(a[2], a[3]); w.z = cvt_pk_bf16(b[0], b[1]); w.w = cvt_pk_bf16(b[2], b[3]); return w; }

__device__ __forceinline__ void rope8(float (&v)[8], int fq, int t, const float2* tab) {
    const int pos = (fq < 2) ? (t >> 6) : (t & 63);
    const float sgn = (fq & 1) ? 1.f : -1.f;
#pragma unroll
    for (int i = 0; i < 8; ++i) { const float pv = __shfl_xor(v[i], 16); const float2 cs = tab[pos * 8 + i]; v[i] = v[i] * cs.x + sgn * pv * cs.y; }
}

struct SchedG1 {
    int G, c; const char* H; const char* W;
    static constexpr size_t TS = (size_t)256 * 1024 * 2;
    __device__ __forceinline__ bool next(int i, Unit& u) const {
        const int L = i * G + c; if (L >= 1280) return false;
        int pm, pn;
        tile_remap(L, 64, 20, pm, pn);
        if (pn == 3 || pn == 4) { u.kind = 1; u.ta = pn; u.tb = pm; } else { u.kind = 0; u.ta = pm; u.tb = pn; }
        return true;
    }
    __device__ __forceinline__ const char* aptr(const Unit& u) const { return (u.kind == 1 ? W : H) + (size_t)u.ta * TS; }
    __device__ __forceinline__ const char* bptr(const Unit& u) const { return (u.kind == 1 ? H : W) + (size_t)u.tb * TS; }
};
struct SchedG1C {
    int nC, c; const char* H; const char* W;
    static constexpr size_t TS = (size_t)256 * 1024 * 2;
    __device__ __forceinline__ bool next(int i, Unit& u) const {
        if (c >= nC) return false;
        const int k = i * nC + c; if (k >= 20) return false;
        const int pm = 64 + k / 5, pn = k % 5;
        if (pn == 3 || pn == 4) { u.kind = 1; u.ta = pn; u.tb = pm; } else { u.kind = 0; u.ta = pm; u.tb = pn; }
        return true;
    }
    __device__ __forceinline__ const char* aptr(const Unit& u) const { return (u.kind == 1 ? W : H) + (size_t)u.ta * TS; }
    __device__ __forceinline__ const char* bptr(const Unit& u) const { return (u.kind == 1 ? H : W) + (size_t)u.tb * TS; }
};
struct EpiG1 {
    static constexpr bool PERM = true, AFTER_DRAIN = false;
    __device__ __forceinline__ bool keep(const Unit&) const { return false; }
    unsigned char* ws; unsigned char* dout;
    __device__ __forceinline__ void operator()(const f32x4 (&acc)[2][2][4][2], const Unit& u, int wr, int wc, int fr, int fq) const {
        using pg8::HALF;
        if (u.kind == 1) {
            bf16* VBT = (bf16*)(ws + WS_VBT);
#pragma unroll
            for (int bj = 0; bj < 2; ++bj) {
                int b, t; row_bt(256 * u.tb + HALF * bj + 32 * wc + 8 * fq, b, t);
#pragma unroll
                for (int ai = 0; ai < 2; ++ai)
#pragma unroll
                    for (int m = 0; m < 4; ++m) { const int vc = 256 * (u.ta - 3) + HALF * ai + 64 * wr + 16 * m + fr, h = vc >> 6, dv = vc & 63;
                        *(v4u*)(VBT + ((size_t)((b * NH + h) * 64 + dv)) * TK + t) = pack8(acc[ai][bj][m][0], acc[ai][bj][m][1]); }
            }
            return;
        }
        const int pn = u.tb;
        const float2* tab = (const float2*)(ws + WS_ROPE);
#pragma unroll
        for (int ai = 0; ai < 2; ++ai)
#pragma unroll
            for (int m = 0; m < 4; ++m) {
                const int row = 256 * u.ta + HALF * ai + 64 * wr + 16 * m + fr; int b, t; row_bt(row, b, t);
                float qq = 0.f;
#pragma unroll
                for (int bj = 0; bj < 2; ++bj) {
                    const int col = HALF * bj + 32 * wc + 8 * fq;
                    const f32x4 v0 = acc[ai][bj][m][0], v1 = acc[ai][bj][m][1];
                    if (pn == 0) {
                        *(v4u*)((bf16*)(ws + WS_T0) + (size_t)row * 256 + col) = pack8(v0, v1);
                        if (bj == 0) { float q = (v0[0] * v0[0] + v0[1] * v0[1]) + (v0[2] * v0[2] + v0[3] * v0[3]) + (v1[0] * v1[0] + v1[1] * v1[1]) + (v1[2] * v1[2] + v1[3] * v1[3]);
                            q += __shfl_xor(q, 16); q += __shfl_xor(q, 32); if (fq == 0) ((float*)(ws + WS_SSQKV))[row * 4 + wc] = q; }
                        else if (wc == 0) {
                            float v[8] = {v0[0], v0[1], v0[2], v0[3], v1[0], v1[1], v1[2], v1[3]};
                            if (u.ta < 64) rope8(v, fq, t, tab);
                            v4u w; w.x = cvt_pk_bf16(v[0], v[1]); w.y = cvt_pk_bf16(v[2], v[3]); w.z = cvt_pk_bf16(v[4], v[5]); w.w = cvt_pk_bf16(v[6], v[7]);
                            bf16* KA = (bf16*)(dout + DO_KA);
#pragma unroll
                            for (int h = 0; h < NH; ++h) *(v4u*)(KA + ((size_t)(b * NH + h) * TK + t) * 96 + 64 + 8 * fq) = w;
                        }
                    } else if (pn <= 2) {
                        const int kc = 256 * (pn - 1) + col, h = kc >> 6, d = kc & 63;
                        *(v4u*)((bf16*)(ws + WS_KB) + ((size_t)(b * NH + h) * TK + t) * 64 + d) = pack8(v0, v1);
                    } else if (pn == 5) {
                        *(v4u*)((bf16*)(ws + WS_CQ) + (size_t)row * 256 + col) = pack8(v0, v1);
                        qq += (v0[0] * v0[0] + v0[1] * v0[1]) + (v0[2] * v0[2] + v0[3] * v0[3]) + (v1[0] * v1[0] + v1[1] * v1[1]) + (v1[2] * v1[2] + v1[3] * v1[3]);
                    } else if (pn <= 7 || (pn >= 10 && pn <= 11)) {
                        bf16* dst = (bf16*)(ws + (pn <= 7 ? WS_SZA : WS_SZB)) + (size_t)row * 512 + 256 * (pn <= 7 ? pn - 6 : pn - 10) + col;
                        f32x4 a, c2;
#pragma unroll
                        for (int e = 0; e < 4; ++e) { a[e] = siluf_(v0[e]); c2[e] = siluf_(v1[e]); }
                        *(v4u*)dst = pack8(a, c2);
                    } else if (pn <= 9) {
                        const int qc = 256 * (pn - 8) + col, h = qc >> 6, d = qc & 63;
                        *(v4u*)((bf16*)(ws + WS_QB) + ((size_t)(b * NH + h) * SEQ + t) * 64 + d) = pack8(v0 * NA_C2, v1 * NA_C2);
                    } else {
                        bf16* dst = (bf16*)(ws + (pn <= 15 ? WS_SGA : WS_SGB)) + (size_t)row * 1024 + 256 * (pn <= 15 ? pn - 12 : pn - 16) + col;
                        f32x4 a, c2;
#pragma unroll
                        for (int e = 0; e < 4; ++e) { a[e] = fmaxf(sigmoidf_(v0[e]), 1e-18f); c2[e] = fmaxf(sigmoidf_(v1[e]), 1e-18f); }
                        *(v4u*)dst = pack8(a, c2);
                    }
                }
                if (pn == 5) { qq += __shfl_xor(qq, 16); qq += __shfl_xor(qq, 32); if (fq == 0) ((float*)(ws + WS_SSQQ))[row * 4 + wc] = qq; }
            }
    }
};

struct SchedG23 {
    int first, cnt, c; const char* wsb;
    static constexpr size_t TS = (size_t)256 * 256 * 2;
    __device__ __forceinline__ bool next(int i, Unit& u) const {
        if (c < first) return false;
        const int L = i * cnt + (c - first); if (L >= 448) return false;
        if (L < 192) { u.kind = 0; u.ta = L % 64; u.tb = L / 64; return true; }
        const int k = L - 192, pm = k % 64, pn = k / 64;
        if (pn < 2) { u.kind = 1; u.ta = pm; u.tb = pn; } else { u.kind = 2; u.ta = pn; u.tb = pm; }
        return true;
    }
    __device__ __forceinline__ const char* aptr(const Unit& u) const { const size_t o = (u.kind == 0) ? WS_CQ : (u.kind == 1) ? WS_T0 : WS_WUKV; return wsb + o + (size_t)u.ta * TS; }
    __device__ __forceinline__ const char* bptr(const Unit& u) const { const size_t o = (u.kind == 0) ? WS_WUQ : (u.kind == 1) ? WS_WUKV : WS_T0; return wsb + o + (size_t)u.tb * TS; }
};
struct EpiG23 {
    static constexpr bool PERM = true, AFTER_DRAIN = false;
    __device__ __forceinline__ bool keep(const Unit&) const { return false; }
    unsigned char* ws; unsigned char* dout;
    __device__ __forceinline__ void operator()(const f32x4 (&acc)[2][2][4][2], const Unit& u, int wr, int wc, int fr, int fq) const {
        using pg8::HALF;
        const float* SSQKV = (const float*)(ws + WS_SSQKV);
        if (u.kind == 2) {
            bf16* VAT = (bf16*)(dout + DO_VAT);
#pragma unroll
            for (int bj = 0; bj < 2; ++bj) {
                const int tok0 = 256 * u.tb + HALF * bj + 32 * wc + 8 * fq; int b, t; row_bt(tok0, b, t);
                float rs[8];
                { const f32x4 ss = *(const f32x4*)(SSQKV + (size_t)(tok0 + (fr & 7)) * 4); const float mine = 1.0f / sqrtf(((ss[0] + ss[1]) + (ss[2] + ss[3])) * (1.f / 128.f) + EPS);
#pragma unroll
                  for (int i = 0; i < 8; ++i) rs[i] = __shfl(mine, (fq << 4) + i); }
#pragma unroll
                for (int ai = 0; ai < 2; ++ai)
#pragma unroll
                    for (int m = 0; m < 4; ++m) { const int vc = 256 * (u.ta - 2) + HALF * ai + 64 * wr + 16 * m + fr, h = vc >> 6, dv = vc & 63;
                        f32x4 a = acc[ai][bj][m][0], c2 = acc[ai][bj][m][1];
#pragma unroll
                        for (int e = 0; e < 4; ++e) { a[e] *= rs[e]; c2[e] *= rs[4 + e]; }
                        *(v4u*)(VAT + ((size_t)((b * NH + h) * 64 + dv)) * TK + t) = pack8(a, c2); }
            }
            return;
        }
        const float2* tab = (const float2*)(ws + WS_ROPE);
#pragma unroll
        for (int ai = 0; ai < 2; ++ai)
#pragma unroll
            for (int m = 0; m < 4; ++m) {
                const int row = 256 * u.ta + HALF * ai + 64 * wr + 16 * m + fr; int b, t; row_bt(row, b, t);
                if (u.kind == 0) {
                    const f32x4 ss = *(const f32x4*)((const float*)(ws + WS_SSQQ) + (size_t)row * 4);
                    const float f = MLA_C2 / sqrtf(((ss[0] + ss[1]) + (ss[2] + ss[3])) * (1.f / 256.f) + EPS);
                    bf16* QA = (bf16*)(ws + WS_QA);
#pragma unroll
                    for (int bj = 0; bj < 2; ++bj) {
                        const f32x4 v0 = acc[ai][bj][m][0] * f, v1 = acc[ai][bj][m][1] * f;
                        if (u.tb < 2) { const int qc = 256 * u.tb + HALF * bj + 32 * wc + 8 * fq, h = qc >> 6, d = qc & 63;
                            *(v4u*)(QA + ((size_t)(b * NH + h) * SEQ + t) * 96 + d) = pack8(v0, v1);
                        } else { const int h = 4 * bj + wc;
                            float v[8] = {v0[0], v0[1], v0[2], v0[3], v1[0], v1[1], v1[2], v1[3]};
                            rope8(v, fq, t, tab);
                            v4u w; w.x = cvt_pk_bf16(v[0], v[1]); w.y = cvt_pk_bf16(v[2], v[3]); w.z = cvt_pk_bf16(v[4], v[5]); w.w = cvt_pk_bf16(v[6], v[7]);
                            *(v4u*)(QA + ((size_t)(b * NH + h) * SEQ + t) * 96 + 64 + 8 * fq) = w; }
                    }
                } else {
                    const f32x4 ss = *(const f32x4*)(SSQKV + (size_t)row * 4);
                    const float f = 1.0f / sqrtf(((ss[0] + ss[1]) + (ss[2] + ss[3])) * (1.f / 128.f) + EPS);
                    bf16* KA = (bf16*)(dout + DO_KA);
#pragma unroll
                    for (int bj = 0; bj < 2; ++bj) { const int kc = 256 * u.tb + HALF * bj + 32 * wc + 8 * fq, h = kc >> 6, d = kc & 63;
                        *(v4u*)(KA + ((size_t)(b * NH + h) * TK + t) * 96 + d) = pack8(acc[ai][bj][m][0] * f, acc[ai][bj][m][1] * f); }
                }
            }
    }
};

struct SchedG23C {
    int nC, c; const char* wsb;
    static constexpr size_t TS = (size_t)256 * 256 * 2;
    __device__ __forceinline__ bool next(int i, Unit& u) const {
        if (c >= nC) return false;
        const int k = i * nC + c; if (k >= 16) return false;
        if (k < 8) { u.kind = 1; u.ta = 64 + (k >> 1); u.tb = k & 1; } else { const int kk = k - 8; u.kind = 2; u.ta = 2 + (kk >> 2); u.tb = 64 + (kk & 3); }
        return true;
    }
    __device__ __forceinline__ const char* aptr(const Unit& u) const { const size_t o = (u.kind == 1) ? WS_T0 : WS_WUKV; return wsb + o + (size_t)u.ta * TS; }
    __device__ __forceinline__ const char* bptr(const Unit& u) const { const size_t o = (u.kind == 1) ? WS_WUKV : WS_T0; return wsb + o + (size_t)u.tb * TS; }
};
struct SchedG4 {
    int G, c; const char* OA; const char* OB; const char* WOA; const char* WOB;
    static constexpr size_t TS = (size_t)256 * 512 * 2;
    __device__ __forceinline__ bool next(int j, Unit& u) const {
        const int tile = c + (j >> 1) * G; if (tile >= 256) return false;
        tile_remap(tile, 64, 4, u.ta, u.tb); u.kind = j & 1; return true;
    }
    __device__ __forceinline__ const char* aptr(const Unit& u) const { return (u.kind ? OB : OA) + (size_t)u.ta * TS; }
    __device__ __forceinline__ const char* bptr(const Unit& u) const { return (u.kind ? WOB : WOA) + (size_t)u.tb * TS; }
};
struct EpiG4 {
    static constexpr bool PERM = true, AFTER_DRAIN = false;
    unsigned char* ws; float* scratch;
    __device__ __forceinline__ bool keep(const Unit& u) const { return u.kind == 0; }
    __device__ __forceinline__ void operator()(f32x4 (&acc)[2][2][4][2], const Unit& u, int wr, int wc, int fr, int fq) const {
        using pg8::HALF;
        const bf16* SGA = (const bf16*)(ws + WS_SGA); const bf16* SGB = (const bf16*)(ws + WS_SGB);
        bf16* Mb = (bf16*)(ws + WS_M);
#pragma unroll
        for (int ai = 0; ai < 2; ++ai) {
            v4u ga[4][2], gb[4][2];
#pragma unroll
            for (int m = 0; m < 4; ++m)
#pragma unroll
                for (int bj = 0; bj < 2; ++bj) {
                    const size_t off = (size_t)(256 * u.ta + HALF * ai + 64 * wr + 16 * m + fr) * 1024 + 256 * u.tb + HALF * bj + 32 * wc + 8 * fq;
                    gb[m][bj] = *(const v4u*)(SGB + off);
                    if (u.kind == 0) ga[m][bj] = *(const v4u*)(SGA + off); else ga[m][bj] = (v4u){0u, 0u, 0u, 0u};
                }
#pragma unroll
            for (int m = 0; m < 4; ++m)
#pragma unroll
                for (int bj = 0; bj < 2; ++bj) {
                    const v4u A = ga[m][bj], B = gb[m][bj];
                    const float sb[8] = {bf_lo(B.x), bf_hi(B.x), bf_lo(B.y), bf_hi(B.y), bf_lo(B.z), bf_hi(B.z), bf_lo(B.w), bf_hi(B.w)};
                    f32x4 v0 = acc[ai][bj][m][0], v1 = acc[ai][bj][m][1];
                    if (u.kind == 0) {
                        const float sa[8] = {bf_lo(A.x), bf_hi(A.x), bf_lo(A.y), bf_hi(A.y), bf_lo(A.z), bf_hi(A.z), bf_lo(A.w), bf_hi(A.w)};
#pragma unroll
                        for (int e = 0; e < 4; ++e) { v0[e] *= sa[e] * fast_rcp(sb[e]); v1[e] *= sa[4 + e] * fast_rcp(sb[4 + e]); }
                        acc[ai][bj][m][0] = v0; acc[ai][bj][m][1] = v1;
                    } else {
                        const size_t off = (size_t)(256 * u.ta + HALF * ai + 64 * wr + 16 * m + fr) * 1024 + 256 * u.tb + HALF * bj + 32 * wc + 8 * fq;
#pragma unroll
                        for (int e = 0; e < 4; ++e) { v0[e] *= sb[e]; v1[e] *= sb[4 + e]; }
                        *(v4u*)(Mb + off) = pack8(v0, v1);
                    }
                }
        }
    }
};

struct SchedG5 {
    int G, c; const char* M; const char* W;
    static constexpr size_t TS = (size_t)256 * 1024 * 2;
    __device__ __forceinline__ bool next(int i, Unit& u) const { const int L = i * G + c; if (L >= 256) return false; tile_remap(L, 64, 4, u.ta, u.tb); u.kind = 0; return true; }
    __device__ __forceinline__ const char* aptr(const Unit& u) const { return M + (size_t)u.ta * TS; }
    __device__ __forceinline__ const char* bptr(const Unit& u) const { return W + (size_t)u.tb * TS; }
};
struct EpiG5 {
    static constexpr bool PERM = true, AFTER_DRAIN = false;
    __device__ __forceinline__ bool keep(const Unit&) const { return false; }
    unsigned char* ws; const float* x; float* out;
    __device__ __forceinline__ void operator()(const f32x4 (&acc)[2][2][4][2], const Unit& u, int wr, int wc, int fr, int fq) const {
        using pg8::HALF;
        const float* MOD = (const float*)(ws + WS_MOD) + ((256 * u.ta) >> 12) * 3072 + 2048;
        f32x4 gt[2][2];
#pragma unroll
        for (int bj = 0; bj < 2; ++bj) { const int col = 256 * u.tb + HALF * bj + 32 * wc + 8 * fq; gt[bj][0] = *(const f32x4*)(MOD + col); gt[bj][1] = *(const f32x4*)(MOD + col + 4); }
#pragma unroll
        for (int ai = 0; ai < 2; ++ai) {
            f32x4 xa[4][2][2];
#pragma unroll
            for (int m = 0; m < 4; ++m)
#pragma unroll
                for (int bj = 0; bj < 2; ++bj) {
                    const size_t off = (size_t)(256 * u.ta + HALF * ai + 64 * wr + 16 * m + fr) * 1024 + 256 * u.tb + HALF * bj + 32 * wc + 8 * fq;
                    xa[m][bj][0] = *(const f32x4*)(x + off); xa[m][bj][1] = *(const f32x4*)(x + off + 4);
                }
#pragma unroll
            for (int m = 0; m < 4; ++m) {
                const int row = 256 * u.ta + HALF * ai + 64 * wr + 16 * m + fr;
                float q = 0.f;
#pragma unroll
                for (int bj = 0; bj < 2; ++bj) {
                    const size_t off = (size_t)row * 1024 + 256 * u.tb + HALF * bj + 32 * wc + 8 * fq;
                    const f32x4 o0 = xa[m][bj][0] + gt[bj][0] * acc[ai][bj][m][0], o1 = xa[m][bj][1] + gt[bj][1] * acc[ai][bj][m][1];
                    *(f32x4*)(out + off) = o0; *(f32x4*)(out + off + 4) = o1;
                    q += (o0[0] * o0[0] + o0[1] * o0[1]) + (o0[2] * o0[2] + o0[3] * o0[3]) + (o1[0] * o1[0] + o1[1] * o1[1]) + (o1[2] * o1[2] + o1[3] * o1[3]);
                }
                q += __shfl_xor(q, 16); q += __shfl_xor(q, 32);
                if (fq == 0) ((float*)(ws + WS_SSQO))[(size_t)row * 16 + u.tb * 4 + wc] = q;
            }
        }
    }
};

constexpr int CW_PANEL = 8192;
struct EpiG5F {
    static constexpr bool PERM = true, AFTER_DRAIN = true;
    __device__ __forceinline__ bool keep(const Unit&) const { return false; }
    unsigned char* ws; const float* x; float* out; const float* final_g;
    __device__ __forceinline__ void operator()(const f32x4 (&)[2][2][4][2], const Unit&, int, int, int, int) const {}
    __device__ __forceinline__ void fused(f32x4 (&acc)[2][2][4][2], const Unit& u, int wr, int wc, int fr, int fq, LAS unsigned char* lds, int wid, int lane) const {
        using pg8::HALF;
        const float* MOD = (const float*)(ws + WS_MOD) + ((256 * u.ta) >> 12) * 3072 + 2048;
        LAS float* Pq = (LAS float*)lds;
        LAS float* Sr = (LAS float*)(lds + 4096);
        float* slots = (float*)(ws + WS_SSQO);
        unsigned* cnt = (unsigned*)(ws + WS_CTL) + CW_PANEL + 64 * u.ta;
        f32x4 gt[2][2];
#pragma unroll
        for (int bj = 0; bj < 2; ++bj) { const int col = 256 * u.tb + HALF * bj + 32 * wc + 8 * fq; gt[bj][0] = *(const f32x4*)(MOD + col); gt[bj][1] = *(const f32x4*)(MOD + col + 4); }
#pragma unroll
        for (int ai = 0; ai < 2; ++ai) {
            f32x4 xa[4][2][2];
#pragma unroll
            for (int m = 0; m < 4; ++m)
#pragma unroll
                for (int bj = 0; bj < 2; ++bj) {
                    const size_t off = (size_t)(256 * u.ta + HALF * ai + 64 * wr + 16 * m + fr) * 1024 + 256 * u.tb + HALF * bj + 32 * wc + 8 * fq;
                    xa[m][bj][0] = *(const f32x4*)(x + off); xa[m][bj][1] = *(const f32x4*)(x + off + 4);
                }
#pragma unroll
            for (int m = 0; m < 4; ++m) {
                float q = 0.f;
#pragma unroll
                for (int bj = 0; bj < 2; ++bj) {
                    const f32x4 o0 = xa[m][bj][0] + gt[bj][0] * acc[ai][bj][m][0], o1 = xa[m][bj][1] + gt[bj][1] * acc[ai][bj][m][1];
                    acc[ai][bj][m][0] = o0; acc[ai][bj][m][1] = o1;
                    q += (o0[0] * o0[0] + o0[1] * o0[1]) + (o0[2] * o0[2] + o0[3] * o0[3]) + (o1[0] * o1[0] + o1[1] * o1[1]) + (o1[2] * o1[2] + o1[3] * o1[3]);
                }
                q += __shfl_xor(q, 16); q += __shfl_xor(q, 32);
                if (fq == 0) Pq[(HALF * ai + 64 * wr + 16 * m + fr) * 4 + wc] = q;
            }
        }
        asm volatile("s_waitcnt lgkmcnt(0)" ::: "memory"); __builtin_amdgcn_s_barrier(); asm volatile("" ::: "memory");
        const int row = wid * 32 + (lane & 31);
        if (lane < 32) { const float t = (Pq[row * 4 + 0] + Pq[row * 4 + 1]) + (Pq[row * 4 + 2] + Pq[row * 4 + 3]);
            __hip_atomic_store(slots + (size_t)(256 * u.ta + row) * 16 + 4 * u.tb, t, __ATOMIC_RELAXED, __HIP_MEMORY_SCOPE_AGENT); }
        asm volatile("s_waitcnt vmcnt(0)" ::: "memory");
        if (lane == 0) __hip_atomic_fetch_add(cnt, 1u, __ATOMIC_RELAXED, __HIP_MEMORY_SCOPE_AGENT);
        if (wid == 0) {
            unsigned spins = 0;
            while ((unsigned)__builtin_amdgcn_readfirstlane(__hip_atomic_load(cnt, __ATOMIC_RELAXED, __HIP_MEMORY_SCOPE_AGENT)) < 32u) { __builtin_amdgcn_s_sleep(2); if (++spins > (1u << 22)) break; }
            __builtin_amdgcn_fence(__ATOMIC_ACQUIRE, "agent");
        }
        asm volatile("s_waitcnt vmcnt(0) lgkmcnt(0)" ::: "memory"); __builtin_amdgcn_s_barrier(); asm volatile("" ::: "memory");
        if (lane < 32) { const float* sl = slots + (size_t)(256 * u.ta + row) * 16; float t = 0.f;
#pragma unroll
            for (int k = 0; k < 4; ++k) t += __hip_atomic_load(sl + 4 * k, __ATOMIC_RELAXED, __HIP_MEMORY_SCOPE_AGENT);
            Sr[row] = 1.0f / sqrtf(t * (1.f / DM) + EPS); }
        asm volatile("s_waitcnt vmcnt(0) lgkmcnt(0)" ::: "memory"); __builtin_amdgcn_s_barrier(); asm volatile("" ::: "memory");
        f32x4 fg[2][2];
#pragma unroll
        for (int bj = 0; bj < 2; ++bj) { const int col = 256 * u.tb + HALF * bj + 32 * wc + 8 * fq; fg[bj][0] = *(const f32x4*)(final_g + col); fg[bj][1] = *(const f32x4*)(final_g + col + 4); }
#pragma unroll
        for (int ai = 0; ai < 2; ++ai)
#pragma unroll
            for (int m = 0; m < 4; ++m) { const int r = HALF * ai + 64 * wr + 16 * m + fr; const float rs = Sr[r];
#pragma unroll
                for (int bj = 0; bj < 2; ++bj) { const size_t off = (size_t)(256 * u.ta + r) * 1024 + 256 * u.tb + HALF * bj + 32 * wc + 8 * fq;
                    *(f32x4*)(out + off) = acc[ai][bj][m][0] * rs * fg[bj][0]; *(f32x4*)(out + off + 4) = acc[ai][bj][m][1] * rs * fg[bj][1]; } }
    }
};

__device__ __forceinline__ void p7_final(const Ptrs& P, int lane, int wave, int G) {
    const int gw = blockIdx.x * NWAVES + wave, NGW = G * NWAVES;
    const float* SSQO = (const float*)(P.ws + WS_SSQO);
    for (int row = gw; row < MLAT; row += NGW) {
        float s = 0.f;
        { const f32x4* p = (const f32x4*)(SSQO + (size_t)row * 16); const f32x4 a = p[0], b = p[1], c = p[2], d = p[3];
          s = ((a[0] + a[1]) + (a[2] + a[3])) + ((b[0] + b[1]) + (b[2] + b[3])) + ((c[0] + c[1]) + (c[2] + c[3])) + ((d[0] + d[1]) + (d[2] + d[3])); }
        const float rstd = 1.0f / sqrtf(s * (1.f / DM) + EPS);
        f32x4* o4 = (f32x4*)(P.out + (size_t)row * DM) + lane;
        const f32x4* g4 = (const f32x4*)P.final_g + lane;
#pragma unroll
        for (int j = 0; j < 4; ++j) { f32x4 v = o4[64 * j]; const f32x4 g = g4[64 * j]; v = v * rstd * g; o4[64 * j] = v; }
    }
}

__device__ __forceinline__ int crow(int r, int hi) { return (r & 3) + 8 * (r >> 2) + 4 * hi; }
__device__ __forceinline__ float half_max(float v) { const auto rr = __builtin_amdgcn_permlane32_swap(__float_as_uint(v), __float_as_uint(v), false, false); return fmaxf(__uint_as_float(rr[0]), __uint_as_float(rr[1])); }
__device__ __forceinline__ float half_sum(float v) { const auto rr = __builtin_amdgcn_permlane32_swap(__float_as_uint(v), __float_as_uint(v), false, false); return __uint_as_float(rr[0]) + __uint_as_float(rr[1]); }
constexpr int VROW = 136;
constexpr int ATT_RPB_OFF = 96 * 1024;

template <int DK, bool NA>
__device__ __forceinline__ void attn_unit(LAS unsigned char* lds, const bf16* Qg, const bf16* Kg, const bf16* Vtg, bf16* SZ, const float* rpb, int b, int h, int qblk, int tid, int lane, int wave) {
    constexpr int KROW = DK * 2 + 16, KCH = DK / 8  , NKC = 64 * KCH, KT_BYTES = 64 * KROW, VT_BYTES = 64 * VROW, BUF = KT_BYTES + VT_BYTES;
    const int r32 = lane & 31, hi = lane >> 5;
    const int q0 = qblk * 256;
    const bf16* Kh = Kg + (size_t)(b * NH + h) * TK * DK;
    const bf16* Vh = Vtg + (size_t)(b * NH + h) * 64 * TK;
    int ntiles, kr_lo = 0, nwin = 0, rq = 0, cq = 0, rs = 0, cs = 0;
    if (NA) { const int r0 = qblk * 4; auto rst = [](int r) { int s = r - 4; s = s < 0 ? 0 : s; return s > 56 ? 56 : s; };
        kr_lo = rst(r0); nwin = rst(r0 + 3) + 8 - kr_lo; ntiles = nwin + 4;
        rq = r0 + (wave >> 1); cq = 32 * (wave & 1) + r32; rs = rst(rq); cs = cq - 8; cs = cs < 0 ? 0 : cs; cs = cs > 48 ? 48 : cs;
        LAS float* bt = (LAS float*)(lds + ATT_RPB_OFF);
        for (int i = tid; i < 15 * 31; i += 512) bt[i] = rpb[h * 465 + i] * LOG2E;
    } else ntiles = TK / 64;
    bf16x8 qf[DK / 16];
    { const bf16* qp = Qg + ((size_t)(b * NH + h) * SEQ + q0 + 32 * wave + r32) * DK + 8 * hi;
#pragma unroll
      for (int s = 0; s < DK / 16; ++s) qf[s] = *(const bf16x8*)(qp + 16 * s); }
    auto tile_tok = [&](int j) -> int { if (NA) return j < nwin ? (kr_lo + j) * 64 : SEQ + (j - nwin) * 64; return j * 64; };
    v4u kreg0, kreg1, vreg;
    const int kc0 = tid, kc1 = tid + 512;
    auto gload = [&](int j) { const int tok = tile_tok(j);
        const unsigned char* kb = (const unsigned char*)(Kh + (size_t)tok * DK);
        kreg0 = *(const v4u*)(kb + (size_t)kc0 * 16);
        if (kc1 < NKC) kreg1 = *(const v4u*)(kb + (size_t)kc1 * 16);
        vreg = *(const v4u*)((const unsigned char*)(Vh + (size_t)(tid >> 3) * TK + tok) + (tid & 7) * 16); };
    auto lstore = [&](int buf) { LAS unsigned char* base = lds + buf * BUF;
        *(LAS v4u*)(base + (kc0 / KCH) * KROW + (kc0 % KCH) * 16) = kreg0;
        if (kc1 < NKC) *(LAS v4u*)(base + (kc1 / KCH) * KROW + (kc1 % KCH) * 16) = kreg1;
        LAS unsigned char* vp = base + KT_BYTES + (tid >> 3) * VROW + (tid & 7) * 16;
        *(LAS v2u*)vp = (v2u){vreg.x, vreg.y}; *(LAS v2u*)(vp + 8) = (v2u){vreg.z, vreg.w}; };
    float m_run = -1e30f, l_run = 0.f;
    f32x16 o0 = {}, o1 = {};
    gload(0); lstore(0); __syncthreads();
    for (int j = 0; j < ntiles; ++j) {
        const bool more = (j + 1 < ntiles);
        if (more) gload(j + 1);
        bool active = true; int krow = 0;
        if (NA && j < nwin) { krow = kr_lo + j; active = (krow >= rs && krow < rs + 8); }
        if (active) {
            const LAS unsigned char* kb = lds + (j & 1) * BUF;
            const LAS unsigned char* vb = kb + KT_BYTES;
            f32x16 s0 = {}, s1 = {};
#pragma unroll
            for (int s = 0; s < DK / 16; ++s) {
                const bf16x8 k0 = *(const LAS bf16x8*)(kb + r32 * KROW + (16 * s + 8 * hi) * 2);
                const bf16x8 k1 = *(const LAS bf16x8*)(kb + (32 + r32) * KROW + (16 * s + 8 * hi) * 2);
                s0 = __builtin_amdgcn_mfma_f32_32x32x16_bf16(k0, qf[s], s0, 0, 0, 0);
                s1 = __builtin_amdgcn_mfma_f32_32x32x16_bf16(k1, qf[s], s1, 0, 0, 0);
            }
            if (NA && j < nwin) {
                const LAS float* bt = (const LAS float*)(lds + ATT_RPB_OFF) + (krow - rq + 7) * 31 + (15 - cq);
#pragma unroll
                for (int i = 0; i < 16; ++i) {
                    const int kc = crow(i, hi);
                    { const bool ok = (unsigned)(kc - cs) < 16u; const float bv = bt[ok ? kc : cq]; s0[i] = ok ? s0[i] + bv : -1e30f; }
                    { const int kc2 = kc + 32; const bool ok = (unsigned)(kc2 - cs) < 16u; const float bv = bt[ok ? kc2 : cq]; s1[i] = ok ? s1[i] + bv : -1e30f; }
                }
            }
            float mx = fmaxf(s0[0], s1[0]);
#pragma unroll
            for (int i = 1; i < 16; ++i) mx = fmaxf(mx, fmaxf(s0[i], s1[i]));
            mx = half_max(mx);
            if (__any(mx > m_run + 4.0f)) {
                const float mnew = fmaxf(m_run, mx);
                const float alpha = __builtin_amdgcn_exp2f(m_run - mnew);
                m_run = mnew; l_run *= alpha;
#pragma unroll
                for (int i = 0; i < 16; ++i) { o0[i] *= alpha; o1[i] *= alpha; }
            }
            float ls = 0.f;
#pragma unroll
            for (int i = 0; i < 16; ++i) { s0[i] = __builtin_amdgcn_exp2f(s0[i] - m_run); s1[i] = __builtin_amdgcn_exp2f(s1[i] - m_run); ls += s0[i] + s1[i]; }
            l_run += ls;
            bf16x8 pb[2][2];
#pragma unroll
            for (int kk = 0; kk < 2; ++kk) {
                v4u w0, w1;
                w0.x = cvt_pk_bf16(s0[8 * kk + 0], s0[8 * kk + 1]); w0.y = cvt_pk_bf16(s0[8 * kk + 2], s0[8 * kk + 3]); w0.z = cvt_pk_bf16(s0[8 * kk + 4], s0[8 * kk + 5]); w0.w = cvt_pk_bf16(s0[8 * kk + 6], s0[8 * kk + 7]);
                w1.x = cvt_pk_bf16(s1[8 * kk + 0], s1[8 * kk + 1]); w1.y = cvt_pk_bf16(s1[8 * kk + 2], s1[8 * kk + 3]); w1.z = cvt_pk_bf16(s1[8 * kk + 4], s1[8 * kk + 5]); w1.w = cvt_pk_bf16(s1[8 * kk + 6], s1[8 * kk + 7]);
                pb[0][kk] = __builtin_bit_cast(bf16x8, w0); pb[1][kk] = __builtin_bit_cast(bf16x8, w1);
            }
#pragma unroll
            for (int u = 0; u < 2; ++u)
#pragma unroll
                for (int kk = 0; kk < 2; ++kk) {
                    const int koff = (32 * u + 16 * kk + 4 * hi) * 2;
                    const LAS unsigned char* v0p = vb + r32 * VROW + koff;
                    const LAS unsigned char* v1p = vb + (32 + r32) * VROW + koff;
                    const s16x4 a0 = *(const LAS s16x4*)v0p, a1 = *(const LAS s16x4*)(v0p + 16);
                    const s16x4 c0 = *(const LAS s16x4*)v1p, c1 = *(const LAS s16x4*)(v1p + 16);
                    const bf16x8 vf0 = {a0[0], a0[1], a0[2], a0[3], a1[0], a1[1], a1[2], a1[3]};
                    const bf16x8 vf1 = {c0[0], c0[1], c0[2], c0[3], c1[0], c1[1], c1[2], c1[3]};
                    o0 = __builtin_amdgcn_mfma_f32_32x32x16_bf16(vf0, pb[u][kk], o0, 0, 0, 0);
                    o1 = __builtin_amdgcn_mfma_f32_32x32x16_bf16(vf1, pb[u][kk], o1, 0, 0, 0);
                }
        }
        if (more) lstore((j + 1) & 1);
        __syncthreads();
    }
    const float lt = half_sum(l_run);
    const float inv = 1.0f / lt;
    bf16* zp = SZ + ((size_t)(b * SEQ + q0 + 32 * wave + r32)) * 512 + h * 64;
#pragma unroll
    for (int dt = 0; dt < 2; ++dt)
#pragma unroll
        for (int g = 0; g < 4; ++g) {
            bf16* p = zp + 32 * dt + 8 * g + 4 * hi;
            const v2u z = *(const v2u*)p;
            const f32x16& o = dt ? o1 : o0;
            v2u w; w.x = cvt_pk_bf16(o[4 * g + 0] * inv * bf_lo(z.x), o[4 * g + 1] * inv * bf_hi(z.x)); w.y = cvt_pk_bf16(o[4 * g + 2] * inv * bf_lo(z.y), o[4 * g + 3] * inv * bf_hi(z.y));
            *(v2u*)p = w;
        }
}


__device__ __forceinline__ void attn_unit_na2(LAS unsigned char* lds, const bf16* Qg, const bf16* Kg, const bf16* Vtg, bf16* SZ, const float* rpb, int b, int h, int qblk, int tid, int lane, int wave) {
    constexpr int DK = 64; constexpr bool NA = true;
    constexpr int KROW = DK * 2 + 16, KCH = DK / 8  , NKC = 64 * KCH, KT_BYTES = 64 * KROW, VT_BYTES = 64 * VROW, SUB = KT_BYTES + VT_BYTES, BUF = 2 * SUB;
    const int r32 = lane & 31, hi = lane >> 5;
    const int q0 = qblk * 256;
    const bf16* Kh = Kg + (size_t)(b * NH + h) * TK * DK;
    const bf16* Vh = Vtg + (size_t)(b * NH + h) * 64 * TK;
    int ntiles, kr_lo = 0, nwin = 0, rq = 0, cq = 0, rs = 0, cs = 0;
    unsigned vmask0 = 0u, vmask1 = 0u;
    if (NA) { const int r0 = qblk * 4; auto rst = [](int r) { int s = r - 4; s = s < 0 ? 0 : s; return s > 56 ? 56 : s; };
        kr_lo = rst(r0); nwin = rst(r0 + 3) + 8 - kr_lo; ntiles = nwin + 4;
        rq = r0 + (wave >> 1); cq = 32 * (wave & 1) + r32; rs = rst(rq); cs = cq - 8; cs = cs < 0 ? 0 : cs; cs = cs > 48 ? 48 : cs;
        for (int i = 0; i < 16; ++i) { const int kc = crow(i, hi); vmask0 |= ((unsigned)(kc - cs) < 16u ? 1u : 0u) << i; vmask1 |= ((unsigned)(kc + 32 - cs) < 16u ? 1u : 0u) << i; }
        LAS float* bt = (LAS float*)(lds + ATT_RPB_OFF);
        for (int i = tid; i < 15 * 31; i += 512) bt[i] = rpb[h * 465 + i] * LOG2E;
    } else ntiles = TK / 64;
    bf16x8 qf[DK / 16];
    { const bf16* qp = Qg + ((size_t)(b * NH + h) * SEQ + q0 + 32 * wave + r32) * DK + 8 * hi;
#pragma unroll
      for (int s = 0; s < DK / 16; ++s) qf[s] = *(const bf16x8*)(qp + 16 * s); }
    auto tile_tok = [&](int j) -> int { if (NA) return j < nwin ? (kr_lo + j) * 64 : SEQ + (j - nwin) * 64; return j * 64; };
    v4u kreg[2], vreg[2];
    const int kc0 = tid;
    auto gload = [&](int jp) {
#pragma unroll
        for (int sub = 0; sub < 2; ++sub) { const int j = 2 * jp + sub; if (j < ntiles) { const int tok = tile_tok(j);
            kreg[sub] = *(const v4u*)((const unsigned char*)(Kh + (size_t)tok * DK) + (size_t)kc0 * 16);
            vreg[sub] = *(const v4u*)((const unsigned char*)(Vh + (size_t)(tid >> 3) * TK + tok) + (tid & 7) * 16); } } };
    auto lstore = [&](int buf, int jp) {
#pragma unroll
        for (int sub = 0; sub < 2; ++sub) { if (2 * jp + sub < ntiles) { LAS unsigned char* base = lds + buf * BUF + sub * SUB;
            *(LAS v4u*)(base + (kc0 / KCH) * KROW + (kc0 % KCH) * 16) = kreg[sub];
            LAS unsigned char* vp = base + KT_BYTES + (tid >> 3) * VROW + (tid & 7) * 16;
            *(LAS v2u*)vp = (v2u){vreg[sub].x, vreg[sub].y}; *(LAS v2u*)(vp + 8) = (v2u){vreg[sub].z, vreg[sub].w}; } } };
    float m_run = -1e30f, l_run = 0.f;
    f32x16 o0 = {}, o1 = {};
    const int npairs = (ntiles + 1) >> 1;
    gload(0); lstore(0, 0); __syncthreads();
    for (int jp = 0; jp < npairs; ++jp) {
        const bool more = (jp + 1 < npairs);
        if (more) gload(jp + 1);
#pragma unroll
        for (int sub = 0; sub < 2; ++sub) {
        const int j = 2 * jp + sub;
        bool active = (j < ntiles); int krow = 0;
        if (NA && j < nwin) { krow = kr_lo + j; active = (krow >= rs && krow < rs + 8); }
        if (active) {
            const LAS unsigned char* kb = lds + (jp & 1) * BUF + sub * SUB;
            const LAS unsigned char* vb = kb + KT_BYTES;
            f32x16 s0 = {}, s1 = {};
#pragma unroll
            for (int s = 0; s < DK / 16; ++s) {
                const bf16x8 k0 = *(const LAS bf16x8*)(kb + r32 * KROW + (16 * s + 8 * hi) * 2);
                const bf16x8 k1 = *(const LAS bf16x8*)(kb + (32 + r32) * KROW + (16 * s + 8 * hi) * 2);
                s0 = __builtin_amdgcn_mfma_f32_32x32x16_bf16(k0, qf[s], s0, 0, 0, 0);
                s1 = __builtin_amdgcn_mfma_f32_32x32x16_bf16(k1, qf[s], s1, 0, 0, 0);
            }
            if (NA && j < nwin) {
                const LAS float* bt = (const LAS float*)(lds + ATT_RPB_OFF) + (krow - rq + 7) * 31 + (15 - cq);
#pragma unroll
                for (int i = 0; i < 16; ++i) {
                    const LAS float* bp = bt + 4 * hi;
                    const int kci = (i & 3) + 8 * (i >> 2);
                    { const float bv = bp[kci]; s0[i] = ((vmask0 >> i) & 1u) ? s0[i] + bv : -1e30f; }
                    { const float bv = bp[kci + 32]; s1[i] = ((vmask1 >> i) & 1u) ? s1[i] + bv : -1e30f; }
                }
            }
            float mx = fmaxf(s0[0], s1[0]);
#pragma unroll
            for (int i = 1; i < 16; ++i) mx = fmaxf(mx, fmaxf(s0[i], s1[i]));
            mx = half_max(mx);
            if (__any(mx > m_run + 4.0f)) {
                const float mnew = fmaxf(m_run, mx);
                const float alpha = __builtin_amdgcn_exp2f(m_run - mnew);
                m_run = mnew; l_run *= alpha;
#pragma unroll
                for (int i = 0; i < 16; ++i) { o0[i] *= alpha; o1[i] *= alpha; }
            }
            float ls = 0.f;
#pragma unroll
            for (int i = 0; i < 16; ++i) { s0[i] = __builtin_amdgcn_exp2f(s0[i] - m_run); s1[i] = __builtin_amdgcn_exp2f(s1[i] - m_run); ls += s0[i] + s1[i]; }
            l_run += ls;
            bf16x8 pb[2][2];
#pragma unroll
            for (int kk = 0; kk < 2; ++kk) {
                v4u w0, w1;
                w0.x = cvt_pk_bf16(s0[8 * kk + 0], s0[8 * kk + 1]); w0.y = cvt_pk_bf16(s0[8 * kk + 2], s0[8 * kk + 3]); w0.z = cvt_pk_bf16(s0[8 * kk + 4], s0[8 * kk + 5]); w0.w = cvt_pk_bf16(s0[8 * kk + 6], s0[8 * kk + 7]);
                w1.x = cvt_pk_bf16(s1[8 * kk + 0], s1[8 * kk + 1]); w1.y = cvt_pk_bf16(s1[8 * kk + 2], s1[8 * kk + 3]); w1.z = cvt_pk_bf16(s1[8 * kk + 4], s1[8 * kk + 5]); w1.w = cvt_pk_bf16(s1[8 * kk + 6], s1[8 * kk + 7]);
                pb[0][kk] = __builtin_bit_cast(bf16x8, w0); pb[1][kk] = __builtin_bit_cast(bf16x8, w1);
            }
#pragma unroll
            for (int u = 0; u < 2; ++u)
#pragma unroll
                for (int kk = 0; kk < 2; ++kk) {
                    const int koff = (32 * u + 16 * kk + 4 * hi) * 2;
                    const LAS unsigned char* v0p = vb + r32 * VROW + koff;
                    const LAS unsigned char* v1p = vb + (32 + r32) * VROW + koff;
                    const s16x4 a0 = *(const LAS s16x4*)v0p, a1 = *(const LAS s16x4*)(v0p + 16);
                    const s16x4 c0 = *(const LAS s16x4*)v1p, c1 = *(const LAS s16x4*)(v1p + 16);
                    const bf16x8 vf0 = {a0[0], a0[1], a0[2], a0[3], a1[0], a1[1], a1[2], a1[3]};
                    const bf16x8 vf1 = {c0[0], c0[1], c0[2], c0[3], c1[0], c1[1], c1[2], c1[3]};
                    o0 = __builtin_amdgcn_mfma_f32_32x32x16_bf16(vf0, pb[u][kk], o0, 0, 0, 0);
                    o1 = __builtin_amdgcn_mfma_f32_32x32x16_bf16(vf1, pb[u][kk], o1, 0, 0, 0);
                }
        }
        }
        if (more) lstore((jp + 1) & 1, jp + 1);
        __syncthreads();
    }
    const float lt = half_sum(l_run);
    const float inv = 1.0f / lt;
    bf16* zp = SZ + ((size_t)(b * SEQ + q0 + 32 * wave + r32)) * 512 + h * 64;
#pragma unroll
    for (int dt = 0; dt < 2; ++dt)
#pragma unroll
        for (int g = 0; g < 4; ++g) {
            bf16* p = zp + 32 * dt + 8 * g + 4 * hi;
            const v2u z = *(const v2u*)p;
            const f32x16& o = dt ? o1 : o0;
            v2u w; w.x = cvt_pk_bf16(o[4 * g + 0] * inv * bf_lo(z.x), o[4 * g + 1] * inv * bf_hi(z.x)); w.y = cvt_pk_bf16(o[4 * g + 2] * inv * bf_lo(z.y), o[4 * g + 3] * inv * bf_hi(z.y));
            *(v2u*)p = w;
        }
}


__device__ __forceinline__ void attn_unit_mla2(LAS unsigned char* lds, const bf16* Qg, const bf16* Kg, const bf16* Vtg, bf16* SZ, int b, int h, int qblk, int tid, int lane, int wave) {
    constexpr int DK = 96, KROW = DK * 2 + 16, KCH = DK / 8, NKC = 64 * KCH, KT_BYTES = 64 * KROW, VT_BYTES = 64 * VROW, SUB = KT_BYTES + VT_BYTES, BUF = 2 * SUB;
    const int r32 = lane & 31, hi = lane >> 5;
    const int q0 = qblk * 256;
    const bf16* Kh = Kg + (size_t)(b * NH + h) * TK * DK;
    const bf16* Vh = Vtg + (size_t)(b * NH + h) * 64 * TK;
    constexpr int ntiles = TK / 128;
    bf16x8 qf[DK / 16];
    { const bf16* qp = Qg + ((size_t)(b * NH + h) * SEQ + q0 + 32 * wave + r32) * DK + 8 * hi;
#pragma unroll
      for (int s = 0; s < DK / 16; ++s) qf[s] = *(const bf16x8*)(qp + 16 * s); }
    v4u kreg[2][2], vreg[2];
    const int kc0 = tid, kc1 = tid + 512;
    auto gload = [&](int j) {
#pragma unroll
        for (int sub = 0; sub < 2; ++sub) { const int tok = j * 128 + 64 * sub;
            const unsigned char* kb = (const unsigned char*)(Kh + (size_t)tok * DK);
            kreg[sub][0] = *(const v4u*)(kb + (size_t)kc0 * 16);
            if (kc1 < NKC) kreg[sub][1] = *(const v4u*)(kb + (size_t)kc1 * 16);
            vreg[sub] = *(const v4u*)((const unsigned char*)(Vh + (size_t)(tid >> 3) * TK + tok) + (tid & 7) * 16); } };
    auto lstore = [&](int buf) {
#pragma unroll
        for (int sub = 0; sub < 2; ++sub) { LAS unsigned char* base = lds + buf * BUF + sub * SUB;
            *(LAS v4u*)(base + (kc0 / KCH) * KROW + (kc0 % KCH) * 16) = kreg[sub][0];
            if (kc1 < NKC) *(LAS v4u*)(base + (kc1 / KCH) * KROW + (kc1 % KCH) * 16) = kreg[sub][1];
            LAS unsigned char* vp = base + KT_BYTES + (tid >> 3) * VROW + (tid & 7) * 16;
            *(LAS v2u*)vp = (v2u){vreg[sub].x, vreg[sub].y}; *(LAS v2u*)(vp + 8) = (v2u){vreg[sub].z, vreg[sub].w}; } };
    float m_run = 0.f, l_run = 0.f;
    f32x16 o0 = {}, o1 = {};
    gload(0); lstore(0); __syncthreads();
    for (int j = 0; j < ntiles; ++j) {
        const bool more = (j + 1 < ntiles);
        if (more) gload(j + 1);
        const LAS unsigned char* tb = lds + (j & 1) * BUF;
        f32x16 s[2][2];
        f32x16 negm;
#pragma unroll
        for (int i = 0; i < 16; ++i) negm[i] = -m_run;
        const LAS unsigned char* kp0 = tb + r32 * KROW + 16 * hi;
        const LAS unsigned char* vp0 = tb + KT_BYTES + r32 * VROW + 8 * hi;
#define KFRAG(sub, u, st) (*(const LAS bf16x8*)(kp0 + (sub) * SUB + (u) * 32 * KROW + (st) * 32))
        bf16x8 ka[DK / 16][2], kb2[DK / 16][2];
#pragma unroll
        for (int st = 0; st < DK / 16; ++st) { ka[st][0] = KFRAG(0, 0, st); ka[st][1] = KFRAG(0, 1, st); }
        __builtin_amdgcn_sched_barrier(0);
#pragma unroll
        for (int st = 0; st < DK / 16; ++st) {
            kb2[st][0] = KFRAG(1, 0, st); kb2[st][1] = KFRAG(1, 1, st);
            s[0][0] = __builtin_amdgcn_mfma_f32_32x32x16_bf16(ka[st][0], qf[st], st == 0 ? negm : s[0][0], 0, 0, 0);
            s[0][1] = __builtin_amdgcn_mfma_f32_32x32x16_bf16(ka[st][1], qf[st], st == 0 ? negm : s[0][1], 0, 0, 0);
        }
        __builtin_amdgcn_sched_barrier(0);
        s16x4 va[2][2][2][2];
#define VFRAG(sub, u, kk, dt, half) (*(const LAS s16x4*)(vp0 + (sub) * SUB + (dt) * 32 * VROW + (32 * (u) + 16 * (kk)) * 2 + (half) * 16))
#pragma unroll
        for (int u = 0; u < 2; ++u)
#pragma unroll
            for (int kk = 0; kk < 2; ++kk)
#pragma unroll
                for (int dt = 0; dt < 2; ++dt) { va[u][kk][dt][0] = VFRAG(0, u, kk, dt, 0); va[u][kk][dt][1] = VFRAG(0, u, kk, dt, 1); }
#pragma unroll
        for (int st = 0; st < DK / 16; ++st) {
            s[1][0] = __builtin_amdgcn_mfma_f32_32x32x16_bf16(kb2[st][0], qf[st], st == 0 ? negm : s[1][0], 0, 0, 0);
            s[1][1] = __builtin_amdgcn_mfma_f32_32x32x16_bf16(kb2[st][1], qf[st], st == 0 ? negm : s[1][1], 0, 0, 0);
        }
        __builtin_amdgcn_sched_barrier(0);
        float mx = fmaxf(fmaxf(s[0][0][0], s[0][1][0]), fmaxf(s[1][0][0], s[1][1][0]));
#pragma unroll
        for (int i = 1; i < 16; ++i) mx = fmaxf(mx, fmaxf(fmaxf(s[0][0][i], s[0][1][i]), fmaxf(s[1][0][i], s[1][1][i])));
        mx = half_max(mx);
        if (j == 0 || __any(mx > 4.0f)) {
            const float d = (j == 0) ? mx : fmaxf(mx, 0.f);
            const float alpha = (j == 0) ? 0.f : __builtin_amdgcn_exp2f(-d);
            m_run += d; l_run *= alpha;
#pragma unroll
            for (int i = 0; i < 16; ++i) { o0[i] *= alpha; o1[i] *= alpha; }
#pragma unroll
            for (int sub = 0; sub < 2; ++sub)
#pragma unroll
                for (int u = 0; u < 2; ++u)
#pragma unroll
                    for (int i = 0; i < 16; ++i) s[sub][u][i] -= d;
        }
        float ls = 0.f;
#pragma unroll
        for (int sub = 0; sub < 2; ++sub)
#pragma unroll
            for (int u = 0; u < 2; ++u)
#pragma unroll
                for (int i = 0; i < 16; ++i) { s[sub][u][i] = __builtin_amdgcn_exp2f(s[sub][u][i]); ls += s[sub][u][i]; }
        l_run += ls;
        __builtin_amdgcn_sched_barrier(0);
        s16x4 vb2[2][2][2][2];
#define PFRAG(sub, u, kk) ({ v4u w_; const f32x16& sv_ = s[sub][u]; w_.x = cvt_pk_bf16(sv_[8 * (kk) + 0], sv_[8 * (kk) + 1]); w_.y = cvt_pk_bf16(sv_[8 * (kk) + 2], sv_[8 * (kk) + 3]); \
            w_.z = cvt_pk_bf16(sv_[8 * (kk) + 4], sv_[8 * (kk) + 5]); w_.w = cvt_pk_bf16(sv_[8 * (kk) + 6], sv_[8 * (kk) + 7]); __builtin_bit_cast(bf16x8, w_); })
#define V8(a_) ((bf16x8){(a_)[0][0], (a_)[0][1], (a_)[0][2], (a_)[0][3], (a_)[1][0], (a_)[1][1], (a_)[1][2], (a_)[1][3]})
#pragma unroll
        for (int u = 0; u < 2; ++u)
#pragma unroll
            for (int kk = 0; kk < 2; ++kk) {
#pragma unroll
                for (int dt = 0; dt < 2; ++dt) { vb2[u][kk][dt][0] = VFRAG(1, u, kk, dt, 0); vb2[u][kk][dt][1] = VFRAG(1, u, kk, dt, 1); }
                const bf16x8 pb = PFRAG(0, u, kk);
                o0 = __builtin_amdgcn_mfma_f32_32x32x16_bf16(V8(va[u][kk][0]), pb, o0, 0, 0, 0);
                o1 = __builtin_amdgcn_mfma_f32_32x32x16_bf16(V8(va[u][kk][1]), pb, o1, 0, 0, 0);
            }
        __builtin_amdgcn_sched_barrier(0);
#pragma unroll
        for (int u = 0; u < 2; ++u)
#pragma unroll
            for (int kk = 0; kk < 2; ++kk) {
                const bf16x8 pb = PFRAG(1, u, kk);
                o0 = __builtin_amdgcn_mfma_f32_32x32x16_bf16(V8(vb2[u][kk][0]), pb, o0, 0, 0, 0);
                o1 = __builtin_amdgcn_mfma_f32_32x32x16_bf16(V8(vb2[u][kk][1]), pb, o1, 0, 0, 0);
            }
#undef KFRAG
#undef VFRAG
#undef PFRAG
#undef V8
        if (more) lstore((j + 1) & 1);
        __syncthreads();
    }
    const float lt = half_sum(l_run);
    const float inv = 1.0f / lt;
    bf16* zp = SZ + ((size_t)(b * SEQ + q0 + 32 * wave + r32)) * 512 + h * 64;
#pragma unroll
    for (int dt = 0; dt < 2; ++dt)
#pragma unroll
        for (int g = 0; g < 4; ++g) {
            bf16* p = zp + 32 * dt + 8 * g + 4 * hi;
            const v2u z = *(const v2u*)p;
            const f32x16& o = dt ? o1 : o0;
            v2u w; w.x = cvt_pk_bf16(o[4 * g + 0] * inv * bf_lo(z.x), o[4 * g + 1] * inv * bf_hi(z.x)); w.y = cvt_pk_bf16(o[4 * g + 2] * inv * bf_lo(z.y), o[4 * g + 3] * inv * bf_hi(z.y));
            *(v2u*)p = w;
        }
}

constexpr int CW_CTXKV = 12288;
__device__ __forceinline__ void p4_attention(const Ptrs& P, LAS unsigned char* lds, int tid, int lane, int wave, int G) {
    const int bx = blockIdx.x; const int vcu = (G % 8 == 0) ? (bx % 8) * (G / 8) + bx / 8 : bx;
    for (int u = vcu; u < 512; u += G) { const int bh = u >> 4, qb = u & 15;
        attn_unit_na2(lds, (const bf16*)(P.ws + WS_QB), (const bf16*)(P.ws + WS_KB), (const bf16*)(P.ws + WS_VBT), (bf16*)(P.ws + WS_SZB), P.rpb, bh >> 3, bh & 7, qb, tid, lane, wave); }
    if (tid == 0) { unsigned* cnt = (unsigned*)(P.ws + WS_CTL) + CW_CTXKV; unsigned spins = 0;
        while (__hip_atomic_load(cnt, __ATOMIC_RELAXED, __HIP_MEMORY_SCOPE_AGENT) < 16u) { __builtin_amdgcn_s_sleep(2); if (++spins > (1u << 22)) break; }
        __builtin_amdgcn_fence(__ATOMIC_ACQUIRE, "agent"); asm volatile("s_waitcnt vmcnt(0)" ::: "memory"); }
    __syncthreads();
    for (int u = vcu; u < 512; u += G) { const int bh = u >> 4, qb = u & 15;
        attn_unit_mla2(lds, (const bf16*)(P.ws + WS_QA), (const bf16*)((unsigned char*)P.out + DO_KA), (const bf16*)((unsigned char*)P.out + DO_VAT), (bf16*)(P.ws + WS_SZA), bh >> 3, bh & 7, qb, tid, lane, wave); }
}

struct Args { Ptrs p; int ph_lo, ph_hi; };
constexpr int N_PHASES = 8;
__global__ void __launch_bounds__(NWAVES * 64, 2) mk_fwd(Args args) {
    extern __shared__ __attribute__((aligned(16))) unsigned char lds_raw[];
    LAS unsigned char* lds = (LAS unsigned char*)lds_raw;
    const Ptrs& P = args.p;
    const int tid = threadIdx.x, lane = tid & 63, wave = __builtin_amdgcn_readfirstlane(tid >> 6);
    const int G = gridDim.x;
    volatile LAS unsigned* MISC = (volatile LAS unsigned*)(lds + MISC_OFF);
    for (int u = tid; u < 32; u += NWAVES * 64) MISC[u] = 0u;
    __syncthreads();
    XcdBarrier bar; bar.bar = (unsigned*)(P.ws + WS_CTL) + CW_BAR; bar.x = 0; bar.st = nullptr;
    if (MK_N_LAUNCHES == 1) bar = xcd_barrier_post((unsigned*)(P.ws + WS_CTL) + CW_BAR, MISC + 8);
    const int lo = args.ph_lo, hi = args.ph_hi;
    int K1024 = 1024, K512 = 512, K256 = 256; asm volatile("" : "+s"(K1024), "+s"(K512), "+s"(K256));
#ifndef PH_MASK
#define PH_MASK 0xff
#endif
#define IN(k) (((PH_MASK >> (k)) & 1) && lo <= (k) && (k) < hi)
#define SEAM(k) do { if (IN(k) && IN((k) + 1)) xcd_barrier(bar); } while (0)
    unsigned char* ws = P.ws; unsigned char* dout = (unsigned char*)P.out;

    if (IN(0)) { p0_gemv(P, lds, tid, lane, wave, G); }
    SEAM(0);
    if (IN(1)) { p0_weights(P, lds, tid, lane, wave, G); p1_hconv(P, lane, wave, G); }
    SEAM(1);
    if (IN(2)) { SchedG1 S{G, (int)blockIdx.x, (const char*)(ws + WS_H), (const char*)(ws + WS_WIN)}; EpiG1 E{ws, dout};
        pg8::gemm_phase<EpiG1, SchedG1, true, true>(lds, K1024, S, E); }
    SEAM(2);
    const int nCtx = (G >= 64) ? 20 : G, g23_first = (G >= 64) ? 20 : 0;
    if (IN(3)) { { SchedG1C S{nCtx, (int)blockIdx.x, (const char*)(ws + WS_H), (const char*)(ws + WS_WIN)}; EpiG1 E{ws, dout}; pg8::gemm_phase<EpiG1, SchedG1C, true, true>(lds, K1024, S, E); }
        { SchedG23 S{g23_first, G - g23_first, (int)blockIdx.x, (const char*)ws}; EpiG23 E{ws, dout}; pg8::gemm_phase<EpiG23, SchedG23, true, true>(lds, K256, S, E); } }
    SEAM(3);
    if (IN(4)) {
        const int nKv = (G >= 16) ? 16 : G; int my_units = 0; for (int k = (int)blockIdx.x; k < 16 && (int)blockIdx.x < nKv; k += nKv) ++my_units;
        { SchedG23C S{nKv, (int)blockIdx.x, (const char*)ws}; EpiG23 E{ws, dout}; pg8::gemm_phase<EpiG23, SchedG23C, true, true>(lds, K256, S, E); }
        if (my_units > 0) {
            asm volatile("s_waitcnt vmcnt(0)" ::: "memory"); __syncthreads();
            if (tid == 0) { __builtin_amdgcn_fence(__ATOMIC_RELEASE, "agent"); asm volatile("s_waitcnt vmcnt(0)" ::: "memory");
                __hip_atomic_fetch_add((unsigned*)(ws + WS_CTL) + CW_CTXKV, (unsigned)my_units, __ATOMIC_RELAXED, __HIP_MEMORY_SCOPE_AGENT); }
        }
        p4_attention(P, lds, tid, lane, wave, G); }
    SEAM(4);
    if (IN(5)) { SchedG4 S{G, (int)blockIdx.x, (const char*)(ws + WS_SZA), (const char*)(ws + WS_SZB), (const char*)(ws + WS_WOA), (const char*)(ws + WS_WOB)}; EpiG4 E{ws, P.out};
        pg8::gemm_phase<EpiG4, SchedG4, true, true>(lds, K512, S, E); }
    SEAM(5);
    const bool fuse_final = (G == 256) && IN(6) && IN(7);
    if (IN(6)) { SchedG5 S{G, (int)blockIdx.x, (const char*)(ws + WS_M), (const char*)(ws + WS_WOUT)};
        if (fuse_final) { EpiG5F E{ws, P.x, P.out, P.final_g}; pg8::gemm_phase<EpiG5F, SchedG5, false, true>(lds, K1024, S, E); }
        else { EpiG5 E{ws, P.x, P.out}; pg8::gemm_phase<EpiG5, SchedG5, true, true>(lds, K1024, S, E); } }
    if (!fuse_final) {
    SEAM(6);
    if (IN(7)) { p7_final(P, lane, wave, G); }
    }
#undef IN
#undef SEAM
}

extern "C" void kernel_launch(void* const* d_in, const int* in_sizes, int n_in, void* d_out, int out_size, void* d_ws, size_t ws_size, hipStream_t stream) {
    static int grid = 0;
    if (grid == 0) {
        if (n_in != 17 || in_sizes[0] != MLAT * DM || out_size != MLAT * DM || ws_size < WS_END) { fprintf(stderr, "kernel_launch: unexpected shapes (n_in %d, ws %zu); nothing launched\n", n_in, ws_size); grid = -1; return; }
        int dev = 0, cus = 0, per_cu = 0;
        if (hipGetDevice(&dev) != hipSuccess || hipDeviceGetAttribute(&cus, hipDeviceAttributeMultiprocessorCount, dev) != hipSuccess) { grid = -1; return; }
        if (hipFuncSetAttribute((const void*)mk_fwd, hipFuncAttributeMaxDynamicSharedMemorySize, LDS_BYTES) != hipSuccess) { fprintf(stderr, "kernel_launch: hipFuncSetAttribute failed\n"); grid = -1; return; }
        if (hipOccupancyMaxActiveBlocksPerMultiprocessor(&per_cu, (const void*)mk_fwd, NWAVES * 64, LDS_BYTES) != hipSuccess || per_cu < 1) fprintf(stderr, "kernel_launch: occupancy query says %d\n", per_cu);
        (void)hipGetLastError();
        grid = cus;
    }
    if (grid < 0) return;
    if (hipMemsetAsync((char*)d_ws + WS_CTL, 0, CTL_ZERO_BYTES, stream) != hipSuccess) { fprintf(stderr, "kernel_launch: memset failed\n"); return; }
    Args a{};
    const float** pp = (const float**)&a.p;
    for (int i = 0; i < 17; ++i) pp[i] = (const float*)d_in[i];
    a.p.out = (float*)d_out; a.p.ws = (unsigned char*)d_ws;
    if (MK_N_LAUNCHES == 1) {
        a.ph_lo = 0; a.ph_hi = N_PHASES;
        void* kargs[] = {&a};
        hipError_t e = hipLaunchCooperativeKernel((const void*)mk_fwd, dim3(grid), dim3(NWAVES * 64), kargs, LDS_BYTES, stream);
        if (e != hipSuccess) fprintf(stderr, "kernel_launch: cooperative launch failed: %s (grid %d)\n", hipGetErrorString(e), grid);
    } else {
        for (int k = 0; k < N_PHASES; ++k) { a.ph_lo = k; a.ph_hi = k + 1; hipLaunchKernelGGL(mk_fwd, dim3(grid), dim3(NWAVES * 64), LDS_BYTES, stream, a); }
    }
}
```
